# Optimizing an MI355X kernel written in HIP

```python
import jax, jax.numpy as jnp
from jax import lax
import numpy as np

D_MODEL = 1024
BATCH = 8
SEQ = 2048
DEPTH = 1

MEM_LEN = 256
EPS = 1e-6

HG_HEADS = 4
HG_FDIM = 128
HG_IDIM = 128
HG_WIDTH = HG_HEADS * HG_IDIM
GLA_HEADS = 4
GLA_KDIM = 64
GLA_VDIM = 128
GLA_WIDTH = GLA_HEADS * GLA_VDIM
GLA_GATE_RANK = 16
GLA_GATE_NORMALIZER = 16.0
MIX_WIDTH = HG_WIDTH + GLA_WIDTH
CHUNK = 64
IN_SPLITS = (HG_HEADS * HG_FDIM,
             HG_HEADS * HG_FDIM,
             HG_WIDTH,
             HG_WIDTH,
             GLA_HEADS * GLA_KDIM,
             GLA_HEADS * GLA_KDIM,
             GLA_WIDTH,
             GLA_WIDTH,
             GLA_GATE_RANK)
IN_WIDTH = sum(IN_SPLITS)

XA_HEADS = 4
XA_HDIM = D_MODEL // XA_HEADS

N_EXPERTS = 32
TOP_K = 4
D_EXPERT = D_MODEL
SWIGLU_LIMIT = 7.0
SWIGLU_ALPHA = 1.702
MOE_BLOCK = 256

kernel_name = "hybrid_hgrn2_gla_xattn_moe"


def rmsnorm(x, w):
    xf = x.astype(jnp.float32)
    y = xf * lax.rsqrt(jnp.mean(xf * xf, axis=-1, keepdims=True) + EPS)
    return (y * w.astype(jnp.float32)).astype(x.dtype)


def split_heads(a, n):
    b, t, _ = a.shape
    return a.reshape(b, t, n, -1).transpose(0, 2, 1, 3)


def chunked_gated_recurrence(q, k, v, g, scale):
    B, H, T, K = q.shape
    V = v.shape[-1]
    n = T // CHUNK

    def to_chunks(a):
        return a.reshape(B, H, n, CHUNK, a.shape[-1]).transpose(2, 0, 1, 3, 4)

    qc, kc, vc = to_chunks(q * scale), to_chunks(k), to_chunks(v)
    gc = to_chunks(g.astype(jnp.float32))
    causal = jnp.tril(jnp.ones((CHUNK, CHUNK), dtype=bool))[:, :, None]

    def step(S, inp):
        qb, kb, vb, gb = inp
        b = jnp.cumsum(gb, axis=2)
        diff = b[:, :, :, None, :] - b[:, :, None, :, :]
        decay = jnp.exp(jnp.where(causal, diff, -jnp.inf))
        scores = jnp.einsum('bhik,bhjk,bhijk->bhij', qb, kb, decay)
        o = (jnp.einsum('bhij,bhjv->bhiv', scores, vb)
             + jnp.einsum('bhik,bhkv->bhiv', qb * jnp.exp(b), S))
        b_last = b[:, :, -1:, :]
        S_new = (jnp.exp(b_last[:, :, 0, :])[..., None] * S
                 + jnp.einsum('bhjk,bhjv->bhkv', kb * jnp.exp(b_last - b), vb))
        return S_new, o

    S0 = jnp.zeros((B, H, K, V), jnp.float32)
    _, o = lax.scan(step, S0, (qc, kc, vc, gc))
    return o.transpose(1, 2, 0, 3, 4).reshape(B, H, T, V).astype(v.dtype)


def gated_head_norm(o, gate, w):
    b, h, t, vd = o.shape
    o = rmsnorm(o.transpose(0, 2, 1, 3), w)
    return (o * jax.nn.silu(gate.reshape(b, t, h, vd))).reshape(b, t, h * vd)


def token_mix(h, w_in, lb, hg_onorm_w, gla_w_gk2, gla_b_gk, gla_onorm_w, w_out):
    f32 = jnp.float32
    proj = h @ w_in
    idx = np.cumsum(IN_SPLITS)[:-1].tolist()
    (hq, hf, hi, hgate, gq, gk_, gv, ggate, glr) = jnp.split(proj, idx, axis=-1)

    f = lb + (1.0 - lb) * jax.nn.sigmoid(hf.astype(f32))
    hk = (1.0 - f).astype(h.dtype)
    hlogf = jnp.log(f)
    o_hg = chunked_gated_recurrence(split_heads(jax.nn.silu(hq), HG_HEADS),
                                    split_heads(hk, HG_HEADS),
                                    split_heads(hi, HG_HEADS),
                                    split_heads(hlogf, HG_HEADS), 1.0)
    y_hg = gated_head_norm(o_hg, hgate, hg_onorm_w)

    gdecay = jax.nn.log_sigmoid((glr @ gla_w_gk2 + gla_b_gk).astype(f32)) / GLA_GATE_NORMALIZER
    o_gla = chunked_gated_recurrence(split_heads(gq, GLA_HEADS),
                                     split_heads(gk_, GLA_HEADS),
                                     split_heads(gv, GLA_HEADS),
                                     split_heads(gdecay, GLA_HEADS), GLA_KDIM ** -0.5)
    y_gla = gated_head_norm(o_gla, ggate, gla_onorm_w)

    return jnp.concatenate([y_hg, y_gla], axis=-1) @ w_out


def cross_attend(h, m, w_xq, w_xkv, w_xo):
    b, t, d = h.shape
    q = (h @ w_xq).reshape(b, t, XA_HEADS, XA_HDIM)
    k, v = jnp.split(m @ w_xkv, 2, axis=-1)
    k = k.reshape(b, -1, XA_HEADS, XA_HDIM)
    v = v.reshape(b, -1, XA_HEADS, XA_HDIM)
    s = jnp.einsum('bthd,bmhd->bhtm', q, k).astype(jnp.float32) * (XA_HDIM ** -0.5)
    p = jax.nn.softmax(s, axis=-1).astype(v.dtype)
    o = jnp.einsum('bhtm,bmhd->bthd', p, v).reshape(b, t, d)
    return o @ w_xo


def moe(h, w_router, b_router, w_gate_up, b_gate_up, w_down, b_down):
    b, t, d = h.shape
    n_tok = b * t
    h2 = h.reshape(n_tok, d)
    logits = (h2 @ w_router + b_router).astype(jnp.float32)
    top_v, top_i = lax.top_k(logits, TOP_K)
    gates = jax.nn.softmax(top_v, axis=-1).astype(h.dtype)

    n_assign = n_tok * TOP_K
    flat_e = top_i.reshape(-1).astype(jnp.int32)
    flat_tok = jnp.arange(n_assign, dtype=jnp.int32) // TOP_K
    flat_g = gates.reshape(-1)
    order = jnp.argsort(flat_e, stable=True)
    se, stok, sg = flat_e[order], flat_tok[order], flat_g[order]

    counts = jnp.bincount(flat_e, length=N_EXPERTS).astype(jnp.int32)
    starts = jnp.cumsum(counts) - counts
    padded = (counts + MOE_BLOCK - 1) // MOE_BLOCK * MOE_BLOCK
    pends = jnp.cumsum(padded)
    pstarts = pends - padded
    dest = pstarts[se] + (jnp.arange(n_assign, dtype=jnp.int32) - starts[se])

    n_rows = -(-n_assign // MOE_BLOCK) * MOE_BLOCK + N_EXPERTS * MOE_BLOCK
    n_blocks = n_rows // MOE_BLOCK
    row_tok = jnp.zeros((n_rows,), jnp.int32).at[dest].set(stok)
    row_g = jnp.zeros((n_rows,), h.dtype).at[dest].set(sg)
    block_starts = jnp.arange(n_blocks, dtype=jnp.int32) * MOE_BLOCK
    block_e = jnp.clip(jnp.searchsorted(pends, block_starts, side='right'), 0, N_EXPERTS - 1)

    def expert_block(args):
        xb, e = args
        gu = xb @ w_gate_up[e] + b_gate_up[e]
        gate, up = gu[:, :D_EXPERT], gu[:, D_EXPERT:]
        gate = jnp.minimum(gate, SWIGLU_LIMIT)
        up = jnp.clip(up, -SWIGLU_LIMIT, SWIGLU_LIMIT)
        act = (up + 1.0) * gate * jax.nn.sigmoid(SWIGLU_ALPHA * gate)
        return act @ w_down[e] + b_down[e]

    xb = h2[row_tok].reshape(n_blocks, MOE_BLOCK, d)
    yb = lax.map(expert_block, (xb, block_e)).reshape(n_rows, d)
    y = jnp.zeros_like(h2).at[row_tok].add(yb * row_g[:, None])
    return y.reshape(b, t, d)


def setup_inputs(seed: int = 0) -> dict:
    key = jax.random.key(seed)
    ks = jax.random.split(key, 24)
    f32 = jnp.float32
    nrm = lambda k, shape, scale: jax.random.normal(k, shape, f32) * scale
    gain = lambda k, shape: 1.0 + 0.05 * jax.random.normal(k, shape, f32)
    L, D, E, F = DEPTH, D_MODEL, N_EXPERTS, D_EXPERT
    return {
        "x": nrm(ks[0], (BATCH, SEQ, D), 1.0),
        "mem": nrm(ks[1], (BATCH, MEM_LEN, D), 1.0),
        "norm_mix_w": gain(ks[2], (L, D)),
        "w_in": nrm(ks[3], (L, D, IN_WIDTH), D ** -0.5),
        "hg_lb_logits": nrm(ks[4], (L + 1, HG_HEADS * HG_FDIM), 0.1),
        "hg_onorm_w": gain(ks[5], (L, HG_IDIM)),
        "gla_w_gk2": nrm(ks[6], (L, GLA_GATE_RANK, GLA_HEADS * GLA_KDIM), GLA_GATE_RANK ** -0.5),
        "gla_b_gk": nrm(ks[7], (L, GLA_HEADS * GLA_KDIM), 0.1),
        "gla_onorm_w": gain(ks[8], (L, GLA_VDIM)),
        "w_out": nrm(ks[9], (L, MIX_WIDTH, D), MIX_WIDTH ** -0.5),
        "norm_xa_w": gain(ks[10], (L, D)),
        "norm_mem_w": gain(ks[11], (L, D)),
        "w_xq": nrm(ks[12], (L, D, D), D ** -0.5),
        "w_xkv": nrm(ks[13], (L, D, 2 * D), D ** -0.5),
        "w_xo": nrm(ks[14], (L, D, D), D ** -0.5),
        "norm_moe_w": gain(ks[15], (L, D)),
        "w_router": nrm(ks[16], (L, D, E), D ** -0.5),
        "b_router": nrm(ks[17], (L, E), 0.01),
        "w_gate_up": nrm(ks[18], (L, E, D, 2 * F), D ** -0.5),
        "b_gate_up": nrm(ks[19], (L, E, 2 * F), 0.01),
        "w_down": nrm(ks[20], (L, E, F, D), F ** -0.5),
        "b_down": nrm(ks[21], (L, E, D), 0.01),
        "norm_final_w": gain(ks[22], (D,)),
    }


def reference(x, mem, norm_mix_w, w_in, hg_lb_logits, hg_onorm_w, gla_w_gk2, gla_b_gk,
              gla_onorm_w, w_out, norm_xa_w, norm_mem_w, w_xq, w_xkv, w_xo, norm_moe_w,
              w_router, b_router, w_gate_up, b_gate_up, w_down, b_down, norm_final_w):
    lbs = jnp.cumsum(jax.nn.softmax(hg_lb_logits.astype(jnp.float32), axis=0), axis=0)
    for l in range(DEPTH):
        h = rmsnorm(x, norm_mix_w[l])
        x = x + token_mix(h, w_in[l], lbs[l], hg_onorm_w[l], gla_w_gk2[l], gla_b_gk[l],
                          gla_onorm_w[l], w_out[l])
        x = x + cross_attend(rmsnorm(x, norm_xa_w[l]), rmsnorm(mem, norm_mem_w[l]),
                             w_xq[l], w_xkv[l], w_xo[l])
        x = x + moe(rmsnorm(x, norm_moe_w[l]), w_router[l], b_router[l], w_gate_up[l],
                    b_gate_up[l], w_down[l], b_down[l])
    return rmsnorm(x, norm_final_w)
```

```cpp
#define MEGA_MASK 0x1FFF
#include <hip/hip_runtime.h>
#include <cstdio>
#include <cstdint>

typedef unsigned short bf16;
constexpr int D = 1024, BATCH = 8, SEQ = 2048, NTOK = BATCH * SEQ, MEML = 256, NMEM = BATCH * MEML;
constexpr int INW = 3600;
constexpr int PBW = 3584;
constexpr int GW = 768;
constexpr int NIN = 3840;
constexpr int C_HQ = 0, C_HF = 512, C_HI = 1024, C_HGATE = 1536, C_GQ = 2048, C_GK = 2304, C_GV = 2560, C_GGATE = 3072, C_GLR = 3584;
constexpr int NEXP = 32, TOPK = 4, NASSIGN = NTOK * TOPK, MOEB = 256, NROWS = NASSIGN + NEXP * MOEB, NRT = NROWS / MOEB;
constexpr float EPS = 1e-6f;

constexpr size_t MiB = 1u << 20;
constexpr size_t WS_CTL = 0, CTL_ZERO_BYTES = 1 * MiB;
constexpr int CW_TMO = 0, CW_CODE = 1, CW_BAR = 32768, CW_COUNTS = 16384, CW_FILL = 16384 + 64, CW_RDY = 65536;
constexpr size_t WS_TAB = 1 * MiB;
constexpr size_t OFF_LB = 0, OFF_PSTART = 4096, OFF_TILEE = 8192, OFF_NRT = 12288, OFF_HIST = 16384;
constexpr size_t WS_TOKE = 2 * MiB, WS_TOKG = WS_TOKE + 256 * 1024, WS_TOKDEST = WS_TOKG + 256 * 1024, WS_ROWGATE = WS_TOKDEST + 256 * 1024;
constexpr size_t WS_TOKRSTD = 3 * MiB + 64 * 1024, WS_ROWRSTD = 3 * MiB + 128 * 1024, WS_SSQ = 726 * MiB;
constexpr size_t WS_WT_IN = 4 * MiB;
constexpr size_t WS_WT_OUT = 12 * MiB, WS_WT_XQ = 14 * MiB, WS_WT_XKV = 16 * MiB, WS_WT_XO = 20 * MiB;
constexpr size_t WS_WT_GU = 22 * MiB;
constexpr size_t WS_WT_DN = 150 * MiB;
constexpr size_t WS_PB = 214 * MiB;
constexpr size_t WS_G = 326 * MiB;
constexpr size_t WS_XG = 214 * MiB;
constexpr size_t WS_R2 = 374 * MiB;
constexpr size_t WS_HB = WS_R2, WS_Y = WS_R2 + 32 * MiB, WS_Q = WS_R2 + 64 * MiB, WS_AO = WS_R2 + 96 * MiB, WS_HMB = WS_R2 + 128 * MiB, WS_KB = WS_R2 + 132 * MiB, WS_VT = WS_R2 + 136 * MiB;
constexpr size_t WS_ACT = WS_PB + 80 * MiB;
constexpr size_t WS_X1 = 518 * MiB;
constexpr size_t WS_YB = 582 * MiB;
constexpr size_t WS_SCR = 726 * MiB;
constexpr size_t WS_END = 966 * MiB;

__device__ __forceinline__ unsigned f2bf(float f) { unsigned u = __builtin_bit_cast(unsigned, f); return (u + 0x7fffu + ((u >> 16) & 1u)) >> 16; }
__device__ __forceinline__ float bf2f(unsigned h) { return __builtin_bit_cast(float, h << 16); }
__device__ __forceinline__ unsigned pk2(float lo, float hi) { return f2bf(lo) | (f2bf(hi) << 16); }
__device__ __forceinline__ float wave_sum(float v) {
#pragma unroll
    for (int o = 1; o < 64; o <<= 1) v += __shfl_xor(v, o);
    return v;
}
__device__ __forceinline__ float sigmoidf_(float x) { return 1.f / (1.f + __expf(-x)); }
__device__ __forceinline__ float siluf_(float x) { return x * sigmoidf_(x); }
__device__ __forceinline__ float logsigmoidf_(float z) { return fminf(z, 0.f) - log1pf(__expf(-fabsf(z))); }
__device__ __forceinline__ int gu_rowmap(int n) { return n < 1024 ? (n >> 7) * 256 + (n & 127) : ((n - 1024) >> 7) * 256 + 128 + ((n - 1024) & 127); }
#define LAS __attribute__((address_space(3)))
#define GAS __attribute__((address_space(1)))
typedef short bf16x8 __attribute__((ext_vector_type(8)));
typedef float f32x4 __attribute__((ext_vector_type(4)));
typedef float f32x16 __attribute__((ext_vector_type(16)));
typedef unsigned u32x4 __attribute__((ext_vector_type(4)));
typedef unsigned u32x2 __attribute__((ext_vector_type(2)));
typedef short s16x4 __attribute__((ext_vector_type(4)));
typedef GAS unsigned gu32;
#define RLX_AGENT __ATOMIC_RELAXED, __HIP_MEMORY_SCOPE_AGENT
__device__ __forceinline__ int fresh_lane() { int l; asm volatile("v_mbcnt_lo_u32_b32 %0, -1, 0\n\tv_mbcnt_hi_u32_b32 %0, -1, %0" : "=v"(l)); return l; }
#define LDS_WAIT() asm volatile("s_waitcnt lgkmcnt(0)" ::: "memory")
#define VM_WAIT() asm volatile("s_waitcnt vmcnt(0)" ::: "memory")

#ifndef MOE_FP8
#define MOE_FP8 1
#endif
typedef int i32x8 __attribute__((ext_vector_type(8)));
typedef unsigned u32x8 __attribute__((ext_vector_type(8)));
constexpr float W8S = 64.f, A8S = 4.f, Y8S = 64.f;
__device__ __forceinline__ float clamp8(float x) { return __builtin_amdgcn_fmed3f(x, -448.f, 448.f); }
__device__ __forceinline__ unsigned pk4_fp8(float a, float b, float c, float d) { int w = __builtin_amdgcn_cvt_pk_fp8_f32(clamp8(a), clamp8(b), 0, false); w = __builtin_amdgcn_cvt_pk_fp8_f32(clamp8(c), clamp8(d), w, true); return (unsigned)w; }
namespace pg8 {
constexpr int BM = 256, BK = 64, HALF = 128, HTB = HALF * BK * 2, STAGE_BYTES = 8 * HTB, NXCD = 8, WGM = 8;
constexpr int KK = 1024;
__host__ __device__ __forceinline__ int lds_byte(int r, int c) { const int st = (r >> 4) * 2 + (c >> 5), rr = r & 15, cc = c & 31, ob = rr * 64 + cc * 2; return st * 1024 + (ob ^ (((ob >> 9) & 1) << 5)); }
__host__ __device__ __forceinline__ void stage_rc(int b, int& R, int& C) { const int st = b / 1024, sb = b % 1024, swz = sb ^ (((sb >> 9) & 1) << 5); R = (st >> 1) * 16 + swz / 64; C = (st & 1) * 32 + (swz % 64) / 2; }
__host__ __device__ __forceinline__ int perm32(int rho) { const int n = rho >> 4, i = rho & 15; return 8 * (i >> 2) + 4 * n + (i & 3); }
constexpr size_t TSTEP = (size_t)BM * KK * 2;

struct Unit { const char* A; const char* B; int pm, pn, aux; };

__device__ __forceinline__ void static_tile(int L, int nM, int nN, int& pm, int& pn) {
    const int nwg = nM * nN; int wgid = L; { const int q = nwg / NXCD, r = nwg % NXCD, xcd = wgid % NXCD, off = wgid / NXCD; wgid = (xcd < r ? xcd * (q + 1) : r * (q + 1) + (xcd - r) * q) + off; }
    const int nig = WGM * nN, gid = wgid / nig, fm = gid * WGM, gsz = (nM - fm) < WGM ? (nM - fm) : WGM;
    pm = fm + ((wgid % nig) % gsz); pn = (wgid % nig) / gsz;
}
struct SchedDense {
    const char* A; const char* B; int nM, nN, G, c;
    __device__ __forceinline__ bool next(int i, Unit& u) const { const int L = i * G + c; if (L >= nM * nN) return false; static_tile(L, nM, nN, u.pm, u.pn); u.A = A + (size_t)u.pm * TSTEP; u.B = B + (size_t)u.pn * TSTEP; u.aux = 0; return true; }
};
struct SchedP1 {
    const char* HB; const char* WT_IN; const char* HMB; const char* WT_XKV; int G, c;
    __device__ __forceinline__ bool next(int i, Unit& u) const {
        const int L = i * G + c;
        if (L < 960) { static_tile(L, 64, 15, u.pm, u.pn); u.A = HB + (size_t)u.pm * TSTEP; u.B = WT_IN + (size_t)u.pn * TSTEP; u.aux = 0; return true; }
        if (L < 992) { const int j = L - 960; u.pm = j >> 2; u.pn = j & 3; u.A = HMB + (size_t)u.pm * TSTEP; u.B = WT_XKV + (size_t)u.pn * TSTEP; u.aux = 1; return true; }
        if (L < 1024) { const int j = L - 992; u.pm = j >> 3; u.pn = j & 7; u.A = WT_XKV + (size_t)(4 + u.pm) * TSTEP; u.B = HMB + (size_t)u.pn * TSTEP; u.aux = 2; return true; }
        return false;
    }
};
struct SchedMoe {
    const char* A; const char* W; const LAS int* tile_e; int nrt, nct; size_t wstride, tstep; int G, c; const int* rtok; int shift;
    __device__ __forceinline__ bool next(int i, Unit& u) const {
        const int per = G >> 3, pos = (c & 7) * per + (c >> 3), E = i * G + ((pos - shift + G) % G);
        if (E >= nrt * nct) return false;
        int rt, ct;
        if (shift) { const int q = nrt & 31, nfb = nrt >> 5, ne = nfb * (32 - q) * nct;
            if (E < ne) { const int kt = E / nct; ct = E - kt * nct; const int blk = kt / (32 - q); rt = 32 * blk + q + (kt - blk * (32 - q)); }
            else { const int E2 = E - ne, kt = E2 / nct; ct = E2 - kt * nct; const int blk = kt / q; rt = 32 * blk + (kt - blk * q); } }
        else { rt = E / nct; ct = E - rt * nct; }
        const int e = tile_e[rt];
        u.pm = rt; u.pn = ct; u.aux = e; u.A = rtok ? A : A + (size_t)rt * tstep; u.B = W + (size_t)e * wstride + (size_t)ct * tstep; return true;
    }
};

__device__ __forceinline__ unsigned cvt_pk_bf16(float lo, float hi) { unsigned r; asm volatile("v_cvt_pk_bf16_f32 %0, %1, %2" : "=v"(r) : "v"(lo), "v"(hi)); return r; }
__device__ __forceinline__ float fast_sigmoid(float x) { return __builtin_amdgcn_rcpf(1.f + __expf(-x)); }
__device__ __forceinline__ f32x4 silu4(f32x4 v) { f32x4 o; o[0] = v[0] * fast_sigmoid(v[0]); o[1] = v[1] * fast_sigmoid(v[1]); o[2] = v[2] * fast_sigmoid(v[2]); o[3] = v[3] * fast_sigmoid(v[3]); return o; }
typedef _Float16 h16x2 __attribute__((ext_vector_type(2)));
__device__ __forceinline__ unsigned pkh2(float a, float b) { const h16x2 h = {(_Float16)a, (_Float16)b}; return __builtin_bit_cast(unsigned, h); }
__device__ __forceinline__ u32x4 pack8h(f32x4 a, f32x4 b) { u32x4 w; w.x = pkh2(a[0], a[1]); w.y = pkh2(a[2], a[3]); w.z = pkh2(b[0], b[1]); w.w = pkh2(b[2], b[3]); return w; }
__device__ __forceinline__ u32x4 pack8(f32x4 a, f32x4 b) { u32x4 w; w.x = cvt_pk_bf16(a[0], a[1]); w.y = cvt_pk_bf16(a[2], a[3]); w.z = cvt_pk_bf16(b[0], b[1]); w.w = cvt_pk_bf16(b[2], b[3]); return w; }

#define EPI_ROWS(...) _Pragma("unroll") for (int ai = 0; ai < 2; ++ai) _Pragma("unroll") for (int m = 0; m < 4; ++m) { const int row = row0 + ai * HALF + m * 16; _Pragma("unroll") for (int bj = 0; bj < 2; ++bj) { const f32x4 v0 = acc[ai][bj][m][0], v1 = acc[ai][bj][m][1]; __VA_ARGS__ } }

__device__ __forceinline__ void st16_wt(void* p, u32x4 v) { asm volatile("global_store_dwordx4 %0, %1, off sc1\n\ts_nop 1" :: "v"(p), "v"(v) : "memory"); }
#ifndef WT_STORES
#define WT_STORES 1
#endif
template <int W> __device__ __forceinline__ void st16(void* p, u32x4 v) { if (W) st16_wt(p, v); else *(u32x4*)p = v; }
#ifndef WT3
#define WT3 0
#endif
#ifndef WT7
#define WT7 0
#endif
#ifndef WT11
#define WT11 0
#endif
struct EpiP1 {
    bf16* PB; _Float16* G; bf16* KB; bf16* VT; const float* LB; const float* b_gk;
    template <int TY> __device__ __forceinline__ void tile(const f32x4 (&acc)[2][2][4][2], const Unit& u, int row0, int cl) const {
        f32x4 p0[2], p1[2];
#pragma unroll
        for (int bj = 0; bj < 2; ++bj) { const int c = u.pn * 256 + bj * HALF + cl;
            if (TY == 3) { p0[bj] = *(const f32x4*)(LB + (c - C_HF)); p1[bj] = *(const f32x4*)(LB + (c - C_HF) + 4); }
            else if (TY == 4) { p0[bj] = *(const f32x4*)(b_gk + (c - C_GLR)); p1[bj] = *(const f32x4*)(b_gk + (c - C_GLR) + 4); }
            else { p0[bj] = (f32x4){0.f, 0.f, 0.f, 0.f}; p1[bj] = p0[bj]; } }
        EPI_ROWS({
            const int c = u.pn * 256 + bj * HALF + cl;
            if (TY == 0) *(u32x4*)(PB + (size_t)row * PBW + c) = pack8(v0, v1);
            else if (TY == 1) *(u32x4*)(PB + (size_t)row * PBW + c) = pack8(silu4(v0), silu4(v1));
            else if (TY == 2) *(u32x4*)(PB + (size_t)row * PBW + c) = pack8(v0 * 0.125f, v1 * 0.125f);
            else if (TY == 3) { f32x4 f0, f1, k0, k1, g0, g1;
_Pragma("unroll")
                for (int j = 0; j < 4; ++j) { f0[j] = p0[bj][j] + (1.f - p0[bj][j]) * fast_sigmoid(v0[j]); f1[j] = p1[bj][j] + (1.f - p1[bj][j]) * fast_sigmoid(v1[j]);
                    k0[j] = 1.f - f0[j]; k1[j] = 1.f - f1[j]; g0[j] = __logf(f0[j]); g1[j] = __logf(f1[j]); }
                *(u32x4*)(PB + (size_t)row * PBW + c) = pack8(k0, k1);
                *(u32x4*)(G + (size_t)row * GW + (c - C_HF)) = pack8h(g0, g1); }
            else { f32x4 g0, g1;
_Pragma("unroll")
                for (int j = 0; j < 4; ++j) { const float z0 = v0[j] + p0[bj][j], z1 = v1[j] + p1[bj][j];
                    g0[j] = (fminf(z0, 0.f) - __logf(1.f + __expf(-fabsf(z0)))) * 0.0625f; g1[j] = (fminf(z1, 0.f) - __logf(1.f + __expf(-fabsf(z1)))) * 0.0625f; }
                *(u32x4*)(G + (size_t)row * GW + 512 + (c - C_GLR)) = pack8h(g0, g1); }
        })
    }
    __device__ __forceinline__ void operator()(const f32x4 (&acc)[2][2][4][2], const Unit& u, int wr, int wc, int fr, int fq) const {
        const int row0 = u.pm * BM + wr * 64 + fr, cl = wc * 32 + 8 * fq;
        if (u.aux == 0) {
            const int pn = u.pn;
            if (pn == 2 || pn == 3) tile<3>(acc, u, row0, cl);
            else if (pn == 14) tile<4>(acc, u, row0, cl);
            else if (pn == 8) tile<2>(acc, u, row0, cl);
            else if (pn < 2 || pn == 6 || pn == 7 || pn == 12 || pn == 13) tile<1>(acc, u, row0, cl);
            else tile<0>(acc, u, row0, cl);
        } else if (u.aux == 1) {
            EPI_ROWS({ *(u32x4*)(KB + (size_t)row * D + u.pn * 256 + bj * HALF + cl) = pack8(v0, v1); })
        } else {
            EPI_ROWS({ *(u32x4*)(VT + (size_t)row * NMEM + u.pn * 256 + bj * HALF + cl) = pack8(v0, v1); })
        }
    }
};
struct EpiRes1 {
    const float* R; bf16* XB; float* SSQ;
    __device__ __forceinline__ void operator()(const f32x4 (&acc)[2][2][4][2], const Unit& u, int wr, int wc, int fr, int fq) const {
        const int row0 = u.pm * BM + wr * 64 + fr, cl = wc * 32 + 8 * fq;
#pragma unroll
        for (int ai = 0; ai < 2; ++ai)
#pragma unroll
            for (int m = 0; m < 4; ++m) { const int row = row0 + ai * HALF + m * 16; const size_t off = (size_t)row * D + u.pn * 256 + cl;
                f32x4 r[2][2]; float ss = 0.f;
#pragma unroll
                for (int bj = 0; bj < 2; ++bj) { r[bj][0] = *(const f32x4*)(R + off + bj * HALF); r[bj][1] = *(const f32x4*)(R + off + bj * HALF + 4); }
#pragma unroll
                for (int bj = 0; bj < 2; ++bj) { const f32x4 c0 = r[bj][0] + acc[ai][bj][m][0], c1 = r[bj][1] + acc[ai][bj][m][1];
                    st16<WT3>(XB + off + bj * HALF, pack8(c0, c1));
                    ss += ((c0[0] * c0[0] + c0[1] * c0[1]) + (c0[2] * c0[2] + c0[3] * c0[3])) + ((c1[0] * c1[0] + c1[1] * c1[1]) + (c1[2] * c1[2] + c1[3] * c1[3])); }
                ss += __shfl_xor(ss, 16); ss += __shfl_xor(ss, 32);
                if (fq == 0) SSQ[(size_t)row * 16 + u.pn * 4 + wc] = ss;
                if (m & 1) asm volatile("" ::: "memory"); }
    }
};
struct EpiRes2 {
    bf16* XB; unsigned char* X8;
    __device__ __forceinline__ void operator()(const f32x4 (&acc)[2][2][4][2], const Unit& u, int wr, int wc, int fr, int fq) const {
        const int row0 = u.pm * BM + wr * 64 + fr, cl = wc * 32 + 8 * fq;
#pragma unroll
        for (int ai = 0; ai < 2; ++ai)
#pragma unroll
            for (int mp = 0; mp < 4; mp += 2) {
                u32x4 r[2][2]; u32x2 w8[2][2];
#pragma unroll
                for (int q = 0; q < 2; ++q)
#pragma unroll
                    for (int bj = 0; bj < 2; ++bj) r[q][bj] = *(const u32x4*)(XB + (size_t)(row0 + ai * HALF + (mp + q) * 16) * D + u.pn * 256 + cl + bj * HALF);
#pragma unroll
                for (int q = 0; q < 2; ++q) { const int m = mp + q; const size_t off = (size_t)(row0 + ai * HALF + m * 16) * D + u.pn * 256 + cl;
#pragma unroll
                    for (int bj = 0; bj < 2; ++bj) { const f32x4 c0 = (f32x4){bf2f(r[q][bj].x & 0xffffu), bf2f(r[q][bj].x >> 16), bf2f(r[q][bj].y & 0xffffu), bf2f(r[q][bj].y >> 16)} + acc[ai][bj][m][0],
                                                                  c1 = (f32x4){bf2f(r[q][bj].z & 0xffffu), bf2f(r[q][bj].z >> 16), bf2f(r[q][bj].w & 0xffffu), bf2f(r[q][bj].w >> 16)} + acc[ai][bj][m][1];
                        st16<WT7>(XB + off + bj * HALF, pack8(c0, c1));
                        w8[q][bj].x = pk4_fp8(c0[0], c0[1], c0[2], c0[3]); w8[q][bj].y = pk4_fp8(c1[0], c1[1], c1[2], c1[3]); } }
                if (X8) {
#pragma unroll
                    for (int bj = 0; bj < 2; ++bj) { const u32x2 rx = __builtin_amdgcn_permlane16_swap(w8[0][bj].x, w8[1][bj].x, false, false), ry = __builtin_amdgcn_permlane16_swap(w8[0][bj].y, w8[1][bj].y, false, false);
                        st16<WT7>(X8 + (size_t)(row0 + ai * HALF + (mp + (fq & 1)) * 16) * D + u.pn * 256 + bj * HALF + cl - 8 * (fq & 1), (u32x4){rx.x, ry.x, rx.y, ry.y}); } }
                asm volatile("" ::: "memory"); }
    }
};
__device__ __forceinline__ float row_rstd16(const float* SSQ, int row, int fq) {
    const f32x4 p = *(const f32x4*)(SSQ + (size_t)row * 16 + 4 * fq); float t = (p[0] + p[1]) + (p[2] + p[3]); t += __shfl_xor(t, 16); t += __shfl_xor(t, 32);
    return rsqrtf(t * (1.f / D) + EPS);
}
struct EpiBf16S {
    bf16* O; float scale; const float* SSQ;
    __device__ __forceinline__ void operator()(const f32x4 (&acc)[2][2][4][2], const Unit& u, int wr, int wc, int fr, int fq) const {
        const int row0 = u.pm * BM + wr * 64 + fr, cl = wc * 32 + 8 * fq;
        float scv[2][4];
#pragma unroll
        for (int ai = 0; ai < 2; ++ai)
#pragma unroll
            for (int m = 0; m < 4; ++m) scv[ai][m] = row_rstd16(SSQ, row0 + ai * HALF + m * 16, fq) * scale;
#pragma unroll
        for (int ai = 0; ai < 2; ++ai)
#pragma unroll
            for (int m = 0; m < 4; ++m) { const int row = row0 + ai * HALF + m * 16; const float sc = scv[ai][m];
#pragma unroll
                for (int bj = 0; bj < 2; ++bj) *(u32x4*)(O + (size_t)row * D + u.pn * 256 + bj * HALF + cl) = pack8(acc[ai][bj][m][0] * sc, acc[ai][bj][m][1] * sc); }
    }
};
typedef float f32x2 __attribute__((ext_vector_type(2)));
struct EpiMoe1 {
    void* ACT; const float* bgu; const float* row_rstd; unsigned* rdy;
    static __device__ __forceinline__ f32x2 act2(f32x2 ag, f32x2 au, f32x2 rs, f32x2 bg, f32x2 bu) {
        constexpr float OS = MOE_FP8 ? A8S : 1.f, C2 = -1.702f * 1.4426950408889634f;
        f32x2 g = ag * rs + bg, u = au * rs + bu;
        g.x = fminf(g.x, 7.f); g.y = fminf(g.y, 7.f); u.x = __builtin_amdgcn_fmed3f(u.x, -7.f, 7.f); u.y = __builtin_amdgcn_fmed3f(u.y, -7.f, 7.f);
        const f32x2 t = g * C2; f32x2 e; e.x = __builtin_amdgcn_exp2f(t.x); e.y = __builtin_amdgcn_exp2f(t.y);
        const f32x2 d = e + 1.f; f32x2 r; r.x = __builtin_amdgcn_rcpf(d.x); r.y = __builtin_amdgcn_rcpf(d.y);
        return (u * OS + OS) * (g * r);
    }
    __device__ __forceinline__ void operator()(const f32x4 (&acc)[2][2][4][2], const Unit& u, int wr, int wc, int fr, int fq) const { run<false>(acc, u, wr, wc, fr, fq, -1); }
    __device__ __forceinline__ const float* pre(const Unit& u, int idx) const { return idx < 256 ? bgu + (size_t)u.aux * 2048 + (idx >> 7) * 1024 + u.pn * HALF + (idx & 127) : row_rstd + u.pm * BM + (idx - 256); }
    __device__ __forceinline__ void run_pre0(const f32x4 (&acc)[2][2][4][2], const Unit& u, int wr, int wc, int fr, int fq, const LAS float* eb) const { run_pre<false>(acc, u, wr, wc, fr, fq, -1, eb); }
    template <bool PUB>
    __device__ __forceinline__ void run_pre(const f32x4 (&acc)[2][2][4][2], const Unit& u, int wr, int wc, int fr, int fq, int prev_pm, const LAS float* eb) const {
        int upm = __builtin_amdgcn_readfirstlane(u.pm), upn = __builtin_amdgcn_readfirstlane(u.pn); asm volatile("" : "+s"(upm), "+s"(upn));
        const int rl = wr * 64 + fr, row0 = upm * BM + rl, cl = wc * 32 + 8 * fq, c = upn * HALF + cl;
        const f32x4 bg0 = *(const LAS f32x4*)(eb + cl), bg1 = *(const LAS f32x4*)(eb + cl + 4), bu0 = *(const LAS f32x4*)(eb + 128 + cl), bu1 = *(const LAS f32x4*)(eb + 128 + cl + 4);
        float rsv[2][4];
#pragma unroll
        for (int ai = 0; ai < 2; ++ai)
#pragma unroll
            for (int m = 0; m < 4; ++m) rsv[ai][m] = eb[256 + rl + ai * HALF + m * 16] * (1.f / W8S);
        u32x4 o[2][2];
#pragma unroll
        for (int ai = 0; ai < 2; ++ai)
#pragma unroll
            for (int mp = 0; mp < 4; mp += 2) { u32x2 wq[2];
#pragma unroll
                for (int q = 0; q < 2; ++q) { const int m = mp + q; const f32x2 rs = {rsv[ai][m], rsv[ai][m]};
                    const f32x4 g0 = acc[ai][0][m][0], g1 = acc[ai][0][m][1], u0 = acc[ai][1][m][0], u1 = acc[ai][1][m][1];
                    const f32x2 a = act2((f32x2){g0[0], g0[1]}, (f32x2){u0[0], u0[1]}, rs, (f32x2){bg0[0], bg0[1]}, (f32x2){bu0[0], bu0[1]}), b2 = act2((f32x2){g0[2], g0[3]}, (f32x2){u0[2], u0[3]}, rs, (f32x2){bg0[2], bg0[3]}, (f32x2){bu0[2], bu0[3]});
                    const f32x2 c2 = act2((f32x2){g1[0], g1[1]}, (f32x2){u1[0], u1[1]}, rs, (f32x2){bg1[0], bg1[1]}, (f32x2){bu1[0], bu1[1]}), d2 = act2((f32x2){g1[2], g1[3]}, (f32x2){u1[2], u1[3]}, rs, (f32x2){bg1[2], bg1[3]}, (f32x2){bu1[2], bu1[3]});
                    int w0 = __builtin_amdgcn_cvt_pk_fp8_f32(a.x, a.y, 0, false); w0 = __builtin_amdgcn_cvt_pk_fp8_f32(b2.x, b2.y, w0, true);
                    int w1 = __builtin_amdgcn_cvt_pk_fp8_f32(c2.x, c2.y, 0, false); w1 = __builtin_amdgcn_cvt_pk_fp8_f32(d2.x, d2.y, w1, true); wq[q].x = (unsigned)w0; wq[q].y = (unsigned)w1; }
                const u32x2 rx = __builtin_amdgcn_permlane16_swap(wq[0].x, wq[1].x, false, false), ry = __builtin_amdgcn_permlane16_swap(wq[0].y, wq[1].y, false, false);
                o[ai][mp >> 1] = (u32x4){rx.x, ry.x, rx.y, ry.y}; }
        if constexpr (PUB) {
            asm volatile("s_waitcnt vmcnt(0)" : "+v"(o[0][0]), "+v"(o[0][1]), "+v"(o[1][0]), "+v"(o[1][1]) :: "memory");
            if (prev_pm >= 0 && fr == 0 && fq == 0) (void)__hip_atomic_fetch_add(rdy + 64 * prev_pm, 1u, __ATOMIC_RELAXED, __HIP_MEMORY_SCOPE_AGENT);
        }
#pragma unroll
        for (int ai = 0; ai < 2; ++ai)
#pragma unroll
            for (int h = 0; h < 2; ++h) { unsigned char* dst = (unsigned char*)ACT + (size_t)(row0 + ai * HALF + (2 * h + (fq & 1)) * 16) * D + (c - 8 * (fq & 1));
                if constexpr (PUB) asm volatile("global_store_dwordx4 %0, %1, off sc1\n\ts_nop 1" :: "v"(dst), "v"(o[ai][h]) : "memory");
                else *(u32x4*)dst = o[ai][h]; }
    }
    template <bool PUB>
    __device__ __forceinline__ void run(const f32x4 (&acc)[2][2][4][2], const Unit& u, int wr, int wc, int fr, int fq, int prev_pm) const {
        int upm = __builtin_amdgcn_readfirstlane(u.pm), upn = __builtin_amdgcn_readfirstlane(u.pn), uaux = __builtin_amdgcn_readfirstlane(u.aux); asm volatile("" : "+s"(upm), "+s"(upn), "+s"(uaux));
        const int row0 = upm * BM + wr * 64 + fr, cl = wc * 32 + 8 * fq, c = upn * HALF + cl;
        const float* bb = bgu + (size_t)uaux * 2048 + c;
        const f32x4 bg0 = *(const f32x4*)bb, bg1 = *(const f32x4*)(bb + 4), bu0 = *(const f32x4*)(bb + 1024), bu1 = *(const f32x4*)(bb + 1028);
        float rsv[2][4];
#pragma unroll
        for (int ai = 0; ai < 2; ++ai)
#pragma unroll
            for (int m = 0; m < 4; ++m) rsv[ai][m] = row_rstd[row0 + ai * HALF + m * 16] * (MOE_FP8 ? 1.f / W8S : 1.f);
        if constexpr (PUB) {
            asm volatile("s_waitcnt vmcnt(0)" :: "v"(bg0), "v"(bg1), "v"(bu0), "v"(bu1), "v"(rsv[0][0]), "v"(rsv[0][1]), "v"(rsv[0][2]), "v"(rsv[0][3]), "v"(rsv[1][0]), "v"(rsv[1][1]), "v"(rsv[1][2]), "v"(rsv[1][3]) : "memory");
            if (prev_pm >= 0 && fr == 0 && fq == 0) (void)__hip_atomic_fetch_add(rdy + 64 * prev_pm, 1u, __ATOMIC_RELAXED, __HIP_MEMORY_SCOPE_AGENT);
        }
#pragma unroll
        for (int ai = 0; ai < 2; ++ai)
#pragma unroll
            for (int mp = 0; mp < 4; mp += 2) { u32x2 wq[2];
#pragma unroll
                for (int q = 0; q < 2; ++q) { const int m = mp + q; const f32x2 rs = {rsv[ai][m], rsv[ai][m]};
                    const f32x4 g0 = acc[ai][0][m][0], g1 = acc[ai][0][m][1], u0 = acc[ai][1][m][0], u1 = acc[ai][1][m][1];
                    const f32x2 a = act2((f32x2){g0[0], g0[1]}, (f32x2){u0[0], u0[1]}, rs, (f32x2){bg0[0], bg0[1]}, (f32x2){bu0[0], bu0[1]}), b2 = act2((f32x2){g0[2], g0[3]}, (f32x2){u0[2], u0[3]}, rs, (f32x2){bg0[2], bg0[3]}, (f32x2){bu0[2], bu0[3]});
                    const f32x2 c2 = act2((f32x2){g1[0], g1[1]}, (f32x2){u1[0], u1[1]}, rs, (f32x2){bg1[0], bg1[1]}, (f32x2){bu1[0], bu1[1]}), d2 = act2((f32x2){g1[2], g1[3]}, (f32x2){u1[2], u1[3]}, rs, (f32x2){bg1[2], bg1[3]}, (f32x2){bu1[2], bu1[3]});
                    if (MOE_FP8) { int w0 = __builtin_amdgcn_cvt_pk_fp8_f32(a.x, a.y, 0, false); w0 = __builtin_amdgcn_cvt_pk_fp8_f32(b2.x, b2.y, w0, true);
                        int w1 = __builtin_amdgcn_cvt_pk_fp8_f32(c2.x, c2.y, 0, false); w1 = __builtin_amdgcn_cvt_pk_fp8_f32(d2.x, d2.y, w1, true); wq[q].x = (unsigned)w0; wq[q].y = (unsigned)w1;
                        if constexpr (!PUB) *(u32x2*)((unsigned char*)ACT + (size_t)(row0 + ai * HALF + m * 16) * D + c) = wq[q]; }
                    else *(u32x4*)((bf16*)ACT + (size_t)(row0 + ai * HALF + m * 16) * D + c) = pack8((f32x4){a.x, a.y, b2.x, b2.y}, (f32x4){c2.x, c2.y, d2.x, d2.y}); }
                if constexpr (PUB && MOE_FP8) {
                    const u32x2 rx = __builtin_amdgcn_permlane16_swap(wq[0].x, wq[1].x, false, false), ry = __builtin_amdgcn_permlane16_swap(wq[0].y, wq[1].y, false, false);
                    const u32x4 o = {rx.x, ry.x, rx.y, ry.y};
                    unsigned char* dst = (unsigned char*)ACT + (size_t)(row0 + ai * HALF + (mp + (fq & 1)) * 16) * D + (c - 8 * (fq & 1));
                    asm volatile("global_store_dwordx4 %0, %1, off sc1\n\ts_nop 1" :: "v"(dst), "v"(o) : "memory"); } }
    }
};
struct EpiMoe2 {
    void* YB; const float* bd; const float* row_gate;
    __device__ __forceinline__ const float* pre(const Unit& u, int idx) const { return idx < 256 ? bd + (size_t)u.aux * D + u.pn * 256 + idx : row_gate + u.pm * BM + (idx - 256); }
    __device__ __forceinline__ void run_pre0(const f32x4 (&acc)[2][2][4][2], const Unit& u, int wr, int wc, int fr, int fq, const LAS float* eb) const {
        int upm = __builtin_amdgcn_readfirstlane(u.pm), upn = __builtin_amdgcn_readfirstlane(u.pn); asm volatile("" : "+s"(upm), "+s"(upn));
        const int rl = wr * 64 + fr, row0 = upm * BM + rl, cl = wc * 32 + 8 * fq;
        constexpr float ASC = 1.f / (W8S * A8S);
        f32x4 b0[2], b1[2];
#pragma unroll
        for (int bj = 0; bj < 2; ++bj) { b0[bj] = *(const LAS f32x4*)(eb + bj * HALF + cl); b1[bj] = *(const LAS f32x4*)(eb + bj * HALF + cl + 4); }
        float gv[2][4];
#pragma unroll
        for (int ai = 0; ai < 2; ++ai)
#pragma unroll
            for (int m = 0; m < 4; ++m) gv[ai][m] = eb[256 + rl + ai * HALF + m * 16] * Y8S;
#pragma unroll
        for (int ai = 0; ai < 2; ++ai)
#pragma unroll
            for (int mp = 0; mp < 4; mp += 2)
#pragma unroll
                for (int bj = 0; bj < 2; ++bj) { u32x2 wq[2];
#pragma unroll
                    for (int q = 0; q < 2; ++q) { const int m = mp + q; const float g = gv[ai][m];
                        const f32x4 y0 = (acc[ai][bj][m][0] * ASC + b0[bj]) * g, y1 = (acc[ai][bj][m][1] * ASC + b1[bj]) * g;
                        wq[q].x = pk4_fp8(y0[0], y0[1], y0[2], y0[3]); wq[q].y = pk4_fp8(y1[0], y1[1], y1[2], y1[3]); }
                    const u32x2 rx = __builtin_amdgcn_permlane16_swap(wq[0].x, wq[1].x, false, false), ry = __builtin_amdgcn_permlane16_swap(wq[0].y, wq[1].y, false, false);
                    st16<WT11>((unsigned char*)YB + (size_t)(row0 + ai * HALF + (mp + (fq & 1)) * 16) * D + upn * 256 + bj * HALF + cl - 8 * (fq & 1), (u32x4){rx.x, ry.x, rx.y, ry.y}); }
    }
    __device__ __forceinline__ void operator()(const f32x4 (&acc)[2][2][4][2], const Unit& u, int wr, int wc, int fr, int fq) const {
        int upm = __builtin_amdgcn_readfirstlane(u.pm), upn = __builtin_amdgcn_readfirstlane(u.pn), uaux = __builtin_amdgcn_readfirstlane(u.aux); asm volatile("" : "+s"(upm), "+s"(upn), "+s"(uaux));
        const int row0 = upm * BM + wr * 64 + fr, cl = wc * 32 + 8 * fq;
        constexpr float ASC = MOE_FP8 ? 1.f / (W8S * A8S) : 1.f;
        f32x4 b0[2], b1[2];
#pragma unroll
        for (int bj = 0; bj < 2; ++bj) { const float* bb = bd + (size_t)uaux * D + upn * 256 + bj * HALF + cl; b0[bj] = *(const f32x4*)bb; b1[bj] = *(const f32x4*)(bb + 4); }
        float gv[2][4];
#pragma unroll
        for (int ai = 0; ai < 2; ++ai)
#pragma unroll
            for (int m = 0; m < 4; ++m) gv[ai][m] = row_gate[row0 + ai * HALF + m * 16] * (MOE_FP8 ? Y8S : 1.f);
#pragma unroll
        for (int ai = 0; ai < 2; ++ai)
#pragma unroll
            for (int m = 0; m < 4; ++m) { const int row = row0 + ai * HALF + m * 16; const float g = gv[ai][m];
#pragma unroll
                for (int bj = 0; bj < 2; ++bj) { const f32x4 y0 = (acc[ai][bj][m][0] * ASC + b0[bj]) * g, y1 = (acc[ai][bj][m][1] * ASC + b1[bj]) * g;
                    if (MOE_FP8) { u32x2 w; w.x = pk4_fp8(y0[0], y0[1], y0[2], y0[3]); w.y = pk4_fp8(y1[0], y1[1], y1[2], y1[3]); *(u32x2*)((unsigned char*)YB + (size_t)row * D + upn * 256 + bj * HALF + cl) = w; }
                    else *(u32x4*)((bf16*)YB + (size_t)row * D + upn * 256 + bj * HALF + cl) = pack8(y0, y1); } }
    }
};


template <class Epi, class Sched>
__device__ __forceinline__ void gemm_phase(LAS unsigned char* lds, const Sched& S, const Epi& E, const int tid, const int wid) {
    const int wr = wid >> 2, wc = wid & 3, lane = tid & 63, fr = lane & 15, fq = lane >> 4;
    constexpr int K = KK, nt = K / BK;
    unsigned voffA[2], voffB[2];
#pragma unroll
    for (int i = 0; i < 2; ++i) { int R, C; stage_rc(tid * 16 + i * 8192, R, C); const int Rb = (R & ~31) + perm32(R & 31);
        voffA[i] = (unsigned)(R * K + C) * 2u; voffB[i] = (unsigned)(Rb * K + C) * 2u; }
    constexpr size_t kstep = (size_t)(BK * 2), hstep = (size_t)HALF * K * 2;
    const unsigned ldsw = (unsigned)wid * 1024u;
    const int aoff = lds_byte(wr * 64 + fr, fq * 8), boff = lds_byte(wc * 32 + fr, fq * 8);
#define PG8_SA(b, h) (((b) * 2 + (h)) * HTB)
#define PG8_SB(b, h) ((4 + (b) * 2 + (h)) * HTB)
#define PG8_STAGE(bufoff, gbase, voff) do { _Pragma("unroll") for (int _i = 0; _i < 2; ++_i) \
        __builtin_amdgcn_global_load_lds((const unsigned*)((const char*)(gbase) + (voff)[_i]), (LAS unsigned*)(lds + (bufoff) + ldsw + _i * 8192), 16, 0, 0); } while (0)
#define PG8_LDA(dst, b, h) do { _Pragma("unroll") for (int m = 0; m < 4; ++m) _Pragma("unroll") for (int k = 0; k < 2; ++k) dst[m][k] = *(const LAS bf16x8*)(lds + PG8_SA(b, h) + aoff + m * 2048 + k * 1024); } while (0)
#define PG8_LDB(dst, b, h) do { _Pragma("unroll") for (int n = 0; n < 2; ++n) _Pragma("unroll") for (int k = 0; k < 2; ++k) dst[n][k] = *(const LAS bf16x8*)(lds + PG8_SB(b, h) + boff + n * 2048 + k * 1024); } while (0)
#define PG8_MMA(ai, bj, At, Bt) do { __builtin_amdgcn_s_setprio(1); _Pragma("unroll") for (int m = 0; m < 4; ++m) _Pragma("unroll") for (int n = 0; n < 2; ++n) _Pragma("unroll") for (int k = 0; k < 2; ++k) \
        acc[ai][bj][m][n] = __builtin_amdgcn_mfma_f32_16x16x32_bf16(Bt[n][k], At[m][k], acc[ai][bj][m][n], 0, 0, 0); __builtin_amdgcn_s_setprio(0); } while (0)
#define PG8_WAIT_V(n) asm volatile("s_waitcnt vmcnt(" #n ")" ::: "memory")
#define PG8_WAIT_L(n) asm volatile("s_waitcnt lgkmcnt(" #n ")" ::: "memory")
#define PG8_BAR __builtin_amdgcn_s_barrier()
#define PG8_SCHED __builtin_amdgcn_sched_barrier(0)
    Unit cur, nxt; int ui = 0;
    if (!S.next(0, cur)) return;
    f32x4 acc[2][2][4][2];
#pragma unroll
    for (int a = 0; a < 2; ++a)
#pragma unroll
        for (int b = 0; b < 2; ++b)
#pragma unroll
            for (int m = 0; m < 4; ++m)
#pragma unroll
                for (int n = 0; n < 2; ++n) acc[a][b][m][n] = (f32x4){0.f, 0.f, 0.f, 0.f};
    bf16x8 At[4][2], B0[2][2], B1[2][2];
    const char* cA = cur.A; const char* cB = cur.B;
    PG8_STAGE(PG8_SB(0, 0), cB, voffB); PG8_STAGE(PG8_SB(0, 1), cB + hstep, voffB); PG8_STAGE(PG8_SA(0, 0), cA, voffA); PG8_STAGE(PG8_SA(0, 1), cA + hstep, voffA);
    if (wr == 1) PG8_BAR;
    PG8_WAIT_V(2); PG8_BAR;
    PG8_STAGE(PG8_SB(1, 0), cB + kstep, voffB); PG8_STAGE(PG8_SA(1, 0), cA + kstep, voffA); PG8_STAGE(PG8_SB(1, 1), cB + hstep + kstep, voffB);
    PG8_WAIT_V(6); PG8_BAR;
    for (;;) {
        const bool has_next = S.next(ui + 1, nxt);
        const char* nA = has_next ? nxt.A : cA; const char* nB = has_next ? nxt.B : cB;
        for (int t = 0; t < nt; t += 2) {
            const bool last = (t == nt - 2);
            const char* a1 = cA + (size_t)(t + 1) * kstep;
            const char* a2 = last ? nA : cA + (size_t)(t + 2) * kstep; const char* b2 = last ? nB : cB + (size_t)(t + 2) * kstep;
            const char* a3 = a2 + kstep; const char* b3 = b2 + kstep;
            PG8_LDB(B0, 0, 0); PG8_LDB(B1, 0, 1); PG8_SCHED; PG8_LDA(At, 0, 0); PG8_STAGE(PG8_SA(1, 1), a1 + hstep, voffA);
            PG8_WAIT_V(8); PG8_WAIT_L(0); PG8_BAR; PG8_MMA(0, 0, At, B0); PG8_MMA(0, 1, At, B1); PG8_BAR; PG8_SCHED;
            PG8_LDA(At, 0, 1); PG8_STAGE(PG8_SB(0, 0), b2, voffB); PG8_STAGE(PG8_SB(0, 1), b2 + hstep, voffB); PG8_STAGE(PG8_SA(0, 0), a2, voffA);
            PG8_WAIT_V(8); PG8_WAIT_L(0); PG8_BAR; PG8_MMA(1, 0, At, B0); PG8_MMA(1, 1, At, B1); PG8_BAR; PG8_SCHED;
            PG8_LDB(B0, 1, 0); PG8_LDB(B1, 1, 1); PG8_SCHED; PG8_LDA(At, 1, 0); PG8_STAGE(PG8_SA(0, 1), a2 + hstep, voffA);
            PG8_WAIT_V(8); PG8_WAIT_L(0); PG8_BAR; PG8_MMA(0, 0, At, B0); PG8_MMA(0, 1, At, B1); PG8_BAR; PG8_SCHED;
            PG8_LDA(At, 1, 1); PG8_STAGE(PG8_SB(1, 0), b3, voffB); PG8_STAGE(PG8_SB(1, 1), b3 + hstep, voffB); PG8_STAGE(PG8_SA(1, 0), a3, voffA);
            PG8_WAIT_V(8); PG8_WAIT_L(0); PG8_BAR; PG8_MMA(1, 0, At, B0); PG8_MMA(1, 1, At, B1); PG8_BAR; PG8_SCHED;
        }
        if (wr == 0) PG8_BAR;
        E(acc, cur, wr, wc, fr, fq);
        if (!has_next) break;
#pragma unroll
        for (int a = 0; a < 2; ++a)
#pragma unroll
            for (int b = 0; b < 2; ++b)
#pragma unroll
                for (int m = 0; m < 4; ++m)
#pragma unroll
                    for (int n = 0; n < 2; ++n) acc[a][b][m][n] = (f32x4){0.f, 0.f, 0.f, 0.f};
        cur = nxt; cA = nA; cB = nB; ++ui;
        if (wr == 1) PG8_BAR;
    }
    PG8_WAIT_V(0);
    PG8_BAR;
#undef PG8_SA
#undef PG8_SB
#undef PG8_STAGE
#undef PG8_LDA
#undef PG8_LDB
#undef PG8_MMA
#undef PG8_WAIT_V
#undef PG8_WAIT_L
#undef PG8_BAR
#undef PG8_SCHED
}
#ifndef HANDOFF
#define HANDOFF 0
#endif
constexpr unsigned RDY_NEED = HANDOFF == 2 ? 8u : 64u, RDY_SPIN_CAP = 1u << 22;
__device__ __forceinline__ void rdy_wait(const unsigned* w) { unsigned sp = 0;
    while ((unsigned)__builtin_amdgcn_readfirstlane((int)__hip_atomic_load(w, __ATOMIC_RELAXED, __HIP_MEMORY_SCOPE_AGENT)) < RDY_NEED) { __builtin_amdgcn_s_sleep(2); if (++sp > RDY_SPIN_CAP) break; } }
template <class Epi, class Sched, bool GATHER = false, int MODE = 0, bool PRE = false>
__device__ __forceinline__ void gemm8_phase(LAS unsigned char* lds, const Sched& S, const Epi& E, const int tid, const int wid, unsigned* rdy = nullptr) {
    const int wr = wid >> 2, wc = wid & 3, lane = tid & 63, fr = lane & 15, fq = lane >> 4;
    constexpr int K = KK / 2, nt = K / BK;
    unsigned voffA[2], voffB[2]; int RA[2], CA[2];
#pragma unroll
    for (int i = 0; i < 2; ++i) { int R, C; stage_rc(tid * 16 + i * 8192, R, C); const int Rb = (R & ~31) + perm32(R & 31); RA[i] = R; CA[i] = C;
        voffA[i] = (unsigned)(R * K + C) * 2u; voffB[i] = (unsigned)(Rb * K + C) * 2u; }
    unsigned vA0[2], vA1[2], nA0[2], nA1[2];
    LAS int* lidx = (LAS int*)(lds + STAGE_BYTES);
    constexpr size_t kstep = (size_t)(BK * 2), hstep = (size_t)HALF * K * 2;
    const unsigned ldsw = (unsigned)wid * 1024u;
    const int aoff = lds_byte(wr * 64 + fr, fq * 8), boff = lds_byte(wc * 32 + fr, fq * 8);
#define PG8_SA(b, h) (((b) * 2 + (h)) * HTB)
#define PG8_SB(b, h) ((4 + (b) * 2 + (h)) * HTB)
#define PG8_STAGE(bufoff, gbase, voff) do { _Pragma("unroll") for (int _i = 0; _i < 2; ++_i) \
        __builtin_amdgcn_global_load_lds((const unsigned*)((const char*)(gbase) + (voff)[_i]), (LAS unsigned*)(lds + (bufoff) + ldsw + _i * 8192), 16, 0, 0); } while (0)
#define PG8_LD8(p) __builtin_shufflevector(*(const LAS u32x4*)(p), *(const LAS u32x4*)((p) + 1024), 0, 1, 2, 3, 4, 5, 6, 7)
#define PG8_STAGE_A(bufoff, gbase, h, vg0, vg1) do { if constexpr (GATHER) { if ((h) == 0) PG8_STAGE(bufoff, gbase, vg0); else PG8_STAGE(bufoff, gbase, vg1); } else PG8_STAGE(bufoff, (gbase) + (h) * hstep, voffA); } while (0)
#define PG8_LDA(dst, b, h) do { _Pragma("unroll") for (int m = 0; m < 4; ++m) dst[m] = PG8_LD8(lds + PG8_SA(b, h) + aoff + m * 2048); } while (0)
#define PG8_LDB(dst, b, h) do { _Pragma("unroll") for (int n = 0; n < 2; ++n) dst[n] = PG8_LD8(lds + PG8_SB(b, h) + boff + n * 2048); } while (0)
#define PG8_MMA(ai, bj, At, Bt) do { __builtin_amdgcn_s_setprio(1); _Pragma("unroll") for (int m = 0; m < 4; ++m) _Pragma("unroll") for (int n = 0; n < 2; ++n) \
        asm volatile("v_mfma_f32_16x16x128_f8f6f4 %0, %1, %2, %0" : "+v"(acc[ai][bj][m][n]) : "v"(Bt[n]), "v"(At[m])); __builtin_amdgcn_s_setprio(0); } while (0)
#define PG8_WAIT_V(n) asm volatile("s_waitcnt vmcnt(" #n ")" ::: "memory")
#define PG8_WAIT_L(n) asm volatile("s_waitcnt lgkmcnt(" #n ")" ::: "memory")
#define PG8_BAR __builtin_amdgcn_s_barrier()
#define PG8_SCHED __builtin_amdgcn_sched_barrier(0)
    Unit cur, nxt; int ui = 0;
    if (!S.next(0, cur)) return;
    f32x4 acc[2][2][4][2];
#pragma unroll
    for (int a = 0; a < 2; ++a)
#pragma unroll
        for (int b = 0; b < 2; ++b)
#pragma unroll
            for (int m = 0; m < 4; ++m)
#pragma unroll
                for (int n = 0; n < 2; ++n) acc[a][b][m][n] = (f32x4){0.f, 0.f, 0.f, 0.f};
    u32x8 At[4], B0[2], B1[2];
    const char* cA = cur.A; const char* cB = cur.B;
    int prev_pm = -1; (void)prev_pm;
    LAS float* ebuf = (LAS float*)(lds + STAGE_BYTES + 8192);
#define PG8_PRE(u_, par_) do { if constexpr (PRE) { if (wid >= 4) { _Pragma("unroll") for (int _j = 0; _j < 2; ++_j) \
        __builtin_amdgcn_global_load_lds((const unsigned*)E.pre(u_, _j * 256 + (wid - 4) * 64 + lane), (LAS unsigned*)(ebuf + (par_) * 512 + _j * 256 + (wid - 4) * 64), 4, 0, 0); } } } while (0)
    PG8_PRE(cur, 0);
    if constexpr (MODE == 2) { rdy_wait(rdy + 64 * cur.pm); asm volatile("" ::: "memory"); }
    if constexpr (GATHER) {
#pragma unroll
        for (int i = 0; i < 2; ++i) { const unsigned r0 = (unsigned)S.rtok[cur.pm * 256 + RA[i]], r1 = (unsigned)S.rtok[cur.pm * 256 + HALF + RA[i]];
            vA0[i] = (r0 < (unsigned)NTOK ? r0 : (unsigned)(NTOK - 1)) * (unsigned)(K * 2) + (unsigned)CA[i] * 2u; vA1[i] = (r1 < (unsigned)NTOK ? r1 : (unsigned)(NTOK - 1)) * (unsigned)(K * 2) + (unsigned)CA[i] * 2u; nA0[i] = vA0[i]; nA1[i] = vA1[i]; } }
    PG8_STAGE(PG8_SB(0, 0), cB, voffB); PG8_STAGE(PG8_SB(0, 1), cB + hstep, voffB); PG8_STAGE_A(PG8_SA(0, 0), cA, 0, vA0, vA1); PG8_STAGE_A(PG8_SA(0, 1), cA, 1, vA0, vA1);
    if (wr == 1) PG8_BAR;
    PG8_WAIT_V(2); PG8_BAR;
    PG8_STAGE(PG8_SB(1, 0), cB + kstep, voffB); PG8_STAGE_A(PG8_SA(1, 0), cA + kstep, 0, vA0, vA1); PG8_STAGE(PG8_SB(1, 1), cB + hstep + kstep, voffB);
    PG8_WAIT_V(6); PG8_BAR;
    for (;;) {
        const bool has_next = S.next(ui + 1, nxt);
        const char* nA = has_next ? nxt.A : cA; const char* nB = has_next ? nxt.B : cB;
        if constexpr (MODE == 2) { if (has_next && wid == 0) __builtin_amdgcn_global_load_lds((const unsigned*)(rdy + 64 * nxt.pm), (LAS unsigned*)(lidx + ((ui + 1) & 1) * 256), 4, 0, 16); }
        if constexpr (GATHER) { if (has_next && wid < 4) __builtin_amdgcn_global_load_lds((const unsigned*)(S.rtok + nxt.pm * 256 + 64 * wid + (tid & 63)), (LAS unsigned*)(lidx + ((ui + 1) & 1) * 256 + 64 * wid), 4, 0, 0); }
#pragma clang loop unroll(disable)
        for (int t = 0; t < nt; t += 2) {
            const bool last = (t == nt - 2);
            const char* a1 = cA + (size_t)(t + 1) * kstep;
            const char* a2 = last ? nA : cA + (size_t)(t + 2) * kstep; const char* b2 = last ? nB : cB + (size_t)(t + 2) * kstep;
            const char* a3 = a2 + kstep; const char* b3 = b2 + kstep;
            if constexpr (GATHER) { if (last && has_next) { const LAS int* ix = lidx + ((ui + 1) & 1) * 256;
#pragma unroll
                    for (int i = 0; i < 2; ++i) { const unsigned r0 = (unsigned)ix[RA[i]], r1 = (unsigned)ix[HALF + RA[i]];
                        nA0[i] = (r0 < (unsigned)NTOK ? r0 : (unsigned)(NTOK - 1)) * (unsigned)(K * 2) + (unsigned)CA[i] * 2u; nA1[i] = (r1 < (unsigned)NTOK ? r1 : (unsigned)(NTOK - 1)) * (unsigned)(K * 2) + (unsigned)CA[i] * 2u; } } }
            if constexpr (MODE == 2) { if (last && has_next) { const unsigned snap = (unsigned)__builtin_amdgcn_readfirstlane(*(const LAS int*)(lidx + ((ui + 1) & 1) * 256));
                    if (snap < RDY_NEED) rdy_wait(rdy + 64 * nxt.pm);
                    asm volatile("" ::: "memory"); } }
            unsigned sA0[2], sA1[2];
#pragma unroll
            for (int i = 0; i < 2; ++i) { sA0[i] = last ? nA0[i] : vA0[i]; sA1[i] = last ? nA1[i] : vA1[i]; }
            PG8_LDB(B0, 0, 0); PG8_LDB(B1, 0, 1); PG8_SCHED; PG8_LDA(At, 0, 0); PG8_STAGE_A(PG8_SA(1, 1), a1, 1, vA0, vA1);
            PG8_WAIT_V(8); PG8_WAIT_L(0); PG8_BAR; PG8_MMA(0, 0, At, B0); PG8_MMA(0, 1, At, B1); PG8_BAR; PG8_SCHED;
            PG8_LDA(At, 0, 1); PG8_STAGE(PG8_SB(0, 0), b2, voffB); PG8_STAGE(PG8_SB(0, 1), b2 + hstep, voffB); PG8_STAGE_A(PG8_SA(0, 0), a2, 0, sA0, sA1);
            PG8_WAIT_V(8); PG8_WAIT_L(0); PG8_BAR; PG8_MMA(1, 0, At, B0); PG8_MMA(1, 1, At, B1); PG8_BAR; PG8_SCHED;
            PG8_LDB(B0, 1, 0); PG8_LDB(B1, 1, 1); PG8_SCHED; PG8_LDA(At, 1, 0); PG8_STAGE_A(PG8_SA(0, 1), a2, 1, sA0, sA1);
            PG8_WAIT_V(8); PG8_WAIT_L(0); PG8_BAR; PG8_MMA(0, 0, At, B0); PG8_MMA(0, 1, At, B1); PG8_BAR; PG8_SCHED;
            PG8_LDA(At, 1, 1); PG8_STAGE(PG8_SB(1, 0), b3, voffB); PG8_STAGE(PG8_SB(1, 1), b3 + hstep, voffB); PG8_STAGE_A(PG8_SA(1, 0), a3, 0, sA0, sA1);
            PG8_WAIT_V(8); PG8_WAIT_L(0); PG8_BAR; PG8_MMA(1, 0, At, B0); PG8_MMA(1, 1, At, B1); PG8_BAR; PG8_SCHED;
        }
        asm volatile("s_nop 15\n\ts_nop 15" ::: "memory");
        if (wr == 0) PG8_BAR;
        if constexpr (MODE == 1 && PRE) { E.template run_pre<true>(acc, cur, wr, wc, fr, fq, prev_pm, ebuf + (ui & 1) * 512); prev_pm = __builtin_amdgcn_readfirstlane(cur.pm); }
        else if constexpr (MODE == 1) { E.template run<true>(acc, cur, wr, wc, fr, fq, prev_pm); prev_pm = __builtin_amdgcn_readfirstlane(cur.pm); }
        else if constexpr (PRE) E.run_pre0(acc, cur, wr, wc, fr, fq, ebuf + (ui & 1) * 512);
        else E(acc, cur, wr, wc, fr, fq);
        if (!has_next) break;
#pragma unroll
        for (int a = 0; a < 2; ++a)
#pragma unroll
            for (int b = 0; b < 2; ++b)
#pragma unroll
                for (int m = 0; m < 4; ++m)
#pragma unroll
                    for (int n = 0; n < 2; ++n) acc[a][b][m][n] = (f32x4){0.f, 0.f, 0.f, 0.f};
        cur = nxt; cA = nA; cB = nB; ++ui;
        PG8_PRE(cur, ui & 1);
        if constexpr (GATHER) {
#pragma unroll
            for (int i = 0; i < 2; ++i) { vA0[i] = nA0[i]; vA1[i] = nA1[i]; } }
        if (wr == 1) PG8_BAR;
    }
    PG8_WAIT_V(0);
    if constexpr (MODE == 1) { if (lane == 0) (void)__hip_atomic_fetch_add(rdy + 64 * __builtin_amdgcn_readfirstlane(cur.pm), 1u, __ATOMIC_RELAXED, __HIP_MEMORY_SCOPE_AGENT); }
    PG8_BAR;
#undef PG8_PRE
#undef PG8_SA
#undef PG8_SB
#undef PG8_STAGE
#undef PG8_LDA
#undef PG8_STAGE_A
#undef PG8_LD8
#undef PG8_LDB
#undef PG8_MMA
#undef PG8_WAIT_V
#undef PG8_WAIT_L
#undef PG8_BAR
#undef PG8_SCHED
}
}

#define XB_TMO      128
#define XB_XCNT(j)  (256  + 64 * (j))
#define XB_XSUB(j)  (1280 + 64 * (j))
#define XB_XGEN(j)  (2304 + 64 * (j))
#define XB_TOP      3328
#define XB_TOPGEN   3392
#define XCD_BAR_WORDS 3456
#define XB_SPIN_CAP (1u << 18)
__device__ __forceinline__ unsigned xb_ld(unsigned* p)              { return __hip_atomic_load(p, __ATOMIC_RELAXED, __HIP_MEMORY_SCOPE_AGENT); }
__device__ __forceinline__ unsigned xb_add(unsigned* p, unsigned v) { return __hip_atomic_fetch_add(p, v, __ATOMIC_RELAXED, __HIP_MEMORY_SCOPE_AGENT); }
__device__ __forceinline__ unsigned xb_xcc_id() { return (unsigned)__builtin_amdgcn_s_getreg((3 << 11) | 20) & 0xFu; }
#define XB_SPIN(cond, bar) do { unsigned _sp = 0; while (cond) { __builtin_amdgcn_s_sleep(1); \
    if ((++_sp & 255u) == 0u) { if (xb_ld(&(bar)[XB_TMO])) break; if (_sp > XB_SPIN_CAP) { atomicAdd(&(bar)[XB_TMO], 1u); break; } } } } while (0)
struct XcdBarrier { unsigned* bar; unsigned x; volatile LAS unsigned* st; };
__device__ __forceinline__ XcdBarrier xcd_barrier_post(unsigned* bar, volatile LAS unsigned* st) {
    XcdBarrier b; b.bar = bar; b.x = xb_xcc_id(); b.st = st;
    if (threadIdx.x == 0) (void)xb_add(&bar[XB_XCNT(b.x)], 1u);
    return b;
}
__device__ __forceinline__ void xcd_barrier_complete(unsigned* bar, unsigned x, unsigned& nloc, unsigned& nx) {
    const unsigned G = gridDim.x * gridDim.y * gridDim.z;
    unsigned sum, cnt, mine, sp = 0u;
    for (;;) {
        sum = 0u; cnt = 0u; mine = 0u;
#pragma unroll
        for (unsigned j = 0; j < 16; ++j) { const unsigned c = xb_ld(&bar[XB_XCNT(j)]); sum += c; cnt += (c > 0u) ? 1u : 0u; mine = (j == x) ? c : mine; }
        if (sum == G) break;
        __builtin_amdgcn_s_sleep(1);
        if ((++sp & 255u) == 0u) { if (xb_ld(&bar[XB_TMO])) break; if (sp > XB_SPIN_CAP) { atomicAdd(&bar[XB_TMO], 1u); break; } }
    }
    nloc = mine > 0u ? mine : 1u; nx = cnt > 0u ? cnt : 1u;
}
__device__ __forceinline__ void xcd_barrier(const XcdBarrier& b, const bool leader) {
    asm volatile("s_waitcnt vmcnt(0)" ::: "memory");
    __syncthreads();
    if (leader) {
        unsigned* bar = b.bar;
        __builtin_amdgcn_s_waitcnt(0);
        unsigned nloc = b.st[0], nx = b.st[1];
        if (nloc == 0u) { xcd_barrier_complete(bar, b.x, nloc, nx); b.st[0] = nloc; b.st[1] = nx; }
        const unsigned old = xb_add(&bar[XB_XSUB(b.x)], 1u);
        const unsigned gen = old / nloc;
        if (old + 1u == (gen + 1u) * nloc) {
            __builtin_amdgcn_fence(__ATOMIC_RELEASE, "agent");
            asm volatile("s_waitcnt vmcnt(0)" ::: "memory");
            const unsigned og = xb_add(&bar[XB_TOP], 1u);
            const unsigned tg = og / nx;
            if (og + 1u == (tg + 1u) * nx) xb_add(&bar[XB_TOPGEN], 1u);
            else XB_SPIN(xb_ld(&bar[XB_TOPGEN]) == tg, bar);
            __builtin_amdgcn_fence(__ATOMIC_ACQUIRE, "agent");
            xb_add(&bar[XB_XGEN(b.x)], 1u);
            asm volatile("s_waitcnt vmcnt(0)" ::: "memory");
        } else {
            XB_SPIN(xb_ld(&bar[XB_XGEN(b.x)]) == gen, bar);
            __builtin_amdgcn_fence(__ATOMIC_ACQUIRE, "agent");
            asm volatile("s_waitcnt vmcnt(0)" ::: "memory");
        }
    }
    __syncthreads();
}

constexpr int NWAVES = 8;
constexpr int RING_OFF = 0, RING_BYTES = 131072;
constexpr int LDSCTL_OFF = 160 * 1024 - 512, MISC_OFF = LDSCTL_OFF + 320;
#ifndef DBG_BAR10
#define DBG_BAR10 0
#endif

constexpr int TILEE_OFF = RING_OFF + RING_BYTES + 4096;
constexpr int LDS_BYTES = 160 * 1024;

struct Args { const float* in[23]; float* out; unsigned char* ws; int ph_lo, ph_hi, li, pad; };

__device__ __forceinline__ void p0_transpose_item(const float* __restrict__ W, int ldw, bf16* __restrict__ WT, int drow0, int n0, int k0, LAS float* scr, int lane, const float* __restrict__ kscale = nullptr) {
    const int c = lane & 7;
    f32x4 ks0 = (f32x4){1.f, 1.f, 1.f, 1.f}, ks1 = ks0;
    if (kscale) { ks0 = *(const f32x4*)(kscale + k0 + 8 * c); ks1 = *(const f32x4*)(kscale + k0 + 8 * c + 4); }
#pragma unroll 8
    for (int i = 0; i < 32; ++i) { const int kk = 2 * i + (lane >> 5); scr[kk * 33 + (lane & 31)] = W[(size_t)(k0 + kk) * ldw + n0 + (lane & 31)]; }
    LDS_WAIT(); asm volatile("" ::: "memory");
    float t[4][8];
#pragma unroll
    for (int j = 0; j < 4; ++j) { const LAS float* sp = scr + (8 * c) * 33 + (lane >> 3) + 8 * j;
#pragma unroll
        for (int q = 0; q < 8; ++q) t[j][q] = sp[q * 33]; }
    LDS_WAIT(); asm volatile("" ::: "memory");
#pragma unroll
    for (int j = 0; j < 4; ++j) { const int n = (lane >> 3) + 8 * j;
        u32x4 o; o.x = pk2(t[j][0] * ks0[0], t[j][1] * ks0[1]); o.y = pk2(t[j][2] * ks0[2], t[j][3] * ks0[3]); o.z = pk2(t[j][4] * ks1[0], t[j][5] * ks1[1]); o.w = pk2(t[j][6] * ks1[2], t[j][7] * ks1[3]);
        *(GAS u32x4*)(WT + (size_t)(drow0 + n) * D + k0 + 8 * c) = o; }
}
__device__ __forceinline__ void p0_item_load(float (&rg)[32], const float* __restrict__ W, int ldw, int n0, int k0, int lane) {
#pragma unroll
    for (int i = 0; i < 32; ++i) rg[i] = W[(size_t)(k0 + 2 * i + (lane >> 5)) * ldw + n0 + (lane & 31)];
}
__device__ __forceinline__ void p0_item_finish(const float (&rg)[32], bf16* __restrict__ WT, int drow0, int k0, LAS float* scr, int lane, const float* __restrict__ kscale) {
    const int c = lane & 7;
    f32x4 ks0 = (f32x4){1.f, 1.f, 1.f, 1.f}, ks1 = ks0;
    if (kscale) { ks0 = *(const f32x4*)(kscale + k0 + 8 * c); ks1 = *(const f32x4*)(kscale + k0 + 8 * c + 4); }
#pragma unroll
    for (int i = 0; i < 32; ++i) scr[(2 * i + (lane >> 5)) * 33 + (lane & 31)] = rg[i];
    LDS_WAIT(); asm volatile("" ::: "memory");
    float t[4][8];
#pragma unroll
    for (int j = 0; j < 4; ++j) { const LAS float* sp = scr + (8 * c) * 33 + (lane >> 3) + 8 * j;
#pragma unroll
        for (int q = 0; q < 8; ++q) t[j][q] = sp[q * 33]; }
    LDS_WAIT(); asm volatile("" ::: "memory");
    const float sc = MOE_FP8 ? W8S : 1.f;
#pragma unroll
    for (int j = 0; j < 4; ++j) { const int n = (lane >> 3) + 8 * j;
        const float v0 = t[j][0] * (ks0[0] * sc), v1 = t[j][1] * (ks0[1] * sc), v2 = t[j][2] * (ks0[2] * sc), v3 = t[j][3] * (ks0[3] * sc), v4 = t[j][4] * (ks1[0] * sc), v5 = t[j][5] * (ks1[1] * sc), v6 = t[j][6] * (ks1[2] * sc), v7 = t[j][7] * (ks1[3] * sc);
        if (MOE_FP8) { u32x2 o; o.x = pk4_fp8(v0, v1, v2, v3); o.y = pk4_fp8(v4, v5, v6, v7);
            *(GAS u32x2*)((unsigned char*)WT + (size_t)(drow0 + n) * D + k0 + 8 * c) = o; }
        else { u32x4 o; o.x = pk2(v0, v1); o.y = pk2(v2, v3); o.z = pk2(v4, v5); o.w = pk2(v6, v7);
            *(GAS u32x4*)(WT + (size_t)(drow0 + n) * D + k0 + 8 * c) = o; } }
}
__device__ __forceinline__ void rms_row_to_bf16(const float* __restrict__ xrow, const float* __restrict__ w, bf16* __restrict__ orow, int lane) {
    const f32x4* xr = (const f32x4*)xrow + lane;
    f32x4 v[4]; float s = 0.f;
#pragma unroll
    for (int j = 0; j < 4; ++j) { v[j] = xr[64 * j]; s += (v[j].x * v[j].x + v[j].y * v[j].y) + (v[j].z * v[j].z + v[j].w * v[j].w); }
    const float r = rsqrtf(wave_sum(s) * (1.f / D) + EPS);
    u32x2* o8 = (u32x2*)orow + lane;
#pragma unroll
    for (int j = 0; j < 4; ++j) { const f32x4 ww = ((const f32x4*)w)[lane + 64 * j]; u32x2 o; o.x = pk2(v[j].x * r * ww.x, v[j].y * r * ww.y); o.y = pk2(v[j].z * r * ww.z, v[j].w * r * ww.w); o8[64 * j] = o; }
}


typedef __bf16 bf16x2_t __attribute__((ext_vector_type(2)));
typedef float f32x2_t __attribute__((ext_vector_type(2)));
__device__ __forceinline__ unsigned cvtpk(float lo, float hi) { const f32x2_t v = {lo, hi}; const bf16x2_t b = __builtin_convertvector(v, bf16x2_t); return __builtin_bit_cast(unsigned, b); }
__device__ __forceinline__ void attn_unit(LAS unsigned char* lds, const bf16* Q, const bf16* KB, const bf16* VT, bf16* AO, int b, int h, int qb, int lane, int wave) {
    constexpr int RS = 528, HB = 73728, HOFF = HB - 128 * RS;
    const int r = lane & 31, hh = lane >> 5;
    const size_t tokq = (size_t)b * SEQ + (size_t)qb * 256 + wave * 32 + r;
    bf16x8 qf[16];
    { const bf16* qp = Q + tokq * D + h * 256 + 8 * hh;
#pragma unroll
      for (int s2 = 0; s2 < 16; ++s2) qf[s2] = *(const bf16x8*)(qp + 16 * s2); }
    const char* kbase = (const char*)(KB + (size_t)(b * MEML) * D + h * 256);
    const char* vbase = (const char*)(VT + (size_t)(h * 256) * NMEM + b * MEML);
#define ATT_DMA(base, pitch, half) do { int ln_ = lane; asm volatile("" : "+v"(ln_)); int g_ = wave * 64 + ln_; int row_ = g_ / 33, cs_ = g_ - row_ * 33; \
        _Pragma("unroll") for (int i_ = 0; i_ < 9; ++i_) { const int rr_ = row_ > 127 ? 127 : row_, cc_ = cs_ > 31 ? 31 : cs_; \
            __builtin_amdgcn_global_load_lds((const unsigned*)((base) + (size_t)(128 * (half) + rr_) * (pitch) + cc_ * 16), (LAS unsigned*)(lds + (half) * HB + (wave + 8 * i_) * 1024), 16, 0, 0); \
            cs_ += 17; row_ += 15; if (cs_ >= 33) { cs_ -= 33; row_ += 1; } } } while (0)
#define ATT_WAIT(n) asm volatile("s_waitcnt vmcnt(" #n ")" ::: "memory")
#define ATT_BAR() do { asm volatile("s_waitcnt lgkmcnt(0)" ::: "memory"); __builtin_amdgcn_s_barrier(); asm volatile("" ::: "memory"); } while (0)
    ATT_DMA(kbase, D * 2, 0); ATT_DMA(kbase, D * 2, 1);
    ATT_WAIT(9); ATT_BAR();
    const LAS unsigned char* kread = lds + r * RS + hh * 16;
    u32x4 pp[8][2]; float alpha[4]; float mrun = -INFINITY, lrun = 0.f;
#pragma unroll
    for (int kq = 0; kq < 4; ++kq) {
        if (kq == 2) { ATT_WAIT(9); ATT_BAR(); }
        f32x16 st[2];
#pragma unroll
        for (int t2 = 0; t2 < 2; ++t2) { const int t = 2 * kq + t2; f32x16 acc;
#pragma unroll
            for (int e = 0; e < 16; ++e) acc[e] = 0.f;
#pragma unroll
            for (int s2 = 0; s2 < 16; ++s2) { const bf16x8 a = *(const LAS bf16x8*)(kread + 32 * t * RS + (t >= 4 ? HOFF : 0) + s2 * 32); acc = __builtin_amdgcn_mfma_f32_32x32x16_bf16(a, qf[s2], acc, 0, 0, 0); if ((s2 & 3) == 3) __builtin_amdgcn_sched_barrier(0); }
            st[t2] = acc; }
        if (kq == 1) { ATT_BAR(); ATT_DMA(vbase, NMEM * 2, 0); }
        if (kq == 3) { ATT_BAR(); ATT_DMA(vbase, NMEM * 2, 1); }
        float m = st[0][0];
#pragma unroll
        for (int t2 = 0; t2 < 2; ++t2)
#pragma unroll
            for (int e = 0; e < 16; ++e) m = fmaxf(m, st[t2][e]);
        m = fmaxf(m, __shfl_xor(m, 32)); m = fmaxf(m, mrun);
        alpha[kq] = __builtin_amdgcn_exp2f((mrun - m) * 1.4426950408889634f); mrun = m;
        float ls = 0.f; const float mc = m * 1.4426950408889634f;
#pragma unroll
        for (int t2 = 0; t2 < 2; ++t2) { const int t = 2 * kq + t2; float pe[16];
#pragma unroll
            for (int e = 0; e < 16; ++e) { pe[e] = __builtin_amdgcn_exp2f(st[t2][e] * 1.4426950408889634f - mc); ls += pe[e]; }
#pragma unroll
            for (int u = 0; u < 2; ++u) { pp[t][u].x = cvtpk(pe[8 * u], pe[8 * u + 1]); pp[t][u].y = cvtpk(pe[8 * u + 2], pe[8 * u + 3]); pp[t][u].z = cvtpk(pe[8 * u + 4], pe[8 * u + 5]); pp[t][u].w = cvtpk(pe[8 * u + 6], pe[8 * u + 7]); }
            __builtin_amdgcn_sched_barrier(0); }
        lrun = lrun * alpha[kq] + ls;
    }
    const float l = lrun + __shfl_xor(lrun, 32);
    const float rl = 1.f / l;
    bf16* orow0 = AO + tokq * D + h * 256;
    const LAS unsigned char* vread = lds + r * RS + 8 * hh;
#pragma unroll
    for (int half = 0; half < 2; ++half) {
        if (half == 0) { ATT_WAIT(9); } else { ATT_WAIT(0); }
        ATT_BAR();
#pragma unroll
        for (int dt = 4 * half; dt < 4 * half + 4; ++dt) { f32x16 acc;
#pragma unroll
            for (int e = 0; e < 16; ++e) acc[e] = 0.f;
            const LAS unsigned char* vrow = vread + 32 * dt * RS + (dt >= 4 ? HOFF : 0);
#pragma unroll
            for (int t = 0; t < 8; ++t) {
                if (t == 2 || t == 4 || t == 6) {
#pragma unroll
                    for (int e = 0; e < 16; ++e) acc[e] *= alpha[t >> 1]; }
#pragma unroll
                for (int u = 0; u < 2; ++u) { const u32x2 a0 = *(const LAS u32x2*)(vrow + (4 * t + 2 * u) * 16), a1 = *(const LAS u32x2*)(vrow + (4 * t + 2 * u + 1) * 16);
                    u32x4 aw; aw.x = a0.x; aw.y = a0.y; aw.z = a1.x; aw.w = a1.y;
                    acc = __builtin_amdgcn_mfma_f32_32x32x16_bf16(__builtin_bit_cast(bf16x8, aw), __builtin_bit_cast(bf16x8, pp[t][u]), acc, 0, 0, 0); }
                __builtin_amdgcn_sched_barrier(0); }
            u32x2 w[4];
#pragma unroll
            for (int g = 0; g < 4; ++g) { w[g].x = cvtpk(acc[4 * g] * rl, acc[4 * g + 1] * rl); w[g].y = cvtpk(acc[4 * g + 2] * rl, acc[4 * g + 3] * rl); }
#pragma unroll
            for (int p2 = 0; p2 < 2; ++p2) {
                const u32x2 rx = __builtin_amdgcn_permlane32_swap(w[2 * p2].x, w[2 * p2 + 1].x, false, false), ry = __builtin_amdgcn_permlane32_swap(w[2 * p2].y, w[2 * p2 + 1].y, false, false);
                *(u32x4*)(orow0 + 32 * dt + 16 * p2 + 8 * hh) = (u32x4){rx.x, ry.x, rx.y, ry.y}; } }
    }
    ATT_BAR();
#undef ATT_DMA
#undef ATT_WAIT
#undef ATT_BAR
}

template <int K> struct ScanGeo { static constexpr int QS = K + 8, VS = 72, OFF_KR = 64 * QS * 2, OFF_TAB = 2 * 64 * QS * 2, BLOB = OFF_TAB + 3 * K * 4; };
__device__ __forceinline__ size_t blob_off(int grp, int b, int h, int c) { return grp == 0 ? (size_t)(((b * 4 + h) * 32) + c) * ScanGeo<128>::BLOB : (size_t)1024 * ScanGeo<128>::BLOB + (size_t)(((b * 4 + h) * 32) + c) * ScanGeo<64>::BLOB; }
#define SC_BAR() do { asm volatile("s_waitcnt vmcnt(0) lgkmcnt(0)" ::: "memory"); __builtin_amdgcn_s_barrier(); asm volatile("" ::: "memory"); } while (0)
#define SC_BARL2() do { asm volatile("s_waitcnt lgkmcnt(0)" ::: "memory"); __builtin_amdgcn_s_barrier(); asm volatile("" ::: "memory"); } while (0)

template <int K, int GRP>
__device__ __forceinline__ void prep_load(float (&g)[64 / (512 / K)], unsigned short (&q)[64 / (512 / K)], unsigned short (&kk)[64 / (512 / K)], const bf16* PB, const _Float16* G, int b, int h, int c, int tid) {
    constexpr int NQ = 512 / K, RPT = 64 / NQ;
    const int qcol = (GRP == 0 ? C_HQ : C_GQ) + h * K, kcol = (GRP == 0 ? C_HF : C_GK) + h * K, gcol = (GRP == 0 ? 0 : 512) + h * K;
    const int pk = tid & (K - 1), prq = tid / K;
    const size_t tok0 = (size_t)b * SEQ + (size_t)c * 64;
#pragma unroll
    for (int r = 0; r < RPT; ++r) { const size_t tk = tok0 + RPT * prq + r; g[r] = (float)G[tk * GW + gcol + pk]; q[r] = PB[tk * PBW + qcol + pk]; kk[r] = PB[tk * PBW + kcol + pk]; }
}
template <int K>
__device__ __forceinline__ void prep_p1(const float (&g)[64 / (512 / K)], const unsigned short (&pq)[64 / (512 / K)], const unsigned short (&pkk)[64 / (512 / K)], LAS unsigned char* lds, int tid) {
    typedef ScanGeo<K> GE; constexpr int NQ = 512 / K, RPT = 64 / NQ, QS = GE::QS;
    LAS bf16* QR = (LAS bf16*)lds; LAS bf16* KR = (LAS bf16*)(lds + GE::OFF_KR); LAS float* TAB = (LAS float*)(lds + GE::OFF_TAB); LAS float* TOT = (LAS float*)(lds + GE::BLOB);
    const int pk = tid & (K - 1), prq = tid / K;
    float bc[RPT];
    { float run = 0.f;
#pragma unroll
      for (int r = 0; r < RPT; ++r) { run += g[r]; bc[r] = run; }
      TOT[prq * K + pk] = run; }
    SC_BARL2();
    { float pre = 0.f, rr = 0.f, tot = 0.f;
#pragma unroll
      for (int gq = 0; gq < NQ; ++gq) { const float t = TOT[gq * K + pk]; pre += (gq < prq) ? t : 0.f; rr += (gq < NQ / 2) ? t : 0.f; tot += t; }
      if (prq == 0) { TAB[pk] = __expf(rr); TAB[K + pk] = __expf(tot); TAB[2 * K + pk] = __expf(tot - rr); }
#pragma unroll
      for (int r = 0; r < RPT; ++r) { const float bb = pre + bc[r]; const float e1 = __expf(bb - rr); const float qv = bf2f(pq[r]) * e1, kv = bf2f(pkk[r]) * __builtin_amdgcn_rcpf(e1);
          QR[(RPT * prq + r) * QS + pk] = (bf16)f2bf(qv); KR[(RPT * prq + r) * QS + pk] = (bf16)f2bf(kv); } }
}
template <int K>
__device__ __forceinline__ void prep_p2(LAS unsigned char* lds, unsigned char* blob, int tid) {
    typedef ScanGeo<K> GE;
    SC_BARL2();
    for (int i = tid; i < GE::BLOB / 16; i += NWAVES * 64) ((u32x4*)blob)[i] = ((const LAS u32x4*)lds)[i];
    SC_BARL2();
}

template <int K, int GRP>
__device__ __forceinline__ void scan128(LAS unsigned char* lds, const bf16* PB, const unsigned char* blobs, bf16* Y, const float* onw, int b, int h, int tid, int lane, int wave) {
    typedef ScanGeo<K> GE; constexpr int QS = GE::QS, VS = GE::VS, NS = K / 32, NKT = K / 64, IMG = GE::OFF_TAB, NDMA = (GE::OFF_TAB / 8) / 1024 + 1;
    constexpr int PW = IMG / 8, NPF = PW / 1024, REM = (PW - NPF * 1024) / 16;
    LAS unsigned char* VTb = lds + 3 * IMG; LAS bf16* VT = (LAS bf16*)VTb; LAS bf16* SST = (LAS bf16*)(VTb + 128 * VS * 2);
    const int q4 = lane >> 4, l15 = lane & 15;
    const int vcol = (GRP == 0 ? C_HI : C_GV) + h * 128, gcol = (GRP == 0 ? C_HGATE : C_GGATE) + h * 128;
    const bool owave = wave < 4; const int I = wave & 3, ws = wave & 3;
    const int vrow = tid & 127, vv = 8 * (vrow & 15) + (vrow >> 4), jg = tid >> 7;
#define SC_DMA(c, buf) do { const unsigned char* src_ = blobs + (size_t)(c) * GE::BLOB + wave * PW + lane * 16; LAS unsigned char* dst_ = lds + (buf) * IMG + wave * PW; \
        _Pragma("unroll") for (int i_ = 0; i_ < NPF; ++i_) __builtin_amdgcn_global_load_lds((const unsigned*)(src_ + i_ * 1024), (LAS unsigned*)(dst_ + i_ * 1024), 16, 0, 0); \
        if (lane < REM) __builtin_amdgcn_global_load_lds((const unsigned*)(src_ + NPF * 1024), (LAS unsigned*)(dst_ + NPF * 1024), 16, 0, 0); } while (0)
#define SC_LOADV(c) do { const size_t t0_ = (size_t)b * SEQ + (size_t)(c) * 64 + 16 * jg; _Pragma("unroll") for (int r_ = 0; r_ < 16; ++r_) pv[r_] = PB[(t0_ + r_) * PBW + vcol + vv]; } while (0)
#define SC_LOADG(c, dst) do { const size_t t0_ = (size_t)b * SEQ + (size_t)(c) * 64 + 16 * I + 4 * q4; _Pragma("unroll") for (int reg_ = 0; reg_ < 4; ++reg_) dst[reg_] = *(const u32x4*)(PB + (t0_ + reg_) * PBW + gcol + 8 * l15); } while (0)
#define SC_LOADT(c) do { const float* tg_ = (const float*)(blobs + (size_t)(c) * GE::BLOB + GE::OFF_TAB); _Pragma("unroll") for (int a_ = 0; a_ < NKT; ++a_) _Pragma("unroll") for (int x_ = 0; x_ < 3; ++x_) tb[a_][x_] = *(const f32x4*)(tg_ + x_ * K + 16 * (NKT * ws + a_) + 4 * q4); } while (0)
#define SC_WAITN(n) asm volatile("s_waitcnt vmcnt(%0)" :: "n"(n) : "memory")
#define SC_BARL() do { asm volatile("s_waitcnt lgkmcnt(0)" ::: "memory"); __builtin_amdgcn_s_barrier(); asm volatile("" ::: "memory"); } while (0)
#define SC_TOP(c) const int buf = (c) % 3; \
        LAS bf16* QR = (LAS bf16*)(lds + buf * IMG); LAS bf16* KR = (LAS bf16*)(lds + buf * IMG + GE::OFF_KR); (void)QR; (void)KR; \
        if ((c) + 1 < SEQ / 64) SC_WAITN(NDMA); else SC_WAITN(0);     \
        SC_BARL();       \
        { u32x4 w0, w1; \
          w0.x = pv[0] | ((unsigned)pv[1] << 16); w0.y = pv[2] | ((unsigned)pv[3] << 16); w0.z = pv[4] | ((unsigned)pv[5] << 16); w0.w = pv[6] | ((unsigned)pv[7] << 16); \
          w1.x = pv[8] | ((unsigned)pv[9] << 16); w1.y = pv[10] | ((unsigned)pv[11] << 16); w1.z = pv[12] | ((unsigned)pv[13] << 16); w1.w = pv[14] | ((unsigned)pv[15] << 16); \
          *(LAS u32x4*)(VT + vrow * VS + 16 * jg) = w0; *(LAS u32x4*)(VT + vrow * VS + 16 * jg + 8) = w1; }
    unsigned short pv[16];
    SC_LOADV(0);
    if (owave) {
        float nw[8]; u32x4 pgc[4], pgn[4], yv[4];
        { const f32x4 n0 = *(const f32x4*)(onw + 8 * l15), n1 = *(const f32x4*)(onw + 8 * l15 + 4); nw[0] = n0[0]; nw[1] = n0[1]; nw[2] = n0[2]; nw[3] = n0[3]; nw[4] = n1[0]; nw[5] = n1[1]; nw[6] = n1[2]; nw[7] = n1[3]; }
        SC_LOADG(0, pgc);
        SC_DMA(0, 0); SC_DMA(1, 1);
#pragma unroll
        for (int reg = 0; reg < 4; ++reg) { yv[reg] = (u32x4){0u, 0u, 0u, 0u}; pgn[reg] = yv[reg]; }
        for (int c = 0; c < SEQ / 64; ++c) {
            SC_TOP(c)
            SC_BARL();
            if (c + 1 < SEQ / 64) { SC_LOADV(c + 1); SC_LOADG(c + 1, pgn); }
            if (c > 0) { bf16* yp = Y + ((size_t)b * SEQ + (size_t)(c - 1) * 64 + 16 * I + 4 * q4) * D + GRP * 512 + h * 128 + 8 * l15;
#pragma unroll
                for (int reg = 0; reg < 4; ++reg) *(u32x4*)(yp + (size_t)reg * D) = yv[reg]; }
            if (c + 2 < SEQ / 64) SC_DMA(c + 2, (c + 2) % 3);
            bf16x8 qf[NS];
#pragma unroll
            for (int s2 = 0; s2 < NS; ++s2) qf[s2] = *(const LAS bf16x8*)(QR + (16 * I + l15) * QS + 32 * s2 + 8 * q4);
            f32x4 AT[4];
#pragma unroll
            for (int J = 0; J < 4; ++J) { f32x4 acc = (f32x4){0.f, 0.f, 0.f, 0.f};
                if (J <= I) {
#pragma unroll
                    for (int s2 = 0; s2 < NS; ++s2) { const bf16x8 kf = *(const LAS bf16x8*)(KR + (16 * J + l15) * QS + 32 * s2 + 8 * q4); acc = __builtin_amdgcn_mfma_f32_16x16x32_bf16(kf, qf[s2], acc, 0, 0, 0); }
                    if (J == I) {
#pragma unroll
                        for (int reg = 0; reg < 4; ++reg) acc[reg] = (4 * q4 + reg > l15) ? 0.f : acc[reg]; } }
                AT[J] = acc; }
            u32x4 aw[2];
#pragma unroll
            for (int sp = 0; sp < 2; ++sp) { aw[sp].x = cvtpk(AT[2 * sp][0], AT[2 * sp][1]); aw[sp].y = cvtpk(AT[2 * sp][2], AT[2 * sp][3]); aw[sp].z = cvtpk(AT[2 * sp + 1][0], AT[2 * sp + 1][1]); aw[sp].w = cvtpk(AT[2 * sp + 1][2], AT[2 * sp + 1][3]); }
            f32x4 o[8]; float ss[4] = {0.f, 0.f, 0.f, 0.f};
#pragma unroll
            for (int vt = 0; vt < 8; ++vt) { f32x4 oo = (f32x4){0.f, 0.f, 0.f, 0.f};
#pragma unroll
                for (int sp = 0; sp < 2; ++sp) if (2 * sp <= I) {
                    const u32x2 b0 = *(const LAS u32x2*)(VT + (16 * vt + l15) * VS + 32 * sp + 4 * q4), b1 = *(const LAS u32x2*)(VT + (16 * vt + l15) * VS + 32 * sp + 16 + 4 * q4);
                    u32x4 bw; bw.x = b0.x; bw.y = b0.y; bw.z = b1.x; bw.w = b1.y;
                    oo = __builtin_amdgcn_mfma_f32_16x16x32_bf16(__builtin_bit_cast(bf16x8, aw[sp]), __builtin_bit_cast(bf16x8, bw), oo, 0, 0, 0); }
#pragma unroll
                for (int s2 = 0; s2 < NS; ++s2) { const bf16x8 sf = *(const LAS bf16x8*)(SST + (16 * vt + l15) * QS + 32 * s2 + 8 * q4); oo = __builtin_amdgcn_mfma_f32_16x16x32_bf16(qf[s2], sf, oo, 0, 0, 0); }
                o[vt] = oo;
#pragma unroll
                for (int reg = 0; reg < 4; ++reg) ss[reg] += oo[reg] * oo[reg]; }
#pragma unroll
            for (int reg = 0; reg < 4; ++reg) { float t = ss[reg]; t += __shfl_xor(t, 1); t += __shfl_xor(t, 2); t += __shfl_xor(t, 4); t += __shfl_xor(t, 8); const float rs = rsqrtf(t * (1.f / 128.f) + EPS);
                const unsigned gw[4] = {pgc[reg].x, pgc[reg].y, pgc[reg].z, pgc[reg].w}; unsigned yw[4];
#pragma unroll
                for (int j = 0; j < 4; ++j) yw[j] = cvtpk(o[2 * j][reg] * rs * nw[2 * j] * bf2f(gw[j] & 0xffffu), o[2 * j + 1][reg] * rs * nw[2 * j + 1] * bf2f(gw[j] >> 16));
                yv[reg] = (u32x4){yw[0], yw[1], yw[2], yw[3]}; pgc[reg] = pgn[reg]; }
        }
        { bf16* yp = Y + ((size_t)b * SEQ + (size_t)(SEQ / 64 - 1) * 64 + 16 * I + 4 * q4) * D + GRP * 512 + h * 128 + 8 * l15;
#pragma unroll
          for (int reg = 0; reg < 4; ++reg) *(u32x4*)(yp + (size_t)reg * D) = yv[reg]; }
    } else {
        f32x4 S[NKT][8]; f32x4 tb[NKT][3];
#pragma unroll
        for (int a = 0; a < NKT; ++a)
#pragma unroll
            for (int vt = 0; vt < 8; ++vt) S[a][vt] = (f32x4){0.f, 0.f, 0.f, 0.f};
        SC_LOADT(0);
        SC_DMA(0, 0); SC_DMA(1, 1);
        for (int c = 0; c < SEQ / 64; ++c) {
            SC_TOP(c)
            float d63[NKT][4], e2[NKT][4];
#pragma unroll
            for (int a = 0; a < NKT; ++a) { const int kt = NKT * ws + a;
#pragma unroll
                for (int reg = 0; reg < 4; ++reg) { d63[a][reg] = tb[a][1][reg]; e2[a][reg] = tb[a][2][reg]; }
#pragma unroll
                for (int vt = 0; vt < 8; ++vt) { u32x2 w; w.x = cvtpk(tb[a][0][0] * S[a][vt][0], tb[a][0][1] * S[a][vt][1]); w.y = cvtpk(tb[a][0][2] * S[a][vt][2], tb[a][0][3] * S[a][vt][3]);
                    *(LAS u32x2*)(SST + (16 * vt + l15) * QS + 16 * kt + 4 * q4) = w; } }
            SC_BARL();
            if (c + 1 < SEQ / 64) { SC_LOADV(c + 1); SC_LOADT(c + 1); }
            if (c + 2 < SEQ / 64) SC_DMA(c + 2, (c + 2) % 3);
            bf16x8 af[NKT][2];
#pragma unroll
            for (int a = 0; a < NKT; ++a)
#pragma unroll
                for (int s2 = 0; s2 < 2; ++s2) { const LAS bf16* tp = KR + (32 * s2 + 8 * q4 + (l15 >> 2)) * QS + 16 * (NKT * ws + a) + 4 * (l15 & 3);
                    const s16x4 t0 = __builtin_amdgcn_ds_read_tr16_b64_v4i16((LAS s16x4*)tp), t1 = __builtin_amdgcn_ds_read_tr16_b64_v4i16((LAS s16x4*)(tp + 4 * QS));
                    af[a][s2] = (bf16x8){t0[0], t0[1], t0[2], t0[3], t1[0], t1[1], t1[2], t1[3]}; }
#pragma unroll
            for (int vt = 0; vt < 8; ++vt) { bf16x8 vf[2];
#pragma unroll
                for (int s2 = 0; s2 < 2; ++s2) vf[s2] = *(const LAS bf16x8*)(VT + (16 * vt + l15) * VS + 32 * s2 + 8 * q4);
#pragma unroll
                for (int a = 0; a < NKT; ++a) { f32x4 T = (f32x4){0.f, 0.f, 0.f, 0.f};
#pragma unroll
                    for (int s2 = 0; s2 < 2; ++s2) T = __builtin_amdgcn_mfma_f32_16x16x32_bf16(af[a][s2], vf[s2], T, 0, 0, 0);
#pragma unroll
                    for (int reg = 0; reg < 4; ++reg) S[a][vt][reg] = d63[a][reg] * S[a][vt][reg] + e2[a][reg] * T[reg]; } }
        }
    }
    SC_BAR();
#undef SC_TOP
#undef SC_WAITN
#undef SC_BARL
#undef SC_DMA
#undef SC_LOADV
#undef SC_LOADG
#undef SC_LOADT
}

__device__ __forceinline__ void rms_2rows_to_bf16(const float* __restrict__ x0, const float* __restrict__ x1, const float* __restrict__ w, bf16* __restrict__ o0, bf16* __restrict__ o1, int lane) {
    const f32x4* xa = (const f32x4*)x0 + lane; const f32x4* xb = (const f32x4*)x1 + lane;
    f32x4 va[4], vb[4]; float sa = 0.f, sb = 0.f;
#pragma unroll
    for (int j = 0; j < 4; ++j) { va[j] = xa[64 * j]; vb[j] = xb[64 * j]; }
#pragma unroll
    for (int j = 0; j < 4; ++j) { sa += (va[j].x * va[j].x + va[j].y * va[j].y) + (va[j].z * va[j].z + va[j].w * va[j].w); sb += (vb[j].x * vb[j].x + vb[j].y * vb[j].y) + (vb[j].z * vb[j].z + vb[j].w * vb[j].w); }
    const float ra = rsqrtf(wave_sum(sa) * (1.f / D) + EPS), rb = rsqrtf(wave_sum(sb) * (1.f / D) + EPS);
    u32x2* pa = (u32x2*)o0 + lane; u32x2* pb = (u32x2*)o1 + lane;
#pragma unroll
    for (int j = 0; j < 4; ++j) { const f32x4 ww = ((const f32x4*)w)[lane + 64 * j]; u32x2 o; o.x = pk2(va[j].x * ra * ww.x, va[j].y * ra * ww.y); o.y = pk2(va[j].z * ra * ww.z, va[j].w * ra * ww.w); pa[64 * j] = o;
        o.x = pk2(vb[j].x * rb * ww.x, vb[j].y * rb * ww.y); o.y = pk2(vb[j].z * rb * ww.z, vb[j].w * rb * ww.w); pb[64 * j] = o; }
}
__global__ void __launch_bounds__(NWAVES * 64, 2) mega_fwd(Args args) {
    extern __shared__ __attribute__((aligned(16))) unsigned char lds_raw[];
    LAS unsigned char* lds = (LAS unsigned char*)lds_raw;
    volatile LAS unsigned* MISC = (volatile LAS unsigned*)(lds + MISC_OFF);
    const int tid0 = threadIdx.x, wave = __builtin_amdgcn_readfirstlane(tid0 >> 6);
    const int G = gridDim.x, bx = blockIdx.x;
    const int vcu = (G % 8 == 0) ? (bx % 8) * (G / 8) + bx / 8 : bx;
    unsigned char* ws = args.ws;
    unsigned* ctl = (unsigned*)(ws + WS_CTL);
    for (int u = tid0; u < (LDS_BYTES - LDSCTL_OFF) / 4; u += NWAVES * 64) ((LAS unsigned*)(lds + LDSCTL_OFF))[u] = 0u;
    __syncthreads();
    XcdBarrier bar = xcd_barrier_post(ctl + CW_BAR + args.li * XCD_BAR_WORDS, MISC + 8);
    const int lo = args.ph_lo, hi = args.ph_hi;
#define IN(k) (lo <= (k) && (k) < hi)
#define SEAM(k) do { if (IN(k) && IN((k) + 1)) xcd_barrier(bar, wave == 0 && fresh_lane() == 0); } while (0)
    const float* x = args.in[0]; const float* mem = args.in[1]; const float* norm_mix_w = args.in[2]; const float* w_in = args.in[3]; const float* lb_logits = args.in[4];
    const float* norm_xa_w = args.in[10]; const float* norm_moe_w = args.in[15];
    const float* w_gk2 = args.in[6]; const float* b_gk = args.in[7]; const float* w_out = args.in[9]; const float* norm_mem_w = args.in[11];
    const float* w_xq = args.in[12]; const float* w_xkv = args.in[13]; const float* w_xo = args.in[14]; const float* w_gu = args.in[18]; const float* w_down = args.in[20];
    float* LB = (float*)(ws + WS_TAB + OFF_LB);
    bf16* WT_IN = (bf16*)(ws + WS_WT_IN); bf16* WT_OUT = (bf16*)(ws + WS_WT_OUT); bf16* WT_XQ = (bf16*)(ws + WS_WT_XQ); bf16* WT_XKV = (bf16*)(ws + WS_WT_XKV); bf16* WT_XO = (bf16*)(ws + WS_WT_XO);
    bf16* WT_GU = (bf16*)(ws + WS_WT_GU); bf16* WT_DN = (bf16*)(ws + WS_WT_DN);
    bf16* PB = (bf16*)(ws + WS_PB); _Float16* Gd = (_Float16*)(ws + WS_G); bf16* HB = (bf16*)(ws + WS_HB); bf16* HMB = (bf16*)(ws + WS_HMB); bf16* KB = (bf16*)(ws + WS_KB); bf16* VT = (bf16*)(ws + WS_VT);

    if (IN(0)) { const int lane = fresh_lane(), tid = wave * 64 + lane; (void)tid;
        LAS float* scr = (LAS float*)(lds + RING_OFF + wave * 16384);
        const int gw = vcu * NWAVES + wave, NGW = G * NWAVES;
        constexpr int I_IN = 16 * (PBW / 32), I_SQ = 16 * 32, I_KV = 16 * 64;
        constexpr int NITEMS = I_IN + 3 * I_SQ + I_KV;
        for (int it = gw; it < NITEMS; it += NGW) {
            int r = it;
            if (r < I_IN) { const int nb = r % (PBW / 32), kb = r / (PBW / 32); p0_transpose_item(w_in, INW, WT_IN, nb * 32, nb * 32, kb * 64, scr, lane); continue; } r -= I_IN;
            if (r < I_SQ) { const int nb = r & 31, kb = r >> 5; p0_transpose_item(w_out, D, WT_OUT, nb * 32, nb * 32, kb * 64, scr, lane); continue; } r -= I_SQ;
            if (r < I_SQ) { const int nb = r & 31, kb = r >> 5; p0_transpose_item(w_xq, D, WT_XQ, nb * 32, nb * 32, kb * 64, scr, lane, norm_xa_w); continue; } r -= I_SQ;
            if (r < I_SQ) { const int nb = r & 31, kb = r >> 5; p0_transpose_item(w_xo, D, WT_XO, nb * 32, nb * 32, kb * 64, scr, lane); continue; } r -= I_SQ;
            { const int nb = r & 63, kb = r >> 6; p0_transpose_item(w_xkv, 2048, WT_XKV, nb * 32, nb * 32, kb * 64, scr, lane); }
        }
        for (int it = gw; it < 256 * 16; it += NGW) { const int n = it >> 4, k = (it & 15) * 64 + lane; float s = 0.f;
#pragma unroll
            for (int r = 0; r < 16; ++r) s += w_in[(size_t)k * INW + C_GLR + r] * w_gk2[r * 256 + n];
            WT_IN[(size_t)(C_GLR + n) * D + k] = (bf16)f2bf(s); }
        if (bx == 0) { const int j = tid; LB[j] = 1.f / (1.f + __expf(lb_logits[512 + j] - lb_logits[j])); }
        for (int m = gw; m < NTOK; m += 2 * NGW) rms_2rows_to_bf16(x + (size_t)m * D, x + (size_t)(m + NGW) * D, norm_mix_w, HB + (size_t)m * D, HB + (size_t)(m + NGW) * D, lane);
        for (int m = gw; m < NMEM; m += NGW) rms_row_to_bf16(mem + (size_t)m * D, norm_mem_w, HMB + (size_t)m * D, lane);
    }
    SEAM(0);
    if (IN(1)) { const int lane = fresh_lane(), tid = wave * 64 + lane; (void)tid;
        pg8::SchedP1 S{(const char*)HB, (const char*)WT_IN, (const char*)HMB, (const char*)WT_XKV, G, bx};
        pg8::EpiP1 E{PB, Gd, KB, VT, LB, b_gk};
        pg8::gemm_phase<pg8::EpiP1, pg8::SchedP1>(lds + RING_OFF, S, E, tid, wave);
    }
    SEAM(1);

    const float* hg_onorm_w = args.in[5]; const float* gla_onorm_w = args.in[8];
    const float* w_router = args.in[16]; const float* b_router = args.in[17]; const float* b_gu = args.in[19]; const float* b_down = args.in[21]; const float* norm_final_w = args.in[22];
    bf16* Y = (bf16*)(ws + WS_Y); bf16* Q = (bf16*)(ws + WS_Q); bf16* AO = (bf16*)(ws + WS_AO); float* X1 = (float*)(ws + WS_X1);
    bf16* XG = (bf16*)(ws + WS_XG); bf16* ACT = (bf16*)(ws + WS_ACT); bf16* YB = (bf16*)(ws + WS_YB);
    int* tok_e = (int*)(ws + WS_TOKE); float* tok_g = (float*)(ws + WS_TOKG); int* tok_dest = (int*)(ws + WS_TOKDEST); float* row_gate = (float*)(ws + WS_ROWGATE);
    float* SSQ1 = (float*)(ws + WS_SSQ); float* tok_rstd = (float*)(ws + WS_TOKRSTD); float* row_rstd = (float*)(ws + WS_ROWRSTD);
    unsigned char* HB8 = ws + WS_XG; int* row_tok = (int*)(ws + WS_XG + 32 * MiB);
    int* HIST = (int*)(ws + WS_TAB + OFF_HIST); int* tile_e = (int*)(ws + WS_TAB + OFF_TILEE); int* nrt_p = (int*)(ws + WS_TAB + OFF_NRT);
    if (IN(2)) { const int lane = fresh_lane(), tid = wave * 64 + lane; (void)tid;
        unsigned char* blobs = ws + WS_YB;
        {
            float gA[16]; unsigned short qA[16], kA[16]; float gB[8]; unsigned short qB[8], kB[8];
            { const int sq = vcu & 31, c = vcu >> 5; prep_load<128, 0>(gA, qA, kA, PB, Gd, sq >> 2, sq & 3, c, tid); }
#pragma unroll 1
            for (int j = 0; j < 4; ++j) { const int rest = j * 256 + vcu, sq = rest & 31, c = rest >> 5;
                prep_p1<128>(gA, qA, kA, lds + RING_OFF, tid);
                prep_load<64, 1>(gB, qB, kB, PB, Gd, sq >> 2, sq & 3, c, tid);
                prep_p2<128>(lds + RING_OFF, blobs + blob_off(0, sq >> 2, sq & 3, c), tid);
                prep_p1<64>(gB, qB, kB, lds + RING_OFF, tid);
                if (j < 3) { const int rest2 = (j + 1) * 256 + vcu, sq2 = rest2 & 31, c2 = rest2 >> 5; prep_load<128, 0>(gA, qA, kA, PB, Gd, sq2 >> 2, sq2 & 3, c2, tid); }
                prep_p2<64>(lds + RING_OFF, blobs + blob_off(1, sq >> 2, sq & 3, c), tid); }
            asm volatile("s_waitcnt vmcnt(0)" ::: "memory");
        }
        xcd_barrier(bar, wave == 0 && fresh_lane() == 0);
        if ((vcu & 3) == 0) { const int sidx = vcu >> 2, grp = sidx >> 5, sq = sidx & 31;
            if (grp == 0) scan128<128, 0>(lds + RING_OFF, PB, blobs + blob_off(0, sq >> 2, sq & 3, 0), Y, hg_onorm_w, sq >> 2, sq & 3, tid, lane, wave);
            else scan128<64, 1>(lds + RING_OFF, PB, blobs + blob_off(1, sq >> 2, sq & 3, 0), Y, gla_onorm_w, sq >> 2, sq & 3, tid, lane, wave); }
        else {
            LAS float* scr = (LAS float*)(lds + RING_OFF + wave * 16384);
            constexpr int I_GU = 16 * 64, I_DN = 16 * 32;
            constexpr int CVW = 4;
            const int cidx = (vcu >> 2) * 3 + (vcu & 3) - 1, gw = wave < CVW ? cidx * CVW + wave : (1 << 30), NGW = 192 * CVW;
#define CV_DECODE(it, W_, ldw_, WT_, dr_, n0_, k0_, ks_) const float* W_; int ldw_, dr_, n0_, k0_; bf16* WT_; const float* ks_; { const int e_ = (it) / (I_GU + I_DN); int r_ = (it) - e_ * (I_GU + I_DN); \
                if (r_ < I_GU) { const int nb_ = r_ & 63, kb_ = r_ >> 6; W_ = w_gu + (size_t)e_ * D * 2048; ldw_ = 2048; WT_ = (bf16*)((unsigned char*)WT_GU + (size_t)e_ * 2048 * D * (MOE_FP8 ? 1 : 2)); dr_ = gu_rowmap(nb_ * 32); n0_ = nb_ * 32; k0_ = kb_ * 64; ks_ = norm_moe_w; } \
                else { r_ -= I_GU; const int nb_ = r_ & 31, kb_ = r_ >> 5; W_ = w_down + (size_t)e_ * D * D; ldw_ = D; WT_ = (bf16*)((unsigned char*)WT_DN + (size_t)e_ * D * D * (MOE_FP8 ? 1 : 2)); dr_ = nb_ * 32; n0_ = nb_ * 32; k0_ = kb_ * 64; ks_ = nullptr; } }
            constexpr int NIT = NEXP * (I_GU + I_DN);
            float ra[32], rb[32];
            int it = gw;
            if (it < NIT) { CV_DECODE(it, W0, l0, T0, d0, n0, k0, s0) (void)T0; (void)d0; (void)s0; p0_item_load(ra, W0, l0, n0, k0, lane); }
            while (it < NIT) {
                const int it2 = it + NGW;
                if (it2 < NIT) { CV_DECODE(it2, W1, l1, T1, d1, n1, k1, s1) (void)T1; (void)d1; (void)s1; p0_item_load(rb, W1, l1, n1, k1, lane); }
                { CV_DECODE(it, W0, l0, T0, d0, n0, k0, s0) (void)W0; (void)l0; (void)n0; p0_item_finish(ra, T0, d0, k0, scr, lane, s0); }
                if (it2 >= NIT) break;
                const int it3 = it2 + NGW;
                if (it3 < NIT) { CV_DECODE(it3, W0, l0, T0, d0, n0, k0, s0) (void)T0; (void)d0; (void)s0; p0_item_load(ra, W0, l0, n0, k0, lane); }
                { CV_DECODE(it2, W1, l1, T1, d1, n1, k1, s1) (void)W1; (void)l1; (void)n1; p0_item_finish(rb, T1, d1, k1, scr, lane, s1); }
                it = it3;
            }
#undef CV_DECODE
        }
    }
    SEAM(2);
    if (IN(3)) { const int lane = fresh_lane(), tid = wave * 64 + lane; (void)tid;
        pg8::SchedDense S{(const char*)Y, (const char*)WT_OUT, 64, 4, G, bx};
        pg8::EpiRes1 E{x, HB, SSQ1};
        pg8::gemm_phase<pg8::EpiRes1, pg8::SchedDense>(lds + RING_OFF, S, E, tid, wave);
    }
    SEAM(3);
    if (IN(5)) { const int lane = fresh_lane(), tid = wave * 64 + lane; (void)tid;
        pg8::SchedDense S{(const char*)HB, (const char*)WT_XQ, 64, 4, G, bx};
        pg8::EpiBf16S E{Q, 0.0625f, SSQ1};
        pg8::gemm_phase<pg8::EpiBf16S, pg8::SchedDense>(lds + RING_OFF, S, E, tid, wave);
        if (bx < 256) { int pm, pn; pg8::static_tile(bx, 64, 4, pm, pn);
            attn_unit(lds + RING_OFF, Q, KB, VT, AO, pm >> 3, pn, pm & 7, lane, wave); }
    }
    SEAM(6);
    if (IN(7)) { const int lane = fresh_lane(), tid = wave * 64 + lane; (void)tid;
        pg8::SchedDense S{(const char*)AO, (const char*)WT_XO, 64, 4, G, bx};
        pg8::EpiRes2 E{HB, MOE_FP8 ? HB8 : nullptr};
        pg8::gemm_phase<pg8::EpiRes2, pg8::SchedDense>(lds + RING_OFF, S, E, tid, wave);
    }
    SEAM(7);
    if (IN(8)) { const int lane = fresh_lane(), tid = wave * 64 + lane; (void)tid;
        LAS float* part = (LAS float*)(lds + RING_OFF);
        LAS float* ssqp = part + 8 * 2 * 32 * 32;
        LAS float* LG = ssqp + 8 * 64;
        LAS float* RSD = LG + 64 * 33;
        LAS int* hist = (LAS int*)(lds + LDSCTL_OFF);
        if (tid < 32) hist[tid] = 0;
        const float my_br = b_router[tid & 31];
        {
            const int r = lane & 31, hh = lane >> 5;
            u32x4 xw2[2][8];
#pragma unroll
            for (int tt = 0; tt < 2; ++tt) { const bf16* xp = HB + (size_t)(vcu * 64 + 32 * tt + r) * D + 128 * wave + 8 * hh;
#pragma unroll
                for (int s2 = 0; s2 < 8; ++s2) xw2[tt][s2] = *(const u32x4*)(xp + 16 * s2); }
            u32x4 bh[8], bl[8];
#pragma unroll
            for (int s2 = 0; s2 < 8; ++s2) { const int k0 = 128 * wave + 16 * s2 + 8 * hh; float wv[8];
                const f32x4 n0 = *(const f32x4*)(norm_moe_w + k0), n1 = *(const f32x4*)(norm_moe_w + k0 + 4);
#pragma unroll
                for (int j = 0; j < 8; ++j) wv[j] = w_router[(size_t)(k0 + j) * 32 + r] * (j < 4 ? n0[j] : n1[j - 4]);
                unsigned hw[4], lw[4];
#pragma unroll
                for (int j = 0; j < 4; ++j) { hw[j] = cvtpk(wv[2 * j], wv[2 * j + 1]); lw[j] = cvtpk(wv[2 * j] - bf2f(hw[j] & 0xffffu), wv[2 * j + 1] - bf2f(hw[j] >> 16)); }
                bh[s2] = (u32x4){hw[0], hw[1], hw[2], hw[3]}; bl[s2] = (u32x4){lw[0], lw[1], lw[2], lw[3]}; }
#pragma unroll
            for (int tt = 0; tt < 2; ++tt) { f32x16 acc; float ss = 0.f;
#pragma unroll
                for (int e = 0; e < 16; ++e) acc[e] = 0.f;
#pragma unroll
                for (int s2 = 0; s2 < 8; ++s2) { const u32x4 xw = xw2[tt][s2];
                    const float x0 = bf2f(xw.x & 0xffffu), x1 = bf2f(xw.x >> 16), x2 = bf2f(xw.y & 0xffffu), x3 = bf2f(xw.y >> 16), x4 = bf2f(xw.z & 0xffffu), x5 = bf2f(xw.z >> 16), x6 = bf2f(xw.w & 0xffffu), x7 = bf2f(xw.w >> 16);
                    ss += ((x0 * x0 + x1 * x1) + (x2 * x2 + x3 * x3)) + ((x4 * x4 + x5 * x5) + (x6 * x6 + x7 * x7));
                    const bf16x8 ah = __builtin_bit_cast(bf16x8, xw);
                    acc = __builtin_amdgcn_mfma_f32_32x32x16_bf16(ah, __builtin_bit_cast(bf16x8, bh[s2]), acc, 0, 0, 0);
                    acc = __builtin_amdgcn_mfma_f32_32x32x16_bf16(ah, __builtin_bit_cast(bf16x8, bl[s2]), acc, 0, 0, 0); }
#pragma unroll
                for (int reg = 0; reg < 16; ++reg) part[((wave * 2 + tt) * 32 + (reg & 3) + 8 * (reg >> 2) + 4 * hh) * 32 + r] = acc[reg];
                ss += __shfl_xor(ss, 32);
                if (hh == 0) ssqp[wave * 64 + 32 * tt + r] = ss; }
        }
        __syncthreads();
#pragma unroll
        for (int o = 0; o < 4; ++o) { const int idx = tid + 512 * o, tok = idx >> 5, e = idx & 31, tt = tok >> 5, tl = tok & 31; float sum = 0.f, sq = 0.f;
#pragma unroll
            for (int w = 0; w < 8; ++w) { sum += part[((w * 2 + tt) * 32 + tl) * 32 + e]; sq += ssqp[w * 64 + tok]; }
            const float rs = rsqrtf(sq * (1.f / D) + EPS);
            LG[tok * 33 + e] = sum * rs + my_br; if (e == 0) RSD[tok] = rs; }
        __syncthreads();
        if (wave == 0) {
            const int tok = vcu * 64 + lane; float l[32];
#pragma unroll
            for (int i = 0; i < 32; ++i) l[i] = LG[lane * 33 + i];
            int idx[4]; float val[4]; unsigned used = 0u;
#pragma unroll
            for (int k = 0; k < 4; ++k) { float best = -INFINITY; int bi = 0;
#pragma unroll
                for (int i = 0; i < 32; ++i) { const bool ok = !((used >> i) & 1u) && (l[i] > best); best = ok ? l[i] : best; bi = ok ? i : bi; }
                used |= 1u << bi; idx[k] = bi; val[k] = best; }
            float e4[4], es = 0.f;
#pragma unroll
            for (int k = 0; k < 4; ++k) { e4[k] = __expf(val[k] - val[0]); es += e4[k]; }
            const float ri = 1.f / es;
            *(int4*)(tok_e + tok * 4) = make_int4(idx[0], idx[1], idx[2], idx[3]);
            *(f32x4*)(tok_g + tok * 4) = (f32x4){e4[0] * ri, e4[1] * ri, e4[2] * ri, e4[3] * ri};
#pragma unroll
            for (int k = 0; k < 4; ++k) __hip_atomic_fetch_add(&hist[idx[k]], 1, __ATOMIC_RELAXED, __HIP_MEMORY_SCOPE_WORKGROUP);
        }
        if (tid < 64) tok_rstd[vcu * 64 + tid] = RSD[tid];
        __syncthreads();
        if (tid < 32) { HIST[vcu * 32 + tid] = hist[tid]; }
        __syncthreads();
        if (tid < 32) hist[tid] = 0;
    }
    SEAM(8);
    if (IN(9)) { const int lane = fresh_lane(), tid = wave * 64 + lane; (void)tid;
        LAS int* part = (LAS int*)(lds + RING_OFF);
        LAS int* base = part + 1024; LAS int* ea = base + 64; LAS int* dsts = ea + 256;
        int my_e = 0; float my_g = 0.f, my_rs = 0.f;
        if (tid < 256) { my_e = tok_e[vcu * 256 + tid]; my_g = tok_g[vcu * 256 + tid]; my_rs = tok_rstd[vcu * 64 + (tid >> 2)]; }
        { const int e = tid & 31, g = tid >> 5; int tot = 0, bef = 0;
#pragma unroll
            for (int w = 16 * g; w < 16 * g + 16; ++w) { const int h = HIST[w * 32 + e]; tot += h; bef += (w < vcu) ? h : 0; }
            part[g * 32 + e] = tot; part[512 + g * 32 + e] = bef; }
        if (tid < 256) ea[tid] = my_e;
        __syncthreads();
        if (tid < 32) { int tot = 0, bef = 0;
#pragma unroll
            for (int g = 0; g < 16; ++g) { tot += part[g * 32 + tid]; bef += part[512 + g * 32 + tid]; }
            const int nt = (tot + MOEB - 1) / MOEB; int inc = nt;
#pragma unroll
            for (int o = 1; o < 32; o <<= 1) { const int t = __shfl_up(inc, o); inc += (lane >= o) ? t : 0; }
            const int st = inc - nt;
            base[tid] = st * MOEB + bef;
            if (bx == 0) { for (int t = 0; t < nt; ++t) tile_e[st + t] = tid; if (tid == 31) *nrt_p = inc; } }
        __syncthreads();
        if (tid < 256) { const int e = my_e; int rank = 0; for (int a = 0; a < tid; ++a) rank += (ea[a] == e) ? 1 : 0;
            const int dest = base[e] + rank; dsts[tid] = dest; row_gate[dest] = my_g; row_rstd[dest] = my_rs; tok_dest[vcu * 256 + tid] = dest;
            if (MOE_FP8) row_tok[dest] = vcu * 64 + (tid >> 2); }
        if (!MOE_FP8) __syncthreads();
        if (!MOE_FP8)
        for (int tt = 0; tt < 8; ++tt) { const int ti = wave * 8 + tt, tok = vcu * 64 + ti;
            const u32x4* src = (const u32x4*)(HB + (size_t)tok * D); const u32x4 a = src[lane], b = src[lane + 64];
            if (MOE_FP8) { if (lane < 4) row_tok[dsts[ti * 4 + lane]] = tok; continue; }
            if (false) { u32x2 a8, b8;
                a8.x = pk4_fp8(bf2f(a.x & 0xffffu), bf2f(a.x >> 16), bf2f(a.y & 0xffffu), bf2f(a.y >> 16)); a8.y = pk4_fp8(bf2f(a.z & 0xffffu), bf2f(a.z >> 16), bf2f(a.w & 0xffffu), bf2f(a.w >> 16));
                b8.x = pk4_fp8(bf2f(b.x & 0xffffu), bf2f(b.x >> 16), bf2f(b.y & 0xffffu), bf2f(b.y >> 16)); b8.y = pk4_fp8(bf2f(b.z & 0xffffu), bf2f(b.z >> 16), bf2f(b.w & 0xffffu), bf2f(b.w >> 16));
#pragma unroll
                for (int k = 0; k < 4; ++k) { u32x2* dst = (u32x2*)((unsigned char*)XG + (size_t)dsts[ti * 4 + k] * D); dst[lane] = a8; dst[lane + 64] = b8; } }
            else {
#pragma unroll
                for (int k = 0; k < 4; ++k) { u32x4* dst = (u32x4*)(XG + (size_t)dsts[ti * 4 + k] * D); dst[lane] = a; dst[lane + 64] = b; } } }
    }
    SEAM(9);
    if (IN(10)) { const int lane = fresh_lane(), tid = wave * 64 + lane; (void)tid;
        constexpr size_t EB = MOE_FP8 ? 1 : 2;
        LAS int* tile_l = (LAS int*)(lds + TILEE_OFF);
        if (tid < NRT) tile_l[tid] = tile_e[tid];
        __syncthreads();
        pg8::SchedMoe S{MOE_FP8 ? (const char*)HB8 : (const char*)XG, (const char*)WT_GU, tile_l, *nrt_p, 8, (size_t)2048 * D * EB, (size_t)256 * D * EB, G, bx, MOE_FP8 ? row_tok : nullptr, 0};
        pg8::EpiMoe1 E{(void*)ACT, b_gu, row_rstd, ctl + CW_RDY};
        if constexpr (MOE_FP8) pg8::gemm8_phase<pg8::EpiMoe1, pg8::SchedMoe, true, HANDOFF == 1 ? 1 : 0, true>(lds + RING_OFF, S, E, tid, wave, ctl + CW_RDY); else pg8::gemm_phase<pg8::EpiMoe1, pg8::SchedMoe>(lds + RING_OFF, S, E, tid, wave);
    }
    if (IN(10) && IN(11)) { if constexpr (!MOE_FP8 || DBG_BAR10 || !HANDOFF) xcd_barrier(bar, wave == 0 && fresh_lane() == 0);
        else { if constexpr (HANDOFF == 2) {
                if (wave == 0) { const int ln = fresh_lane(); __builtin_amdgcn_fence(__ATOMIC_RELEASE, "agent");
                    const int pos = (bx & 7) * (G >> 3) + (bx >> 3), U = ln * G + pos;
                    if (U < *nrt_p * 8) (void)__hip_atomic_fetch_add(ctl + CW_RDY + 64 * (U >> 3), 1u, __ATOMIC_RELAXED, __HIP_MEMORY_SCOPE_AGENT); } }
            __builtin_amdgcn_fence(__ATOMIC_ACQUIRE, "agent"); __syncthreads(); } }
    if (IN(11)) { const int lane = fresh_lane(), tid = wave * 64 + lane; (void)tid;
        constexpr size_t EB = MOE_FP8 ? 1 : 2;
        const int nrt11 = *nrt_p;
        LAS int* tile_l = (LAS int*)(lds + TILEE_OFF);
        if (!IN(10)) { if (tid < NRT) tile_l[tid] = tile_e[tid]; __syncthreads(); }
        pg8::SchedMoe S{(const char*)ACT, (const char*)WT_DN, tile_l, nrt11, 4, (size_t)D * D * EB, (size_t)256 * D * EB, G, bx, nullptr, (MOE_FP8 && HANDOFF) ? (nrt11 * 8) % G : 0};
        pg8::EpiMoe2 E{(void*)YB, b_down, row_gate};
        if constexpr (MOE_FP8) pg8::gemm8_phase<pg8::EpiMoe2, pg8::SchedMoe, false, HANDOFF ? 2 : 0, true>(lds + RING_OFF, S, E, tid, wave, ctl + CW_RDY); else pg8::gemm_phase<pg8::EpiMoe2, pg8::SchedMoe>(lds + RING_OFF, S, E, tid, wave);
    }
    SEAM(11);
    if (IN(12)) { const int lane = fresh_lane(), tid = wave * 64 + lane; (void)tid;
        const int gw = vcu * NWAVES + wave, NGW = G * NWAVES;
        for (int m = gw; m < NTOK; m += NGW) {
            const u32x2* xr = (const u32x2*)(HB + (size_t)m * D) + lane;
            f32x4 v[4];
#pragma unroll
            for (int j = 0; j < 4; ++j) { const u32x2 xw = xr[64 * j]; v[j] = (f32x4){bf2f(xw.x & 0xffffu), bf2f(xw.x >> 16), bf2f(xw.y & 0xffffu), bf2f(xw.y >> 16)}; }
#pragma unroll
            for (int k = 0; k < 4; ++k) {
                if (MOE_FP8) { const unsigned* yr = (const unsigned*)((const unsigned char*)YB + (size_t)tok_dest[m * 4 + k] * D) + lane;
#pragma unroll
                    for (int j = 0; j < 4; ++j) { const unsigned y = yr[64 * j]; const f32x2_t lo = __builtin_amdgcn_cvt_pk_f32_fp8((int)y, false), hi = __builtin_amdgcn_cvt_pk_f32_fp8((int)y, true);
                        v[j].x += lo[0] * (1.f / Y8S); v[j].y += lo[1] * (1.f / Y8S); v[j].z += hi[0] * (1.f / Y8S); v[j].w += hi[1] * (1.f / Y8S); } }
                else { const u32x2* yr = (const u32x2*)(YB + (size_t)tok_dest[m * 4 + k] * D) + lane;
#pragma unroll
                    for (int j = 0; j < 4; ++j) { const u32x2 y = yr[64 * j]; v[j].x += bf2f(y.x & 0xffffu); v[j].y += bf2f(y.x >> 16); v[j].z += bf2f(y.y & 0xffffu); v[j].w += bf2f(y.y >> 16); } } }
            float s = 0.f;
#pragma unroll
            for (int j = 0; j < 4; ++j) s += (v[j].x * v[j].x + v[j].y * v[j].y) + (v[j].z * v[j].z + v[j].w * v[j].w);
            const float r = rsqrtf(wave_sum(s) * (1.f / D) + EPS);
            f32x4* o = (f32x4*)(args.out + (size_t)m * D) + lane;
#pragma unroll
            for (int j = 0; j < 4; ++j) { const f32x4 ww = ((const f32x4*)norm_final_w)[lane + 64 * j]; o[64 * j] = v[j] * r * ww; }
        }
    }
#undef IN
#undef SEAM
}

static void mega_launch(void* const* d_in, float* out, char* ws, int lo, int hi, int li, hipStream_t stream) {
    static bool attr = false;
    if (!attr) { if (hipFuncSetAttribute((const void*)mega_fwd, hipFuncAttributeMaxDynamicSharedMemorySize, LDS_BYTES) != hipSuccess) fprintf(stderr, "mega_launch: hipFuncSetAttribute failed\n"); attr = true; }
    Args a{};
    for (int i = 0; i < 23; ++i) a.in[i] = (const float*)d_in[i];
    a.out = out; a.ws = (unsigned char*)ws; a.ph_lo = lo; a.ph_hi = hi; a.li = li;
    hipLaunchKernelGGL(mega_fwd, dim3(256), dim3(NWAVES * 64), LDS_BYTES, stream, a);
    const hipError_t le = hipPeekAtLastError();
    if (le != hipSuccess) fprintf(stderr, "mega_launch: launch failed: %s\n", hipGetErrorName(le));
}
extern "C" void kernel_launch(void* const* d_in, const int* in_sizes, int n_in, void* d_out, int out_size, void* d_ws, size_t ws_size, hipStream_t stream) {
    if (n_in != 23 || ws_size < WS_END || out_size != NTOK * D) { fprintf(stderr, "kernel_launch: bad args n_in %d ws %zu out %d\n", n_in, ws_size, out_size); return; }
    (void)in_sizes;
    if (HANDOFF) (void)hipMemsetAsync((char*)d_ws + WS_CTL, 0, CTL_ZERO_BYTES, stream);
    else (void)hipMemsetAsync((char*)d_ws + WS_CTL + (size_t)CW_BAR * 4, 0, 16384, stream);
    mega_launch(d_in, (float*)d_out, (char*)d_ws, 0, 13, 0, stream);
}
```

```cpp
#define MEGA_MASK 0x1FFF
#include <hip/hip_runtime.h>
#include <cstdio>
#include <cstdint>

typedef unsigned short bf16;
constexpr int D = 1024, BATCH = 8, SEQ = 2048, NTOK = BATCH * SEQ, MEML = 256, NMEM = BATCH * MEML;
constexpr int INW = 3600;
constexpr int PBW = 3584;
constexpr int GW = 768;
constexpr int NIN = 3840;
constexpr int C_HQ = 0, C_HF = 512, C_HI = 1024, C_HGATE = 1536, C_GQ = 2048, C_GK = 2304, C_GV = 2560, C_GGATE = 3072, C_GLR = 3584;
constexpr int NEXP = 32, TOPK = 4, NASSIGN = NTOK * TOPK, MOEB = 256, NROWS = NASSIGN + NEXP * MOEB, NRT = NROWS / MOEB;
constexpr float EPS = 1e-6f;

constexpr size_t MiB = 1u << 20;
constexpr size_t WS_CTL = 0, CTL_ZERO_BYTES = 1 * MiB;
constexpr int CW_TMO = 0, CW_CODE = 1, CW_BAR = 32768, CW_COUNTS = 16384, CW_FILL = 16384 + 64, CW_RDY = 65536;
constexpr size_t WS_TAB = 1 * MiB;
constexpr size_t OFF_LB = 0, OFF_PSTART = 4096, OFF_TILEE = 8192, OFF_NRT = 12288, OFF_HIST = 16384;
constexpr size_t WS_TOKE = 2 * MiB, WS_TOKG = WS_TOKE + 256 * 1024, WS_TOKDEST = WS_TOKG + 256 * 1024, WS_ROWGATE = WS_TOKDEST + 256 * 1024;
constexpr size_t WS_TOKRSTD = 3 * MiB + 64 * 1024, WS_ROWRSTD = 3 * MiB + 128 * 1024, WS_SSQ = 726 * MiB;
constexpr size_t WS_WT_IN = 4 * MiB;
constexpr size_t WS_WT_OUT = 12 * MiB, WS_WT_XQ = 14 * MiB, WS_WT_XKV = 16 * MiB, WS_WT_XO = 20 * MiB;
constexpr size_t WS_WT_GU = 22 * MiB;
constexpr size_t WS_WT_DN = 150 * MiB;
constexpr size_t WS_PB = 214 * MiB;
constexpr size_t WS_G = 326 * MiB;
constexpr size_t WS_XG = 214 * MiB;
constexpr size_t WS_R2 = 374 * MiB;
constexpr size_t WS_HB = WS_R2, WS_Y = WS_R2 + 32 * MiB, WS_Q = WS_R2 + 64 * MiB, WS_AO = WS_R2 + 96 * MiB, WS_HMB = WS_R2 + 128 * MiB, WS_KB = WS_R2 + 132 * MiB, WS_VT = WS_R2 + 136 * MiB;
constexpr size_t WS_ACT = WS_PB + 80 * MiB;
constexpr size_t WS_X1 = 518 * MiB;
constexpr size_t WS_YB = 582 * MiB;
constexpr size_t WS_SCR = 726 * MiB;
constexpr size_t WS_END = 966 * MiB;

__device__ __forceinline__ unsigned f2bf(float f) { unsigned u = __builtin_bit_cast(unsigned, f); return (u + 0x7fffu + ((u >> 16) & 1u)) >> 16; }
__device__ __forceinline__ float bf2f(unsigned h) { return __builtin_bit_cast(float, h << 16); }
__device__ __forceinline__ unsigned pk2(float lo, float hi) { return f2bf(lo) | (f2bf(hi) << 16); }
__device__ __forceinline__ float wave_sum(float v) {
#pragma unroll
    for (int o = 1; o < 64; o <<= 1) v += __shfl_xor(v, o);
    return v;
}
__device__ __forceinline__ float sigmoidf_(float x) { return 1.f / (1.f + __expf(-x)); }
__device__ __forceinline__ float siluf_(float x) { return x * sigmoidf_(x); }
__device__ __forceinline__ float logsigmoidf_(float z) { return fminf(z, 0.f) - log1pf(__expf(-fabsf(z))); }
__device__ __forceinline__ int gu_rowmap(int n) { return n < 1024 ? (n >> 7) * 256 + (n & 127) : ((n - 1024) >> 7) * 256 + 128 + ((n - 1024) & 127); }
#define LAS __attribute__((address_space(3)))
#define GAS __attribute__((address_space(1)))
typedef short bf16x8 __attribute__((ext_vector_type(8)));
typedef float f32x4 __attribute__((ext_vector_type(4)));
typedef float f32x16 __attribute__((ext_vector_type(16)));
typedef unsigned u32x4 __attribute__((ext_vector_type(4)));
typedef unsigned u32x2 __attribute__((ext_vector_type(2)));
typedef short s16x4 __attribute__((ext_vector_type(4)));
typedef GAS unsigned gu32;
#define RLX_AGENT __ATOMIC_RELAXED, __HIP_MEMORY_SCOPE_AGENT
__device__ __forceinline__ int fresh_lane() { int l; asm volatile("v_mbcnt_lo_u32_b32 %0, -1, 0\n\tv_mbcnt_hi_u32_b32 %0, -1, %0" : "=v"(l)); return l; }
#define LDS_WAIT() asm volatile("s_waitcnt lgkmcnt(0)" ::: "memory")
#define VM_WAIT() asm volatile("s_waitcnt vmcnt(0)" ::: "memory")

#ifndef MOE_FP8
#define MOE_FP8 1
#endif
typedef int i32x8 __attribute__((ext_vector_type(8)));
typedef unsigned u32x8 __attribute__((ext_vector_type(8)));
constexpr float W8S = 64.f, A8S = 4.f, Y8S = 64.f;
__device__ __forceinline__ float clamp8(float x) { return __builtin_amdgcn_fmed3f(x, -448.f, 448.f); }
__device__ __forceinline__ unsigned pk4_fp8(float a, float b, float c, float d) { int w = __builtin_amdgcn_cvt_pk_fp8_f32(clamp8(a), clamp8(b), 0, false); w = __builtin_amdgcn_cvt_pk_fp8_f32(clamp8(c), clamp8(d), w, true); return (unsigned)w; }
namespace pg8 {
constexpr int BM = 256, BK = 64, HALF = 128, HTB = HALF * BK * 2, STAGE_BYTES = 8 * HTB, NXCD = 8, WGM = 8;
constexpr int KK = 1024;
__host__ __device__ __forceinline__ int lds_byte(int r, int c) { const int st = (r >> 4) * 2 + (c >> 5), rr = r & 15, cc = c & 31, ob = rr * 64 + cc * 2; return st * 1024 + (ob ^ (((ob >> 9) & 1) << 5)); }
__host__ __device__ __forceinline__ void stage_rc(int b, int& R, int& C) { const int st = b / 1024, sb = b % 1024, swz = sb ^ (((sb >> 9) & 1) << 5); R = (st >> 1) * 16 + swz / 64; C = (st & 1) * 32 + (swz % 64) / 2; }
__host__ __device__ __forceinline__ int perm32(int rho) { const int n = rho >> 4, i = rho & 15; return 8 * (i >> 2) + 4 * n + (i & 3); }
constexpr size_t TSTEP = (size_t)BM * KK * 2;

struct Unit { const char* A; const char* B; int pm, pn, aux; };

__device__ __forceinline__ void static_tile(int L, int nM, int nN, int& pm, int& pn) {
    const int nwg = nM * nN; int wgid = L; { const int q = nwg / NXCD, r = nwg % NXCD, xcd = wgid % NXCD, off = wgid / NXCD; wgid = (xcd < r ? xcd * (q + 1) : r * (q + 1) + (xcd - r) * q) + off; }
    const int nig = WGM * nN, gid = wgid / nig, fm = gid * WGM, gsz = (nM - fm) < WGM ? (nM - fm) : WGM;
    pm = fm + ((wgid % nig) % gsz); pn = (wgid % nig) / gsz;
}
struct SchedDense {
    const char* A; const char* B; int nM, nN, G, c;
    __device__ __forceinline__ bool next(int i, Unit& u) const { const int L = i * G + c; if (L >= nM * nN) return false; static_tile(L, nM, nN, u.pm, u.pn); u.A = A + (size_t)u.pm * TSTEP; u.B = B + (size_t)u.pn * TSTEP; u.aux = 0; return true; }
};
struct SchedP1 {
    const char* HB; const char* WT_IN; const char* HMB; const char* WT_XKV; int G, c;
    __device__ __forceinline__ bool next(int i, Unit& u) const {
        const int L = i * G + c;
        if (L < 960) { static_tile(L, 64, 15, u.pm, u.pn); u.A = HB + (size_t)u.pm * TSTEP; u.B = WT_IN + (size_t)u.pn * TSTEP; u.aux = 0; return true; }
        if (L < 992) { const int j = L - 960; u.pm = j >> 2; u.pn = j & 3; u.A = HMB + (size_t)u.pm * TSTEP; u.B = WT_XKV + (size_t)u.pn * TSTEP; u.aux = 1; return true; }
        if (L < 1024) { const int j = L - 992; u.pm = j >> 3; u.pn = j & 7; u.A = WT_XKV + (size_t)(4 + u.pm) * TSTEP; u.B = HMB + (size_t)u.pn * TSTEP; u.aux = 2; return true; }
        return false;
    }
};
struct SchedMoe {
    const char* A; const char* W; const LAS int* tile_e; int nrt, nct; size_t wstride, tstep; int G, c; const int* rtok; int shift;
    __device__ __forceinline__ bool next(int i, Unit& u) const {
        const int per = G >> 3, pos = (c & 7) * per + (c >> 3), E = i * G + ((pos - shift + G) % G);
        if (E >= nrt * nct) return false;
        int rt, ct;
        if (shift) { const int q = nrt & 31, nfb = nrt >> 5, ne = nfb * (32 - q) * nct;
            if (E < ne) { const int kt = E / nct; ct = E - kt * nct; const int blk = kt / (32 - q); rt = 32 * blk + q + (kt - blk * (32 - q)); }
            else { const int E2 = E - ne, kt = E2 / nct; ct = E2 - kt * nct; const int blk = kt / q; rt = 32 * blk + (kt - blk * q); } }
        else { rt = E / nct; ct = E - rt * nct; }
        const int e = tile_e[rt];
        u.pm = rt; u.pn = ct; u.aux = e; u.A = rtok ? A : A + (size_t)rt * tstep; u.B = W + (size_t)e * wstride + (size_t)ct * tstep; return true;
    }
};

__device__ __forceinline__ unsigned cvt_pk_bf16(float lo, float hi) { unsigned r; asm volatile("v_cvt_pk_bf16_f32 %0, %1, %2" : "=v"(r) : "v"(lo), "v"(hi)); return r; }
__device__ __forceinline__ float fast_sigmoid(float x) { return __builtin_amdgcn_rcpf(1.f + __expf(-x)); }
__device__ __forceinline__ f32x4 silu4(f32x4 v) { f32x4 o; o[0] = v[0] * fast_sigmoid(v[0]); o[1] = v[1] * fast_sigmoid(v[1]); o[2] = v[2] * fast_sigmoid(v[2]); o[3] = v[3] * fast_sigmoid(v[3]); return o; }
typedef _Float16 h16x2 __attribute__((ext_vector_type(2)));
__device__ __forceinline__ unsigned pkh2(float a, float b) { const h16x2 h = {(_Float16)a, (_Float16)b}; return __builtin_bit_cast(unsigned, h); }
__device__ __forceinline__ u32x4 pack8h(f32x4 a, f32x4 b) { u32x4 w; w.x = pkh2(a[0], a[1]); w.y = pkh2(a[2], a[3]); w.z = pkh2(b[0], b[1]); w.w = pkh2(b[2], b[3]); return w; }
__device__ __forceinline__ u32x4 pack8(f32x4 a, f32x4 b) { u32x4 w; w.x = cvt_pk_bf16(a[0], a[1]); w.y = cvt_pk_bf16(a[2], a[3]); w.z = cvt_pk_bf16(b[0], b[1]); w.w = cvt_pk_bf16(b[2], b[3]); return w; }

#define EPI_ROWS(...) _Pragma("unroll") for (int ai = 0; ai < 2; ++ai) _Pragma("unroll") for (int m = 0; m < 4; ++m) { const int row = row0 + ai * HALF + m * 16; _Pragma("unroll") for (int bj = 0; bj < 2; ++bj) { const f32x4 v0 = acc[ai][bj][m][0], v1 = acc[ai][bj][m][1]; __VA_ARGS__ } }

__device__ __forceinline__ void st16_wt(void* p, u32x4 v) { asm volatile("global_store_dwordx4 %0, %1, off sc1\n\ts_nop 1" :: "v"(p), "v"(v) : "memory"); }
#ifndef WT_STORES
#define WT_STORES 1
#endif
template <int W> __device__ __forceinline__ void st16(void* p, u32x4 v) { if (W) st16_wt(p, v); else *(u32x4*)p = v; }
#ifndef WT3
#define WT3 0
#endif
#ifndef WT7
#define WT7 0
#endif
#ifndef WT11
#define WT11 0
#endif
struct EpiP1 {
    bf16* PB; _Float16* G; bf16* KB; bf16* VT; const float* LB; const float* b_gk;
    template <int TY> __device__ __forceinline__ void tile(const f32x4 (&acc)[2][2][4][2], const Unit& u, int row0, int cl) const {
        f32x4 p0[2], p1[2];
#pragma unroll
        for (int bj = 0; bj < 2; ++bj) { const int c = u.pn * 256 + bj * HALF + cl;
            if (TY == 3) { p0[bj] = *(const f32x4*)(LB + (c - C_HF)); p1[bj] = *(const f32x4*)(LB + (c - C_HF) + 4); }
            else if (TY == 4) { p0[bj] = *(const f32x4*)(b_gk + (c - C_GLR)); p1[bj] = *(const f32x4*)(b_gk + (c - C_GLR) + 4); }
            else { p0[bj] = (f32x4){0.f, 0.f, 0.f, 0.f}; p1[bj] = p0[bj]; } }
        EPI_ROWS({
            const int c = u.pn * 256 + bj * HALF + cl;
            if (TY == 0) *(u32x4*)(PB + (size_t)row * PBW + c) = pack8(v0, v1);
            else if (TY == 1) *(u32x4*)(PB + (size_t)row * PBW + c) = pack8(silu4(v0), silu4(v1));
            else if (TY == 2) *(u32x4*)(PB + (size_t)row * PBW + c) = pack8(v0 * 0.125f, v1 * 0.125f);
            else if (TY == 3) { f32x4 f0, f1, k0, k1, g0, g1;
_Pragma("unroll")
                for (int j = 0; j < 4; ++j) { f0[j] = p0[bj][j] + (1.f - p0[bj][j]) * fast_sigmoid(v0[j]); f1[j] = p1[bj][j] + (1.f - p1[bj][j]) * fast_sigmoid(v1[j]);
                    k0[j] = 1.f - f0[j]; k1[j] = 1.f - f1[j]; g0[j] = __logf(f0[j]); g1[j] = __logf(f1[j]); }
                *(u32x4*)(PB + (size_t)row * PBW + c) = pack8(k0, k1);
                *(u32x4*)(G + (size_t)row * GW + (c - C_HF)) = pack8h(g0, g1); }
            else { f32x4 g0, g1;
_Pragma("unroll")
                for (int j = 0; j < 4; ++j) { const float z0 = v0[j] + p0[bj][j], z1 = v1[j] + p1[bj][j];
                    g0[j] = (fminf(z0, 0.f) - __logf(1.f + __expf(-fabsf(z0)))) * 0.0625f; g1[j] = (fminf(z1, 0.f) - __logf(1.f + __expf(-fabsf(z1)))) * 0.0625f; }
                *(u32x4*)(G + (size_t)row * GW + 512 + (c - C_GLR)) = pack8h(g0, g1); }
        })
    }
    __device__ __forceinline__ void operator()(const f32x4 (&acc)[2][2][4][2], const Unit& u, int wr, int wc, int fr, int fq) const {
        const int row0 = u.pm * BM + wr * 64 + fr, cl = wc * 32 + 8 * fq;
        if (u.aux == 0) {
            const int pn = u.pn;
            if (pn == 2 || pn == 3) tile<3>(acc, u, row0, cl);
            else if (pn == 14) tile<4>(acc, u, row0, cl);
            else if (pn == 8) tile<2>(acc, u, row0, cl);
            else if (pn < 2 || pn == 6 || pn == 7 || pn == 12 || pn == 13) tile<1>(acc, u, row0, cl);
            else tile<0>(acc, u, row0, cl);
        } else if (u.aux == 1) {
            EPI_ROWS({ *(u32x4*)(KB + (size_t)row * D + u.pn * 256 + bj * HALF + cl) = pack8(v0, v1); })
        } else {
            EPI_ROWS({ *(u32x4*)(VT + (size_t)row * NMEM + u.pn * 256 + bj * HALF + cl) = pack8(v0, v1); })
        }
    }
};
struct EpiRes1 {
    const float* R; bf16* XB; float* SSQ;
    __device__ __forceinline__ void operator()(const f32x4 (&acc)[2][2][4][2], const Unit& u, int wr, int wc, int fr, int fq) const {
        const int row0 = u.pm * BM + wr * 64 + fr, cl = wc * 32 + 8 * fq;
#pragma unroll
        for (int ai = 0; ai < 2; ++ai)
#pragma unroll
            for (int m = 0; m < 4; ++m) { const int row = row0 + ai * HALF + m * 16; const size_t off = (size_t)row * D + u.pn * 256 + cl;
                f32x4 r[2][2]; float ss = 0.f;
#pragma unroll
                for (int bj = 0; bj < 2; ++bj) { r[bj][0] = *(const f32x4*)(R + off + bj * HALF); r[bj][1] = *(const f32x4*)(R + off + bj * HALF + 4); }
#pragma unroll
                for (int bj = 0; bj < 2; ++bj) { const f32x4 c0 = r[bj][0] + acc[ai][bj][m][0], c1 = r[bj][1] + acc[ai][bj][m][1];
                    st16<WT3>(XB + off + bj * HALF, pack8(c0, c1));
                    ss += ((c0[0] * c0[0] + c0[1] * c0[1]) + (c0[2] * c0[2] + c0[3] * c0[3])) + ((c1[0] * c1[0] + c1[1] * c1[1]) + (c1[2] * c1[2] + c1[3] * c1[3])); }
                ss += __shfl_xor(ss, 16); ss += __shfl_xor(ss, 32);
                if (fq == 0) SSQ[(size_t)row * 16 + u.pn * 4 + wc] = ss;
                if (m & 1) asm volatile("" ::: "memory"); }
    }
};
struct EpiRes2 {
    bf16* XB; unsigned char* X8;
    __device__ __forceinline__ void operator()(const f32x4 (&acc)[2][2][4][2], const Unit& u, int wr, int wc, int fr, int fq) const {
        const int row0 = u.pm * BM + wr * 64 + fr, cl = wc * 32 + 8 * fq;
#pragma unroll
        for (int ai = 0; ai < 2; ++ai)
#pragma unroll
            for (int mp = 0; mp < 4; mp += 2) {
                u32x4 r[2][2]; u32x2 w8[2][2];
#pragma unroll
                for (int q = 0; q < 2; ++q)
#pragma unroll
                    for (int bj = 0; bj < 2; ++bj) r[q][bj] = *(const u32x4*)(XB + (size_t)(row0 + ai * HALF + (mp + q) * 16) * D + u.pn * 256 + cl + bj * HALF);
#pragma unroll
                for (int q = 0; q < 2; ++q) { const int m = mp + q; const size_t off = (size_t)(row0 + ai * HALF + m * 16) * D + u.pn * 256 + cl;
#pragma unroll
                    for (int bj = 0; bj < 2; ++bj) { const f32x4 c0 = (f32x4){bf2f(r[q][bj].x & 0xffffu), bf2f(r[q][bj].x >> 16), bf2f(r[q][bj].y & 0xffffu), bf2f(r[q][bj].y >> 16)} + acc[ai][bj][m][0],
                                                                  c1 = (f32x4){bf2f(r[q][bj].z & 0xffffu), bf2f(r[q][bj].z >> 16), bf2f(r[q][bj].w & 0xffffu), bf2f(r[q][bj].w >> 16)} + acc[ai][bj][m][1];
                        st16<WT7>(XB + off + bj * HALF, pack8(c0, c1));
                        w8[q][bj].x = pk4_fp8(c0[0], c0[1], c0[2], c0[3]); w8[q][bj].y = pk4_fp8(c1[0], c1[1], c1[2], c1[3]); } }
                if (X8) {
#pragma unroll
                    for (int bj = 0; bj < 2; ++bj) { const u32x2 rx = __builtin_amdgcn_permlane16_swap(w8[0][bj].x, w8[1][bj].x, false, false), ry = __builtin_amdgcn_permlane16_swap(w8[0][bj].y, w8[1][bj].y, false, false);
                        st16<WT7>(X8 + (size_t)(row0 + ai * HALF + (mp + (fq & 1)) * 16) * D + u.pn * 256 + bj * HALF + cl - 8 * (fq & 1), (u32x4){rx.x, ry.x, rx.y, ry.y}); } }
                asm volatile("" ::: "memory"); }
    }
};
__device__ __forceinline__ float row_rstd16(const float* SSQ, int row, int fq) {
    const f32x4 p = *(const f32x4*)(SSQ + (size_t)row * 16 + 4 * fq); float t = (p[0] + p[1]) + (p[2] + p[3]); t += __shfl_xor(t, 16); t += __shfl_xor(t, 32);
    return rsqrtf(t * (1.f / D) + EPS);
}
struct EpiBf16S {
    bf16* O; float scale; const float* SSQ;
    __device__ __forceinline__ void operator()(const f32x4 (&acc)[2][2][4][2], const Unit& u, int wr, int wc, int fr, int fq) const {
        const int row0 = u.pm * BM + wr * 64 + fr, cl = wc * 32 + 8 * fq;
        float scv[2][4];
#pragma unroll
        for (int ai = 0; ai < 2; ++ai)
#pragma unroll
            for (int m = 0; m < 4; ++m) scv[ai][m] = row_rstd16(SSQ, row0 + ai * HALF + m * 16, fq) * scale;
#pragma unroll
        for (int ai = 0; ai < 2; ++ai)
#pragma unroll
            for (int m = 0; m < 4; ++m) { const int row = row0 + ai * HALF + m * 16; const float sc = scv[ai][m];
#pragma unroll
                for (int bj = 0; bj < 2; ++bj) *(u32x4*)(O + (size_t)row * D + u.pn * 256 + bj * HALF + cl) = pack8(acc[ai][bj][m][0] * sc, acc[ai][bj][m][1] * sc); }
    }
};
typedef float f32x2 __attribute__((ext_vector_type(2)));
struct EpiMoe1 {
    void* ACT; const float* bgu; const float* row_rstd; unsigned* rdy;
    static __device__ __forceinline__ f32x2 act2(f32x2 ag, f32x2 au, f32x2 rs, f32x2 bg, f32x2 bu) {
        constexpr float OS = MOE_FP8 ? A8S : 1.f, C2 = -1.702f * 1.4426950408889634f;
        f32x2 g = ag * rs + bg, u = au * rs + bu;
        g.x = fminf(g.x, 7.f); g.y = fminf(g.y, 7.f); u.x = __builtin_amdgcn_fmed3f(u.x, -7.f, 7.f); u.y = __builtin_amdgcn_fmed3f(u.y, -7.f, 7.f);
        const f32x2 t = g * C2; f32x2 e; e.x = __builtin_amdgcn_exp2f(t.x); e.y = __builtin_amdgcn_exp2f(t.y);
        const f32x2 d = e + 1.f; f32x2 r; r.x = __builtin_amdgcn_rcpf(d.x); r.y = __builtin_amdgcn_rcpf(d.y);
        return (u * OS + OS) * (g * r);
    }
    __device__ __forceinline__ void operator()(const f32x4 (&acc)[2][2][4][2], const Unit& u, int wr, int wc, int fr, int fq) const { run<false>(acc, u, wr, wc, fr, fq, -1); }
    __device__ __forceinline__ const float* pre(const Unit& u, int idx) const { return idx < 256 ? bgu + (size_t)u.aux * 2048 + (idx >> 7) * 1024 + u.pn * HALF + (idx & 127) : row_rstd + u.pm * BM + (idx - 256); }
    __device__ __forceinline__ void run_pre0(const f32x4 (&acc)[2][2][4][2], const Unit& u, int wr, int wc, int fr, int fq, const LAS float* eb) const { run_pre<false>(acc, u, wr, wc, fr, fq, -1, eb); }
    template <bool PUB>
    __device__ __forceinline__ void run_pre(const f32x4 (&acc)[2][2][4][2], const Unit& u, int wr, int wc, int fr, int fq, int prev_pm, const LAS float* eb) const {
        int upm = __builtin_amdgcn_readfirstlane(u.pm), upn = __builtin_amdgcn_readfirstlane(u.pn); asm volatile("" : "+s"(upm), "+s"(upn));
        const int rl = wr * 64 + fr, row0 = upm * BM + rl, cl = wc * 32 + 8 * fq, c = upn * HALF + cl;
        const f32x4 bg0 = *(const LAS f32x4*)(eb + cl), bg1 = *(const LAS f32x4*)(eb + cl + 4), bu0 = *(const LAS f32x4*)(eb + 128 + cl), bu1 = *(const LAS f32x4*)(eb + 128 + cl + 4);
        float rsv[2][4];
#pragma unroll
        for (int ai = 0; ai < 2; ++ai)
#pragma unroll
            for (int m = 0; m < 4; ++m) rsv[ai][m] = eb[256 + rl + ai * HALF + m * 16] * (1.f / W8S);
        u32x4 o[2][2];
#pragma unroll
        for (int ai = 0; ai < 2; ++ai)
#pragma unroll
            for (int mp = 0; mp < 4; mp += 2) { u32x2 wq[2];
#pragma unroll
                for (int q = 0; q < 2; ++q) { const int m = mp + q; const f32x2 rs = {rsv[ai][m], rsv[ai][m]};
                    const f32x4 g0 = acc[ai][0][m][0], g1 = acc[ai][0][m][1], u0 = acc[ai][1][m][0], u1 = acc[ai][1][m][1];
                    const f32x2 a = act2((f32x2){g0[0], g0[1]}, (f32x2){u0[0], u0[1]}, rs, (f32x2){bg0[0], bg0[1]}, (f32x2){bu0[0], bu0[1]}), b2 = act2((f32x2){g0[2], g0[3]}, (f32x2){u0[2], u0[3]}, rs, (f32x2){bg0[2], bg0[3]}, (f32x2){bu0[2], bu0[3]});
                    const f32x2 c2 = act2((f32x2){g1[0], g1[1]}, (f32x2){u1[0], u1[1]}, rs, (f32x2){bg1[0], bg1[1]}, (f32x2){bu1[0], bu1[1]}), d2 = act2((f32x2){g1[2], g1[3]}, (f32x2){u1[2], u1[3]}, rs, (f32x2){bg1[2], bg1[3]}, (f32x2){bu1[2], bu1[3]});
                    int w0 = __builtin_amdgcn_cvt_pk_fp8_f32(a.x, a.y, 0, false); w0 = __builtin_amdgcn_cvt_pk_fp8_f32(b2.x, b2.y, w0, true);
                    int w1 = __builtin_amdgcn_cvt_pk_fp8_f32(c2.x, c2.y, 0, false); w1 = __builtin_amdgcn_cvt_pk_fp8_f32(d2.x, d2.y, w1, true); wq[q].x = (unsigned)w0; wq[q].y = (unsigned)w1; }
                const u32x2 rx = __builtin_amdgcn_permlane16_swap(wq[0].x, wq[1].x, false, false), ry = __builtin_amdgcn_permlane16_swap(wq[0].y, wq[1].y, false, false);
                o[ai][mp >> 1] = (u32x4){rx.x, ry.x, rx.y, ry.y}; }
        if constexpr (PUB) {
            asm volatile("s_waitcnt vmcnt(0)" : "+v"(o[0][0]), "+v"(o[0][1]), "+v"(o[1][0]), "+v"(o[1][1]) :: "memory");
            if (prev_pm >= 0 && fr == 0 && fq == 0) (void)__hip_atomic_fetch_add(rdy + 64 * prev_pm, 1u, __ATOMIC_RELAXED, __HIP_MEMORY_SCOPE_AGENT);
        }
#pragma unroll
        for (int ai = 0; ai < 2; ++ai)
#pragma unroll
            for (int h = 0; h < 2; ++h) { unsigned char* dst = (unsigned char*)ACT + (size_t)(row0 + ai * HALF + (2 * h + (fq & 1)) * 16) * D + (c - 8 * (fq & 1));
                if constexpr (PUB) asm volatile("global_store_dwordx4 %0, %1, off sc1\n\ts_nop 1" :: "v"(dst), "v"(o[ai][h]) : "memory");
                else *(u32x4*)dst = o[ai][h]; }
    }
    template <bool PUB>
    __device__ __forceinline__ void run(const f32x4 (&acc)[2][2][4][2], const Unit& u, int wr, int wc, int fr, int fq, int prev_pm) const {
        int upm = __builtin_amdgcn_readfirstlane(u.pm), upn = __builtin_amdgcn_readfirstlane(u.pn), uaux = __builtin_amdgcn_readfirstlane(u.aux); asm volatile("" : "+s"(upm), "+s"(upn), "+s"(uaux));
        const int row0 = upm * BM + wr * 64 + fr, cl = wc * 32 + 8 * fq, c = upn * HALF + cl;
        const float* bb = bgu + (size_t)uaux * 2048 + c;
        const f32x4 bg0 = *(const f32x4*)bb, bg1 = *(const f32x4*)(bb + 4), bu0 = *(const f32x4*)(bb + 1024), bu1 = *(const f32x4*)(bb + 1028);
        float rsv[2][4];
#pragma unroll
        for (int ai = 0; ai < 2; ++ai)
#pragma unroll
            for (int m = 0; m < 4; ++m) rsv[ai][m] = row_rstd[row0 + ai * HALF + m * 16] * (MOE_FP8 ? 1.f / W8S : 1.f);
        if constexpr (PUB) {
            asm volatile("s_waitcnt vmcnt(0)" :: "v"(bg0), "v"(bg1), "v"(bu0), "v"(bu1), "v"(rsv[0][0]), "v"(rsv[0][1]), "v"(rsv[0][2]), "v"(rsv[0][3]), "v"(rsv[1][0]), "v"(rsv[1][1]), "v"(rsv[1][2]), "v"(rsv[1][3]) : "memory");
            if (prev_pm >= 0 && fr == 0 && fq == 0) (void)__hip_atomic_fetch_add(rdy + 64 * prev_pm, 1u, __ATOMIC_RELAXED, __HIP_MEMORY_SCOPE_AGENT);
        }
#pragma unroll
        for (int ai = 0; ai < 2; ++ai)
#pragma unroll
            for (int mp = 0; mp < 4; mp += 2) { u32x2 wq[2];
#pragma unroll
                for (int q = 0; q < 2; ++q) { const int m = mp + q; const f32x2 rs = {rsv[ai][m], rsv[ai][m]};
                    const f32x4 g0 = acc[ai][0][m][0], g1 = acc[ai][0][m][1], u0 = acc[ai][1][m][0], u1 = acc[ai][1][m][1];
                    const f32x2 a = act2((f32x2){g0[0], g0[1]}, (f32x2){u0[0], u0[1]}, rs, (f32x2){bg0[0], bg0[1]}, (f32x2){bu0[0], bu0[1]}), b2 = act2((f32x2){g0[2], g0[3]}, (f32x2){u0[2], u0[3]}, rs, (f32x2){bg0[2], bg0[3]}, (f32x2){bu0[2], bu0[3]});
                    const f32x2 c2 = act2((f32x2){g1[0], g1[1]}, (f32x2){u1[0], u1[1]}, rs, (f32x2){bg1[0], bg1[1]}, (f32x2){bu1[0], bu1[1]}), d2 = act2((f32x2){g1[2], g1[3]}, (f32x2){u1[2], u1[3]}, rs, (f32x2){bg1[2], bg1[3]}, (f32x2){bu1[2], bu1[3]});
                    if (MOE_FP8) { int w0 = __builtin_amdgcn_cvt_pk_fp8_f32(a.x, a.y, 0, false); w0 = __builtin_amdgcn_cvt_pk_fp8_f32(b2.x, b2.y, w0, true);
                        int w1 = __builtin_amdgcn_cvt_pk_fp8_f32(c2.x, c2.y, 0, false); w1 = __builtin_amdgcn_cvt_pk_fp8_f32(d2.x, d2.y, w1, true); wq[q].x = (unsigned)w0; wq[q].y = (unsigned)w1;
                        if constexpr (!PUB) *(u32x2*)((unsigned char*)ACT + (size_t)(row0 + ai * HALF + m * 16) * D + c) = wq[q]; }
                    else *(u32x4*)((bf16*)ACT + (size_t)(row0 + ai * HALF + m * 16) * D + c) = pack8((f32x4){a.x, a.y, b2.x, b2.y}, (f32x4){c2.x, c2.y, d2.x, d2.y}); }
                if constexpr (PUB && MOE_FP8) {
                    const u32x2 rx = __builtin_amdgcn_permlane16_swap(wq[0].x, wq[1].x, false, false), ry = __builtin_amdgcn_permlane16_swap(wq[0].y, wq[1].y, false, false);
                    const u32x4 o = {rx.x, ry.x, rx.y, ry.y};
                    unsigned char* dst = (unsigned char*)ACT + (size_t)(row0 + ai * HALF + (mp + (fq & 1)) * 16) * D + (c - 8 * (fq & 1));
                    asm volatile("global_store_dwordx4 %0, %1, off sc1\n\ts_nop 1" :: "v"(dst), "v"(o) : "memory"); } }
    }
};
struct EpiMoe2 {
    void* YB; const float* bd; const float* row_gate;
    __device__ __forceinline__ const float* pre(const Unit& u, int idx) const { return idx < 256 ? bd + (size_t)u.aux * D + u.pn * 256 + idx : row_gate + u.pm * BM + (idx - 256); }
    __device__ __forceinline__ void run_pre0(const f32x4 (&acc)[2][2][4][2], const Unit& u, int wr, int wc, int fr, int fq, const LAS float* eb) const {
        int upm = __builtin_amdgcn_readfirstlane(u.pm), upn = __builtin_amdgcn_readfirstlane(u.pn); asm volatile("" : "+s"(upm), "+s"(upn));
        const int rl = wr * 64 + fr, row0 = upm * BM + rl, cl = wc * 32 + 8 * fq;
        constexpr float ASC = 1.f / (W8S * A8S);
        f32x4 b0[2], b1[2];
#pragma unroll
        for (int bj = 0; bj < 2; ++bj) { b0[bj] = *(const LAS f32x4*)(eb + bj * HALF + cl); b1[bj] = *(const LAS f32x4*)(eb + bj * HALF + cl + 4); }
        float gv[2][4];
#pragma unroll
        for (int ai = 0; ai < 2; ++ai)
#pragma unroll
            for (int m = 0; m < 4; ++m) gv[ai][m] = eb[256 + rl + ai * HALF + m * 16] * Y8S;
#pragma unroll
        for (int ai = 0; ai < 2; ++ai)
#pragma unroll
            for (int mp = 0; mp < 4; mp += 2)
#pragma unroll
                for (int bj = 0; bj < 2; ++bj) { u32x2 wq[2];
#pragma unroll
                    for (int q = 0; q < 2; ++q) { const int m = mp + q; const float g = gv[ai][m];
                        const f32x4 y0 = (acc[ai][bj][m][0] * ASC + b0[bj]) * g, y1 = (acc[ai][bj][m][1] * ASC + b1[bj]) * g;
                        wq[q].x = pk4_fp8(y0[0], y0[1], y0[2], y0[3]); wq[q].y = pk4_fp8(y1[0], y1[1], y1[2], y1[3]); }
                    const u32x2 rx = __builtin_amdgcn_permlane16_swap(wq[0].x, wq[1].x, false, false), ry = __builtin_amdgcn_permlane16_swap(wq[0].y, wq[1].y, false, false);
                    st16<WT11>((unsigned char*)YB + (size_t)(row0 + ai * HALF + (mp + (fq & 1)) * 16) * D + upn * 256 + bj * HALF + cl - 8 * (fq & 1), (u32x4){rx.x, ry.x, rx.y, ry.y}); }
    }
    __device__ __forceinline__ void operator()(const f32x4 (&acc)[2][2][4][2], const Unit& u, int wr, int wc, int fr, int fq) const {
        int upm = __builtin_amdgcn_readfirstlane(u.pm), upn = __builtin_amdgcn_readfirstlane(u.pn), uaux = __builtin_amdgcn_readfirstlane(u.aux); asm volatile("" : "+s"(upm), "+s"(upn), "+s"(uaux));
        const int row0 = upm * BM + wr * 64 + fr, cl = wc * 32 + 8 * fq;
        constexpr float ASC = MOE_FP8 ? 1.f / (W8S * A8S) : 1.f;
        f32x4 b0[2], b1[2];
#pragma unroll
        for (int bj = 0; bj < 2; ++bj) { const float* bb = bd + (size_t)uaux * D + upn * 256 + bj * HALF + cl; b0[bj] = *(const f32x4*)bb; b1[bj] = *(const f32x4*)(bb + 4); }
        float gv[2][4];
#pragma unroll
        for (int ai = 0; ai < 2; ++ai)
#pragma unroll
            for (int m = 0; m < 4; ++m) gv[ai][m] = row_gate[row0 + ai * HALF + m * 16] * (MOE_FP8 ? Y8S : 1.f);
#pragma unroll
        for (int ai = 0; ai < 2; ++ai)
#pragma unroll
            for (int m = 0; m < 4; ++m) { const int row = row0 + ai * HALF + m * 16; const float g = gv[ai][m];
#pragma unroll
                for (int bj = 0; bj < 2; ++bj) { const f32x4 y0 = (acc[ai][bj][m][0] * ASC + b0[bj]) * g, y1 = (acc[ai][bj][m][1] * ASC + b1[bj]) * g;
                    if (MOE_FP8) { u32x2 w; w.x = pk4_fp8(y0[0], y0[1], y0[2], y0[3]); w.y = pk4_fp8(y1[0], y1[1], y1[2], y1[3]); *(u32x2*)((unsigned char*)YB + (size_t)row * D + upn * 256 + bj * HALF + cl) = w; }
                    else *(u32x4*)((bf16*)YB + (size_t)row * D + upn * 256 + bj * HALF + cl) = pack8(y0, y1); } }
    }
};


template <class Epi, class Sched>
__device__ __forceinline__ void gemm_phase(LAS unsigned char* lds, const Sched& S, const Epi& E, const int tid, const int wid) {
    const int wr = wid >> 2, wc = wid & 3, lane = tid & 63, fr = lane & 15, fq = lane >> 4;
    constexpr int K = KK, nt = K / BK;
    unsigned voffA[2], voffB[2];
#pragma unroll
    for (int i = 0; i < 2; ++i) { int R, C; stage_rc(tid * 16 + i * 8192, R, C); const int Rb = (R & ~31) + perm32(R & 31);
        voffA[i] = (unsigned)(R * K + C) * 2u; voffB[i] = (unsigned)(Rb * K + C) * 2u; }
    constexpr size_t kstep = (size_t)(BK * 2), hstep = (size_t)HALF * K * 2;
    const unsigned ldsw = (unsigned)wid * 1024u;
    const int aoff = lds_byte(wr * 64 + fr, fq * 8), boff = lds_byte(wc * 32 + fr, fq * 8);
#define PG8_SA(b, h) (((b) * 2 + (h)) * HTB)
#define PG8_SB(b, h) ((4 + (b) * 2 + (h)) * HTB)
#define PG8_STAGE(bufoff, gbase, voff) do { _Pragma("unroll") for (int _i = 0; _i < 2; ++_i) \
        __builtin_amdgcn_global_load_lds((const unsigned*)((const char*)(gbase) + (voff)[_i]), (LAS unsigned*)(lds + (bufoff) + ldsw + _i * 8192), 16, 0, 0); } while (0)
#define PG8_LDA(dst, b, h) do { _Pragma("unroll") for (int m = 0; m < 4; ++m) _Pragma("unroll") for (int k = 0; k < 2; ++k) dst[m][k] = *(const LAS bf16x8*)(lds + PG8_SA(b, h) + aoff + m * 2048 + k * 1024); } while (0)
#define PG8_LDB(dst, b, h) do { _Pragma("unroll") for (int n = 0; n < 2; ++n) _Pragma("unroll") for (int k = 0; k < 2; ++k) dst[n][k] = *(const LAS bf16x8*)(lds + PG8_SB(b, h) + boff + n * 2048 + k * 1024); } while (0)
#define PG8_MMA(ai, bj, At, Bt) do { __builtin_amdgcn_s_setprio(1); _Pragma("unroll") for (int m = 0; m < 4; ++m) _Pragma("unroll") for (int n = 0; n < 2; ++n) _Pragma("unroll") for (int k = 0; k < 2; ++k) \
        acc[ai][bj][m][n] = __builtin_amdgcn_mfma_f32_16x16x32_bf16(Bt[n][k], At[m][k], acc[ai][bj][m][n], 0, 0, 0); __builtin_amdgcn_s_setprio(0); } while (0)
#define PG8_WAIT_V(n) asm volatile("s_waitcnt vmcnt(" #n ")" ::: "memory")
#define PG8_WAIT_L(n) asm volatile("s_waitcnt lgkmcnt(" #n ")" ::: "memory")
#define PG8_BAR __builtin_amdgcn_s_barrier()
#define PG8_SCHED __builtin_amdgcn_sched_barrier(0)
    Unit cur, nxt; int ui = 0;
    if (!S.next(0, cur)) return;
    f32x4 acc[2][2][4][2];
#pragma unroll
    for (int a = 0; a < 2; ++a)
#pragma unroll
        for (int b = 0; b < 2; ++b)
#pragma unroll
            for (int m = 0; m < 4; ++m)
#pragma unroll
                for (int n = 0; n < 2; ++n) acc[a][b][m][n] = (f32x4){0.f, 0.f, 0.f, 0.f};
    bf16x8 At[4][2], B0[2][2], B1[2][2];
    const char* cA = cur.A; const char* cB = cur.B;
    PG8_STAGE(PG8_SB(0, 0), cB, voffB); PG8_STAGE(PG8_SB(0, 1), cB + hstep, voffB); PG8_STAGE(PG8_SA(0, 0), cA, voffA); PG8_STAGE(PG8_SA(0, 1), cA + hstep, voffA);
    if (wr == 1) PG8_BAR;
    PG8_WAIT_V(2); PG8_BAR;
    PG8_STAGE(PG8_SB(1, 0), cB + kstep, voffB); PG8_STAGE(PG8_SA(1, 0), cA + kstep, voffA); PG8_STAGE(PG8_SB(1, 1), cB + hstep + kstep, voffB);
    PG8_WAIT_V(6); PG8_BAR;
    for (;;) {
        const bool has_next = S.next(ui + 1, nxt);
        const char* nA = has_next ? nxt.A : cA; const char* nB = has_next ? nxt.B : cB;
        for (int t = 0; t < nt; t += 2) {
            const bool last = (t == nt - 2);
            const char* a1 = cA + (size_t)(t + 1) * kstep;
            const char* a2 = last ? nA : cA + (size_t)(t + 2) * kstep; const char* b2 = last ? nB : cB + (size_t)(t + 2) * kstep;
            const char* a3 = a2 + kstep; const char* b3 = b2 + kstep;
            PG8_LDB(B0, 0, 0); PG8_LDB(B1, 0, 1); PG8_SCHED; PG8_LDA(At, 0, 0); PG8_STAGE(PG8_SA(1, 1), a1 + hstep, voffA);
            PG8_WAIT_V(8); PG8_WAIT_L(0); PG8_BAR; PG8_MMA(0, 0, At, B0); PG8_MMA(0, 1, At, B1); PG8_BAR; PG8_SCHED;
            PG8_LDA(At, 0, 1); PG8_STAGE(PG8_SB(0, 0), b2, voffB); PG8_STAGE(PG8_SB(0, 1), b2 + hstep, voffB); PG8_STAGE(PG8_SA(0, 0), a2, voffA);
            PG8_WAIT_V(8); PG8_WAIT_L(0); PG8_BAR; PG8_MMA(1, 0, At, B0); PG8_MMA(1, 1, At, B1); PG8_BAR; PG8_SCHED;
            PG8_LDB(B0, 1, 0); PG8_LDB(B1, 1, 1); PG8_SCHED; PG8_LDA(At, 1, 0); PG8_STAGE(PG8_SA(0, 1), a2 + hstep, voffA);
            PG8_WAIT_V(8); PG8_WAIT_L(0); PG8_BAR; PG8_MMA(0, 0, At, B0); PG8_MMA(0, 1, At, B1); PG8_BAR; PG8_SCHED;
            PG8_LDA(At, 1, 1); PG8_STAGE(PG8_SB(1, 0), b3, voffB); PG8_STAGE(PG8_SB(1, 1), b3 + hstep, voffB); PG8_STAGE(PG8_SA(1, 0), a3, voffA);
            PG8_WAIT_V(8); PG8_WAIT_L(0); PG8_BAR; PG8_MMA(1, 0, At, B0); PG8_MMA(1, 1, At, B1); PG8_BAR; PG8_SCHED;
        }
        if (wr == 0) PG8_BAR;
        E(acc, cur, wr, wc, fr, fq);
        if (!has_next) break;
#pragma unroll
        for (int a = 0; a < 2; ++a)
#pragma unroll
            for (int b = 0; b < 2; ++b)
#pragma unroll
                for (int m = 0; m < 4; ++m)
#pragma unroll
                    for (int n = 0; n < 2; ++n) acc[a][b][m][n] = (f32x4){0.f, 0.f, 0.f, 0.f};
        cur = nxt; cA = nA; cB = nB; ++ui;
        if (wr == 1) PG8_BAR;
    }
    PG8_WAIT_V(0);
    PG8_BAR;
#undef PG8_SA
#undef PG8_SB
#undef PG8_STAGE
#undef PG8_LDA
#undef PG8_LDB
#undef PG8_MMA
#undef PG8_WAIT_V
#undef PG8_WAIT_L
#undef PG8_BAR
#undef PG8_SCHED
}
#ifndef HANDOFF
#define HANDOFF 0
#endif
constexpr unsigned RDY_NEED = HANDOFF == 2 ? 8u : 64u, RDY_SPIN_CAP = 1u << 22;
__device__ __forceinline__ void rdy_wait(const unsigned* w) { unsigned sp = 0;
    while ((unsigned)__builtin_amdgcn_readfirstlane((int)__hip_atomic_load(w, __ATOMIC_RELAXED, __HIP_MEMORY_SCOPE_AGENT)) < RDY_NEED) { __builtin_amdgcn_s_sleep(2); if (++sp > RDY_SPIN_CAP) break; } }
template <class Epi, class Sched, bool GATHER = false, int MODE = 0, bool PRE = false>
__device__ __forceinline__ void gemm8_phase(LAS unsigned char* lds, const Sched& S, const Epi& E, const int tid, const int wid, unsigned* rdy = nullptr) {
    const int wr = wid >> 2, wc = wid & 3, lane = tid & 63, fr = lane & 15, fq = lane >> 4;
    constexpr int K = KK / 2, nt = K / BK;
    unsigned voffA[2], voffB[2]; int RA[2], CA[2];
#pragma unroll
    for (int i = 0; i < 2; ++i) { int R, C; stage_rc(tid * 16 + i * 8192, R, C); const int Rb = (R & ~31) + perm32(R & 31); RA[i] = R; CA[i] = C;
        voffA[i] = (unsigned)(R * K + C) * 2u; voffB[i] = (unsigned)(Rb * K + C) * 2u; }
    unsigned vA0[2], vA1[2], nA0[2], nA1[2];
    LAS int* lidx = (LAS int*)(lds + STAGE_BYTES);
    constexpr size_t kstep = (size_t)(BK * 2), hstep = (size_t)HALF * K * 2;
    const unsigned ldsw = (unsigned)wid * 1024u;
    const int aoff = lds_byte(wr * 64 + fr, fq * 8), boff = lds_byte(wc * 32 + fr, fq * 8);
#define PG8_SA(b, h) (((b) * 2 + (h)) * HTB)
#define PG8_SB(b, h) ((4 + (b) * 2 + (h)) * HTB)
#define PG8_STAGE(bufoff, gbase, voff) do { _Pragma("unroll") for (int _i = 0; _i < 2; ++_i) \
        __builtin_amdgcn_global_load_lds((const unsigned*)((const char*)(gbase) + (voff)[_i]), (LAS unsigned*)(lds + (bufoff) + ldsw + _i * 8192), 16, 0, 0); } while (0)
#define PG8_LD8(p) __builtin_shufflevector(*(const LAS u32x4*)(p), *(const LAS u32x4*)((p) + 1024), 0, 1, 2, 3, 4, 5, 6, 7)
#define PG8_STAGE_A(bufoff, gbase, h, vg0, vg1) do { if constexpr (GATHER) { if ((h) == 0) PG8_STAGE(bufoff, gbase, vg0); else PG8_STAGE(bufoff, gbase, vg1); } else PG8_STAGE(bufoff, (gbase) + (h) * hstep, voffA); } while (0)
#define PG8_LDA(dst, b, h) do { _Pragma("unroll") for (int m = 0; m < 4; ++m) dst[m] = PG8_LD8(lds + PG8_SA(b, h) + aoff + m * 2048); } while (0)
#define PG8_LDB(dst, b, h) do { _Pragma("unroll") for (int n = 0; n < 2; ++n) dst[n] = PG8_LD8(lds + PG8_SB(b, h) + boff + n * 2048); } while (0)
#define PG8_MMA(ai, bj, At, Bt) do { __builtin_amdgcn_s_setprio(1); _Pragma("unroll") for (int m = 0; m < 4; ++m) _Pragma("unroll") for (int n = 0; n < 2; ++n) \
        asm volatile("v_mfma_f32_16x16x128_f8f6f4 %0, %1, %2, %0" : "+v"(acc[ai][bj][m][n]) : "v"(Bt[n]), "v"(At[m])); __builtin_amdgcn_s_setprio(0); } while (0)
#define PG8_WAIT_V(n) asm volatile("s_waitcnt vmcnt(" #n ")" ::: "memory")
#define PG8_WAIT_L(n) asm volatile("s_waitcnt lgkmcnt(" #n ")" ::: "memory")
#define PG8_BAR __builtin_amdgcn_s_barrier()
#define PG8_SCHED __builtin_amdgcn_sched_barrier(0)
    Unit cur, nxt; int ui = 0;
    if (!S.next(0, cur)) return;
    f32x4 acc[2][2][4][2];
#pragma unroll
    for (int a = 0; a < 2; ++a)
#pragma unroll
        for (int b = 0; b < 2; ++b)
#pragma unroll
            for (int m = 0; m < 4; ++m)
#pragma unroll
                for (int n = 0; n < 2; ++n) acc[a][b][m][n] = (f32x4){0.f, 0.f, 0.f, 0.f};
    u32x8 At[4], B0[2], B1[2];
    const char* cA = cur.A; const char* cB = cur.B;
    int prev_pm = -1; (void)prev_pm;
    LAS float* ebuf = (LAS float*)(lds + STAGE_BYTES + 8192);
#define PG8_PRE(u_, par_) do { if constexpr (PRE) { if (wid >= 4) { _Pragma("unroll") for (int _j = 0; _j < 2; ++_j) \
        __builtin_amdgcn_global_load_lds((const unsigned*)E.pre(u_, _j * 256 + (wid - 4) * 64 + lane), (LAS unsigned*)(ebuf + (par_) * 512 + _j * 256 + (wid - 4) * 64), 4, 0, 0); } } } while (0)
    PG8_PRE(cur, 0);
    if constexpr (MODE == 2) { rdy_wait(rdy + 64 * cur.pm); asm volatile("" ::: "memory"); }
    if constexpr (GATHER) {
#pragma unroll
        for (int i = 0; i < 2; ++i) { const unsigned r0 = (unsigned)S.rtok[cur.pm * 256 + RA[i]], r1 = (unsigned)S.rtok[cur.pm * 256 + HALF + RA[i]];
            vA0[i] = (r0 < (unsigned)NTOK ? r0 : (unsigned)(NTOK - 1)) * (unsigned)(K * 2) + (unsigned)CA[i] * 2u; vA1[i] = (r1 < (unsigned)NTOK ? r1 : (unsigned)(NTOK - 1)) * (unsigned)(K * 2) + (unsigned)CA[i] * 2u; nA0[i] = vA0[i]; nA1[i] = vA1[i]; } }
    PG8_STAGE(PG8_SB(0, 0), cB, voffB); PG8_STAGE(PG8_SB(0, 1), cB + hstep, voffB); PG8_STAGE_A(PG8_SA(0, 0), cA, 0, vA0, vA1); PG8_STAGE_A(PG8_SA(0, 1), cA, 1, vA0, vA1);
    if (wr == 1) PG8_BAR;
    PG8_WAIT_V(2); PG8_BAR;
    PG8_STAGE(PG8_SB(1, 0), cB + kstep, voffB); PG8_STAGE_A(PG8_SA(1, 0), cA + kstep, 0, vA0, vA1); PG8_STAGE(PG8_SB(1, 1), cB + hstep + kstep, voffB);
    PG8_WAIT_V(6); PG8_BAR;
    for (;;) {
        const bool has_next = S.next(ui + 1, nxt);
        const char* nA = has_next ? nxt.A : cA; const char* nB = has_next ? nxt.B : cB;
        if constexpr (MODE == 2) { if (has_next && wid == 0) __builtin_amdgcn_global_load_lds((const unsigned*)(rdy + 64 * nxt.pm), (LAS unsigned*)(lidx + ((ui + 1) & 1) * 256), 4, 0, 16); }
        if constexpr (GATHER) { if (has_next && wid < 4) __builtin_amdgcn_global_load_lds((const unsigned*)(S.rtok + nxt.pm * 256 + 64 * wid + (tid & 63)), (LAS unsigned*)(lidx + ((ui + 1) & 1) * 256 + 64 * wid), 4, 0, 0); }
#pragma clang loop unroll(disable)
        for (int t = 0; t < nt; t += 2) {
            const bool last = (t == nt - 2);
            const char* a1 = cA + (size_t)(t + 1) * kstep;
            const char* a2 = last ? nA : cA + (size_t)(t + 2) * kstep; const char* b2 = last ? nB : cB + (size_t)(t + 2) * kstep;
            const char* a3 = a2 + kstep; const char* b3 = b2 + kstep;
            if constexpr (GATHER) { if (last && has_next) { const LAS int* ix = lidx + ((ui + 1) & 1) * 256;
#pragma unroll
                    for (int i = 0; i < 2; ++i) { const unsigned r0 = (unsigned)ix[RA[i]], r1 = (unsigned)ix[HALF + RA[i]];
                        nA0[i] = (r0 < (unsigned)NTOK ? r0 : (unsigned)(NTOK - 1)) * (unsigned)(K * 2) + (unsigned)CA[i] * 2u; nA1[i] = (r1 < (unsigned)NTOK ? r1 : (unsigned)(NTOK - 1)) * (unsigned)(K * 2) + (unsigned)CA[i] * 2u; } } }
            if constexpr (MODE == 2) { if (last && has_next) { const unsigned snap = (unsigned)__builtin_amdgcn_readfirstlane(*(const LAS int*)(lidx + ((ui + 1) & 1) * 256));
                    if (snap < RDY_NEED) rdy_wait(rdy + 64 * nxt.pm);
                    asm volatile("" ::: "memory"); } }
            unsigned sA0[2], sA1[2];
#pragma unroll
            for (int i = 0; i < 2; ++i) { sA0[i] = last ? nA0[i] : vA0[i]; sA1[i] = last ? nA1[i] : vA1[i]; }
            PG8_LDB(B0, 0, 0); PG8_LDB(B1, 0, 1); PG8_SCHED; PG8_LDA(At, 0, 0); PG8_STAGE_A(PG8_SA(1, 1), a1, 1, vA0, vA1);
            PG8_WAIT_V(8); PG8_WAIT_L(0); PG8_BAR; PG8_MMA(0, 0, At, B0); PG8_MMA(0, 1, At, B1); PG8_BAR; PG8_SCHED;
            PG8_LDA(At, 0, 1); PG8_STAGE(PG8_SB(0, 0), b2, voffB); PG8_STAGE(PG8_SB(0, 1), b2 + hstep, voffB); PG8_STAGE_A(PG8_SA(0, 0), a2, 0, sA0, sA1);
            PG8_WAIT_V(8); PG8_WAIT_L(0); PG8_BAR; PG8_MMA(1, 0, At, B0); PG8_MMA(1, 1, At, B1); PG8_BAR; PG8_SCHED;
            PG8_LDB(B0, 1, 0); PG8_LDB(B1, 1, 1); PG8_SCHED; PG8_LDA(At, 1, 0); PG8_STAGE_A(PG8_SA(0, 1), a2, 1, sA0, sA1);
            PG8_WAIT_V(8); PG8_WAIT_L(0); PG8_BAR; PG8_MMA(0, 0, At, B0); PG8_MMA(0, 1, At, B1); PG8_BAR; PG8_SCHED;
            PG8_LDA(At, 1, 1); PG8_STAGE(PG8_SB(1, 0), b3, voffB); PG8_STAGE(PG8_SB(1, 1), b3 + hstep, voffB); PG8_STAGE_A(PG8_SA(1, 0), a3, 0, sA0, sA1);
            PG8_WAIT_V(8); PG8_WAIT_L(0); PG8_BAR; PG8_MMA(1, 0, At, B0); PG8_MMA(1, 1, At, B1); PG8_BAR; PG8_SCHED;
        }
        asm volatile("s_nop 15\n\ts_nop 15" ::: "memory");
        if (wr == 0) PG8_BAR;
        if constexpr (MODE == 1 && PRE) { E.template run_pre<true>(acc, cur, wr, wc, fr, fq, prev_pm, ebuf + (ui & 1) * 512); prev_pm = __builtin_amdgcn_readfirstlane(cur.pm); }
        else if constexpr (MODE == 1) { E.template run<true>(acc, cur, wr, wc, fr, fq, prev_pm); prev_pm = __builtin_amdgcn_readfirstlane(cur.pm); }
        else if constexpr (PRE) E.run_pre0(acc, cur, wr, wc, fr, fq, ebuf + (ui & 1) * 512);
        else E(acc, cur, wr, wc, fr, fq);
        if (!has_next) break;
#pragma unroll
        for (int a = 0; a < 2; ++a)
#pragma unroll
            for (int b = 0; b < 2; ++b)
#pragma unroll
                for (int m = 0; m < 4; ++m)
#pragma unroll
                    for (int n = 0; n < 2; ++n) acc[a][b][m][n] = (f32x4){0.f, 0.f, 0.f, 0.f};
        cur = nxt; cA = nA; cB = nB; ++ui;
        PG8_PRE(cur, ui & 1);
        if constexpr (GATHER) {
#pragma unroll
            for (int i = 0; i < 2; ++i) { vA0[i] = nA0[i]; vA1[i] = nA1[i]; } }
        if (wr == 1) PG8_BAR;
    }
    PG8_WAIT_V(0);
    if constexpr (MODE == 1) { if (lane == 0) (void)__hip_atomic_fetch_add(rdy + 64 * __builtin_amdgcn_readfirstlane(cur.pm), 1u, __ATOMIC_RELAXED, __HIP_MEMORY_SCOPE_AGENT); }
    PG8_BAR;
#undef PG8_PRE
#undef PG8_SA
#undef PG8_SB
#undef PG8_STAGE
#undef PG8_LDA
#undef PG8_STAGE_A
#undef PG8_LD8
#undef PG8_LDB
#undef PG8_MMA
#undef PG8_WAIT_V
#undef PG8_WAIT_L
#undef PG8_BAR
#undef PG8_SCHED
}
}

#define XB_TMO      128
#define XB_XCNT(j)  (256  + 64 * (j))
#define XB_XSUB(j)  (1280 + 64 * (j))
#define XB_XGEN(j)  (2304 + 64 * (j))
#define XB_TOP      3328
#define XB_TOPGEN   3392
#define XCD_BAR_WORDS 3456
#define XB_SPIN_CAP (1u << 18)
__device__ __forceinline__ unsigned xb_ld(unsigned* p)              { return __hip_atomic_load(p, __ATOMIC_RELAXED, __HIP_MEMORY_SCOPE_AGENT); }
__device__ __forceinline__ unsigned xb_add(unsigned* p, unsigned v) { return __hip_atomic_fetch_add(p, v, __ATOMIC_RELAXED, __HIP_MEMORY_SCOPE_AGENT); }
__device__ __forceinline__ unsigned xb_xcc_id() { return (unsigned)__builtin_amdgcn_s_getreg((3 << 11) | 20) & 0xFu; }
#define XB_SPIN(cond, bar) do { unsigned _sp = 0; while (cond) { __builtin_amdgcn_s_sleep(1); \
    if ((++_sp & 255u) == 0u) { if (xb_ld(&(bar)[XB_TMO])) break; if (_sp > XB_SPIN_CAP) { atomicAdd(&(bar)[XB_TMO], 1u); break; } } } } while (0)
struct XcdBarrier { unsigned* bar; unsigned x; volatile LAS unsigned* st; };
__device__ __forceinline__ XcdBarrier xcd_barrier_post(unsigned* bar, volatile LAS unsigned* st) {
    XcdBarrier b; b.bar = bar; b.x = xb_xcc_id(); b.st = st;
    if (threadIdx.x == 0) (void)xb_add(&bar[XB_XCNT(b.x)], 1u);
    return b;
}
__device__ __forceinline__ void xcd_barrier_complete(unsigned* bar, unsigned x, unsigned& nloc, unsigned& nx) {
    const unsigned G = gridDim.x * gridDim.y * gridDim.z;
    unsigned sum, cnt, mine, sp = 0u;
    for (;;) {
        sum = 0u; cnt = 0u; mine = 0u;
#pragma unroll
        for (unsigned j = 0; j < 16; ++j) { const unsigned c = xb_ld(&bar[XB_XCNT(j)]); sum += c; cnt += (c > 0u) ? 1u : 0u; mine = (j == x) ? c : mine; }
        if (sum == G) break;
        __builtin_amdgcn_s_sleep(1);
        if ((++sp & 255u) == 0u) { if (xb_ld(&bar[XB_TMO])) break; if (sp > XB_SPIN_CAP) { atomicAdd(&bar[XB_TMO], 1u); break; } }
    }
    nloc = mine > 0u ? mine : 1u; nx = cnt > 0u ? cnt : 1u;
}
__device__ __forceinline__ void xcd_barrier(const XcdBarrier& b, const bool leader) {
    asm volatile("s_waitcnt vmcnt(0)" ::: "memory");
    __syncthreads();
    if (leader) {
        unsigned* bar = b.bar;
        __builtin_amdgcn_s_waitcnt(0);
        unsigned nloc = b.st[0], nx = b.st[1];
        if (nloc == 0u) { xcd_barrier_complete(bar, b.x, nloc, nx); b.st[0] = nloc; b.st[1] = nx; }
        const unsigned old = xb_add(&bar[XB_XSUB(b.x)], 1u);
        const unsigned gen = old / nloc;
        if (old + 1u == (gen + 1u) * nloc) {
            __builtin_amdgcn_fence(__ATOMIC_RELEASE, "agent");
            asm volatile("s_waitcnt vmcnt(0)" ::: "memory");
            const unsigned og = xb_add(&bar[XB_TOP], 1u);
            const unsigned tg = og / nx;
            if (og + 1u == (tg + 1u) * nx) xb_add(&bar[XB_TOPGEN], 1u);
            else XB_SPIN(xb_ld(&bar[XB_TOPGEN]) == tg, bar);
            __builtin_amdgcn_fence(__ATOMIC_ACQUIRE, "agent");
            xb_add(&bar[XB_XGEN(b.x)], 1u);
            asm volatile("s_waitcnt vmcnt(0)" ::: "memory");
        } else {
            XB_SPIN(xb_ld(&bar[XB_XGEN(b.x)]) == gen, bar);
            __builtin_amdgcn_fence(__ATOMIC_ACQUIRE, "agent");
            asm volatile("s_waitcnt vmcnt(0)" ::: "memory");
        }
    }
    __syncthreads();
}

constexpr int NWAVES = 8;
constexpr int RING_OFF = 0, RING_BYTES = 131072;
constexpr int LDSCTL_OFF = 160 * 1024 - 512, MISC_OFF = LDSCTL_OFF + 320;
#ifndef DBG_BAR10
#define DBG_BAR10 0
#endif

constexpr int TILEE_OFF = RING_OFF + RING_BYTES + 4096;
constexpr int LDS_BYTES = 160 * 1024;

struct Args { const float* in[23]; float* out; unsigned char* ws; int ph_lo, ph_hi, li, pad; };

__device__ __forceinline__ void p0_transpose_item(const float* __restrict__ W, int ldw, bf16* __restrict__ WT, int drow0, int n0, int k0, LAS float* scr, int lane, const float* __restrict__ kscale = nullptr) {
    const int c = lane & 7;
    f32x4 ks0 = (f32x4){1.f, 1.f, 1.f, 1.f}, ks1 = ks0;
    if (kscale) { ks0 = *(const f32x4*)(kscale + k0 + 8 * c); ks1 = *(const f32x4*)(kscale + k0 + 8 * c + 4); }
#pragma unroll 8
    for (int i = 0; i < 32; ++i) { const int kk = 2 * i + (lane >> 5); scr[kk * 33 + (lane & 31)] = W[(size_t)(k0 + kk) * ldw + n0 + (lane & 31)]; }
    LDS_WAIT(); asm volatile("" ::: "memory");
    float t[4][8];
#pragma unroll
    for (int j = 0; j < 4; ++j) { const LAS float* sp = scr + (8 * c) * 33 + (lane >> 3) + 8 * j;
#pragma unroll
        for (int q = 0; q < 8; ++q) t[j][q] = sp[q * 33]; }
    LDS_WAIT(); asm volatile("" ::: "memory");
#pragma unroll
    for (int j = 0; j < 4; ++j) { const int n = (lane >> 3) + 8 * j;
        u32x4 o; o.x = pk2(t[j][0] * ks0[0], t[j][1] * ks0[1]); o.y = pk2(t[j][2] * ks0[2], t[j][3] * ks0[3]); o.z = pk2(t[j][4] * ks1[0], t[j][5] * ks1[1]); o.w = pk2(t[j][6] * ks1[2], t[j][7] * ks1[3]);
        *(GAS u32x4*)(WT + (size_t)(drow0 + n) * D + k0 + 8 * c) = o; }
}
__device__ __forceinline__ void p0_item_load(float (&rg)[32], const float* __restrict__ W, int ldw, int n0, int k0, int lane) {
#pragma unroll
    for (int i = 0; i < 32; ++i) rg[i] = W[(size_t)(k0 + 2 * i + (lane >> 5)) * ldw + n0 + (lane & 31)];
}
__device__ __forceinline__ void p0_item_finish(const float (&rg)[32], bf16* __restrict__ WT, int drow0, int k0, LAS float* scr, int lane, const float* __restrict__ kscale) {
    const int c = lane & 7;
    f32x4 ks0 = (f32x4){1.f, 1.f, 1.f, 1.f}, ks1 = ks0;
    if (kscale) { ks0 = *(const f32x4*)(kscale + k0 + 8 * c); ks1 = *(const f32x4*)(kscale + k0 + 8 * c + 4); }
#pragma unroll
    for (int i = 0; i < 32; ++i) scr[(2 * i + (lane >> 5)) * 33 + (lane & 31)] = rg[i];
    LDS_WAIT(); asm volatile("" ::: "memory");
    float t[4][8];
#pragma unroll
    for (int j = 0; j < 4; ++j) { const LAS float* sp = scr + (8 * c) * 33 + (lane >> 3) + 8 * j;
#pragma unroll
        for (int q = 0; q < 8; ++q) t[j][q] = sp[q * 33]; }
    LDS_WAIT(); asm volatile("" ::: "memory");
    const float sc = MOE_FP8 ? W8S : 1.f;
#pragma unroll
    for (int j = 0; j < 4; ++j) { const int n = (lane >> 3) + 8 * j;
        const float v0 = t[j][0] * (ks0[0] * sc), v1 = t[j][1] * (ks0[1] * sc), v2 = t[j][2] * (ks0[2] * sc), v3 = t[j][3] * (ks0[3] * sc), v4 = t[j][4] * (ks1[0] * sc), v5 = t[j][5] * (ks1[1] * sc), v6 = t[j][6] * (ks1[2] * sc), v7 = t[j][7] * (ks1[3] * sc);
        if (MOE_FP8) { u32x2 o; o.x = pk4_fp8(v0, v1, v2, v3); o.y = pk4_fp8(v4, v5, v6, v7);
            *(GAS u32x2*)((unsigned char*)WT + (size_t)(drow0 + n) * D + k0 + 8 * c) = o; }
        else { u32x4 o; o.x = pk2(v0, v1); o.y = pk2(v2, v3); o.z = pk2(v4, v5); o.w = pk2(v6, v7);
            *(GAS u32x4*)(WT + (size_t)(drow0 + n) * D + k0 + 8 * c) = o; } }
}
__device__ __forceinline__ void rms_row_to_bf16(const float* __restrict__ xrow, const float* __restrict__ w, bf16* __restrict__ orow, int lane) {
    const f32x4* xr = (const f32x4*)xrow + lane;
    f32x4 v[4]; float s = 0.f;
#pragma unroll
    for (int j = 0; j < 4; ++j) { v[j] = xr[64 * j]; s += (v[j].x * v[j].x + v[j].y * v[j].y) + (v[j].z * v[j].z + v[j].w * v[j].w); }
    const float r = rsqrtf(wave_sum(s) * (1.f / D) + EPS);
    u32x2* o8 = (u32x2*)orow + lane;
#pragma unroll
    for (int j = 0; j < 4; ++j) { const f32x4 ww = ((const f32x4*)w)[lane + 64 * j]; u32x2 o; o.x = pk2(v[j].x * r * ww.x, v[j].y * r * ww.y); o.y = pk2(v[j].z * r * ww.z, v[j].w * r * ww.w); o8[64 * j] = o; }
}


typedef __bf16 bf16x2_t __attribute__((ext_vector_type(2)));
typedef float f32x2_t __attribute__((ext_vector_type(2)));
__device__ __forceinline__ unsigned cvtpk(float lo, float hi) { const f32x2_t v = {lo, hi}; const bf16x2_t b = __builtin_convertvector(v, bf16x2_t); return __builtin_bit_cast(unsigned, b); }
__device__ __forceinline__ void attn_unit(LAS unsigned char* lds, const bf16* Q, const bf16* KB, const bf16* VT, bf16* AO, int b, int h, int qb, int lane, int wave) {
    constexpr int RS = 528, HB = 73728, HOFF = HB - 128 * RS;
    const int r = lane & 31, hh = lane >> 5;
    const size_t tokq = (size_t)b * SEQ + (size_t)qb * 256 + wave * 32 + r;
    bf16x8 qf[16];
    { const bf16* qp = Q + tokq * D + h * 256 + 8 * hh;
#pragma unroll
      for (int s2 = 0; s2 < 16; ++s2) qf[s2] = *(const bf16x8*)(qp + 16 * s2); }
    const char* kbase = (const char*)(KB + (size_t)(b * MEML) * D + h * 256);
    const char* vbase = (const char*)(VT + (size_t)(h * 256) * NMEM + b * MEML);
#define ATT_DMA(base, pitch, half) do { int ln_ = lane; asm volatile("" : "+v"(ln_)); int g_ = wave * 64 + ln_; int row_ = g_ / 33, cs_ = g_ - row_ * 33; \
        _Pragma("unroll") for (int i_ = 0; i_ < 9; ++i_) { const int rr_ = row_ > 127 ? 127 : row_, cc_ = cs_ > 31 ? 31 : cs_; \
            __builtin_amdgcn_global_load_lds((const unsigned*)((base) + (size_t)(128 * (half) + rr_) * (pitch) + cc_ * 16), (LAS unsigned*)(lds + (half) * HB + (wave + 8 * i_) * 1024), 16, 0, 0); \
            cs_ += 17; row_ += 15; if (cs_ >= 33) { cs_ -= 33; row_ += 1; } } } while (0)
#define ATT_WAIT(n) asm volatile("s_waitcnt vmcnt(" #n ")" ::: "memory")
#define ATT_BAR() do { asm volatile("s_waitcnt lgkmcnt(0)" ::: "memory"); __builtin_amdgcn_s_barrier(); asm volatile("" ::: "memory"); } while (0)
    ATT_DMA(kbase, D * 2, 0); ATT_DMA(kbase, D * 2, 1);
    ATT_WAIT(9); ATT_BAR();
    const LAS unsigned char* kread = lds + r * RS + hh * 16;
    u32x4 pp[8][2]; float alpha[4]; float mrun = -INFINITY, lrun = 0.f;
#pragma unroll
    for (int kq = 0; kq < 4; ++kq) {
        if (kq == 2) { ATT_WAIT(9); ATT_BAR(); }
        f32x16 st[2];
#pragma unroll
        for (int t2 = 0; t2 < 2; ++t2) { const int t = 2 * kq + t2; f32x16 acc;
#pragma unroll
            for (int e = 0; e < 16; ++e) acc[e] = 0.f;
#pragma unroll
            for (int s2 = 0; s2 < 16; ++s2) { const bf16x8 a = *(const LAS bf16x8*)(kread + 32 * t * RS + (t >= 4 ? HOFF : 0) + s2 * 32); acc = __builtin_amdgcn_mfma_f32_32x32x16_bf16(a, qf[s2], acc, 0, 0, 0); if ((s2 & 3) == 3) __builtin_amdgcn_sched_barrier(0); }
            st[t2] = acc; }
        if (kq == 1) { ATT_BAR(); ATT_DMA(vbase, NMEM * 2, 0); }
        if (kq == 3) { ATT_BAR(); ATT_DMA(vbase, NMEM * 2, 1); }
        float m = st[0][0];
#pragma unroll
        for (int t2 = 0; t2 < 2; ++t2)
#pragma unroll
            for (int e = 0; e < 16; ++e) m = fmaxf(m, st[t2][e]);
        m = fmaxf(m, __shfl_xor(m, 32)); m = fmaxf(m, mrun);
        alpha[kq] = __builtin_amdgcn_exp2f((mrun - m) * 1.4426950408889634f); mrun = m;
        float ls = 0.f; const float mc = m * 1.4426950408889634f;
#pragma unroll
        for (int t2 = 0; t2 < 2; ++t2) { const int t = 2 * kq + t2; float pe[16];
#pragma unroll
            for (int e = 0; e < 16; ++e) { pe[e] = __builtin_amdgcn_exp2f(st[t2][e] * 1.4426950408889634f - mc); ls += pe[e]; }
#pragma unroll
            for (int u = 0; u < 2; ++u) { pp[t][u].x = cvtpk(pe[8 * u], pe[8 * u + 1]); pp[t][u].y = cvtpk(pe[8 * u + 2], pe[8 * u + 3]); pp[t][u].z = cvtpk(pe[8 * u + 4], pe[8 * u + 5]); pp[t][u].w = cvtpk(pe[8 * u + 6], pe[8 * u + 7]); }
            __builtin_amdgcn_sched_barrier(0); }
        lrun = lrun * alpha[kq] + ls;
    }
    const float l = lrun + __shfl_xor(lrun, 32);
    const float rl = 1.f / l;
    bf16* orow0 = AO + tokq * D + h * 256;
    const LAS unsigned char* vread = lds + r * RS + 8 * hh;
#pragma unroll
    for (int half = 0; half < 2; ++half) {
        if (half == 0) { ATT_WAIT(9); } else { ATT_WAIT(0); }
        ATT_BAR();
#pragma unroll
        for (int dt = 4 * half; dt < 4 * half + 4; ++dt) { f32x16 acc;
#pragma unroll
            for (int e = 0; e < 16; ++e) acc[e] = 0.f;
            const LAS unsigned char* vrow = vread + 32 * dt * RS + (dt >= 4 ? HOFF : 0);
#pragma unroll
            for (int t = 0; t < 8; ++t) {
                if (t == 2 || t == 4 || t == 6) {
#pragma unroll
                    for (int e = 0; e < 16; ++e) acc[e] *= alpha[t >> 1]; }
#pragma unroll
                for (int u = 0; u < 2; ++u) { const u32x2 a0 = *(const LAS u32x2*)(vrow + (4 * t + 2 * u) * 16), a1 = *(const LAS u32x2*)(vrow + (4 * t + 2 * u + 1) * 16);
                    u32x4 aw; aw.x = a0.x; aw.y = a0.y; aw.z = a1.x; aw.w = a1.y;
                    acc = __builtin_amdgcn_mfma_f32_32x32x16_bf16(__builtin_bit_cast(bf16x8, aw), __builtin_bit_cast(bf16x8, pp[t][u]), acc, 0, 0, 0); }
                __builtin_amdgcn_sched_barrier(0); }
            u32x2 w[4];
#pragma unroll
            for (int g = 0; g < 4; ++g) { w[g].x = cvtpk(acc[4 * g] * rl, acc[4 * g + 1] * rl); w[g].y = cvtpk(acc[4 * g + 2] * rl, acc[4 * g + 3] * rl); }
#pragma unroll
            for (int p2 = 0; p2 < 2; ++p2) {
                const u32x2 rx = __builtin_amdgcn_permlane32_swap(w[2 * p2].x, w[2 * p2 + 1].x, false, false), ry = __builtin_amdgcn_permlane32_swap(w[2 * p2].y, w[2 * p2 + 1].y, false, false);
                *(u32x4*)(orow0 + 32 * dt + 16 * p2 + 8 * hh) = (u32x4){rx.x, ry.x, rx.y, ry.y}; } }
    }
    ATT_BAR();
#undef ATT_DMA
#undef ATT_WAIT
#undef ATT_BAR
}

template <int K> struct ScanGeo { static constexpr int QS = K + 8, VS = 72, OFF_KR = 64 * QS * 2, OFF_TAB = 2 * 64 * QS * 2, BLOB = OFF_TAB + 3 * K * 4; };
__device__ __forceinline__ size_t blob_off(int grp, int b, int h, int c) { return grp == 0 ? (size_t)(((b * 4 + h) * 32) + c) * ScanGeo<128>::BLOB : (size_t)1024 * ScanGeo<128>::BLOB + (size_t)(((b * 4 + h) * 32) + c) * ScanGeo<64>::BLOB; }
#define SC_PIN(pv) asm volatile("" : "+v"(pv[0]), "+v"(pv[1]), "+v"(pv[2]), "+v"(pv[3]), "+v"(pv[4]), "+v"(pv[5]), "+v"(pv[6]), "+v"(pv[7]), "+v"(pv[8]), "+v"(pv[9]), "+v"(pv[10]), "+v"(pv[11]), "+v"(pv[12]), "+v"(pv[13]), "+v"(pv[14]), "+v"(pv[15]))
#define SC_BAR() do { asm volatile("s_waitcnt vmcnt(0) lgkmcnt(0)" ::: "memory"); __builtin_amdgcn_s_barrier(); asm volatile("" ::: "memory"); } while (0)
#define SC_BARL2() do { asm volatile("s_waitcnt lgkmcnt(0)" ::: "memory"); __builtin_amdgcn_s_barrier(); asm volatile("" ::: "memory"); } while (0)

template <int K, int GRP>
__device__ __forceinline__ void prep_load(float (&g)[64 / (512 / K)], unsigned short (&q)[64 / (512 / K)], unsigned short (&kk)[64 / (512 / K)], const bf16* PB, const _Float16* G, int b, int h, int c, int tid) {
    constexpr int NQ = 512 / K, RPT = 64 / NQ;
    const int qcol = (GRP == 0 ? C_HQ : C_GQ) + h * K, kcol = (GRP == 0 ? C_HF : C_GK) + h * K, gcol = (GRP == 0 ? 0 : 512) + h * K;
    const int pk = tid & (K - 1), prq = tid / K;
    const size_t tok0 = (size_t)b * SEQ + (size_t)c * 64;
#pragma unroll
    for (int r = 0; r < RPT; ++r) { const size_t tk = tok0 + RPT * prq + r; g[r] = (float)G[tk * GW + gcol + pk]; q[r] = PB[tk * PBW + qcol + pk]; kk[r] = PB[tk * PBW + kcol + pk]; }
}
template <int K>
__device__ __forceinline__ void prep_p1(const float (&g)[64 / (512 / K)], const unsigned short (&pq)[64 / (512 / K)], const unsigned short (&pkk)[64 / (512 / K)], LAS unsigned char* lds, int tid) {
    typedef ScanGeo<K> GE; constexpr int NQ = 512 / K, RPT = 64 / NQ, QS = GE::QS;
    LAS bf16* QR = (LAS bf16*)lds; LAS bf16* KR = (LAS bf16*)(lds + GE::OFF_KR); LAS float* TAB = (LAS float*)(lds + GE::OFF_TAB); LAS float* TOT = (LAS float*)(lds + GE::BLOB);
    const int pk = tid & (K - 1), prq = tid / K;
    float bc[RPT];
    { float run = 0.f;
#pragma unroll
      for (int r = 0; r < RPT; ++r) { run += g[r]; bc[r] = run; }
      TOT[prq * K + pk] = run; }
    SC_BARL2();
    { float pre = 0.f, rr = 0.f, tot = 0.f;
#pragma unroll
      for (int gq = 0; gq < NQ; ++gq) { const float t = TOT[gq * K + pk]; pre += (gq < prq) ? t : 0.f; rr += (gq < NQ / 2) ? t : 0.f; tot += t; }
      if (prq == 0) { TAB[pk] = __expf(rr); TAB[K + pk] = __expf(tot); TAB[2 * K + pk] = __expf(tot - rr); }
#pragma unroll
      for (int r = 0; r < RPT; ++r) { const float bb = pre + bc[r]; const float e1 = __expf(bb - rr); const float qv = bf2f(pq[r]) * e1, kv = bf2f(pkk[r]) * __builtin_amdgcn_rcpf(e1);
          QR[(RPT * prq + r) * QS + pk] = (bf16)f2bf(qv); KR[(RPT * prq + r) * QS + pk] = (bf16)f2bf(kv); } }
}
template <int K>
__device__ __forceinline__ void prep_p2(LAS unsigned char* lds, unsigned char* blob, int tid) {
    typedef ScanGeo<K> GE;
    SC_BARL2();
    for (int i = tid; i < GE::BLOB / 16; i += NWAVES * 64) ((u32x4*)blob)[i] = ((const LAS u32x4*)lds)[i];
    SC_BARL2();
}

template <int K, int GRP>
__device__ __forceinline__ void scan128(LAS unsigned char* lds, const bf16* PB, const unsigned char* blobs, bf16* Y, const float* onw, int b, int h, int tid, int lane, int wave) {
    typedef ScanGeo<K> GE; constexpr int QS = GE::QS, VS = GE::VS, NS = K / 32, NKT = K / 64, IMG = GE::OFF_TAB, NDMA = (GE::OFF_TAB / 8) / 1024 + 1;
    constexpr int PW = IMG / 8, NPF = PW / 1024, REM = (PW - NPF * 1024) / 16;
    LAS unsigned char* VTb = lds + 3 * IMG; LAS bf16* VT = (LAS bf16*)VTb; LAS bf16* SST = (LAS bf16*)(VTb + 128 * VS * 2);
    const int q4 = lane >> 4, l15 = lane & 15;
    const int vcol = (GRP == 0 ? C_HI : C_GV) + h * 128, gcol = (GRP == 0 ? C_HGATE : C_GGATE) + h * 128;
    const bool owave = wave < 4; const int I = wave & 3, ws = wave & 3;
    const int vrow = tid & 127, vv = 8 * (vrow & 15) + (vrow >> 4), jg = tid >> 7;
#define SC_DMA(c, buf) do { const unsigned char* src_ = blobs + (size_t)(c) * GE::BLOB + wave * PW + lane * 16; LAS unsigned char* dst_ = lds + (buf) * IMG + wave * PW; \
        _Pragma("unroll") for (int i_ = 0; i_ < NPF; ++i_) __builtin_amdgcn_global_load_lds((const unsigned*)(src_ + i_ * 1024), (LAS unsigned*)(dst_ + i_ * 1024), 16, 0, 0); \
        if (lane < REM) __builtin_amdgcn_global_load_lds((const unsigned*)(src_ + NPF * 1024), (LAS unsigned*)(dst_ + NPF * 1024), 16, 0, 0); } while (0)
#define SC_LOADV(c) do { const size_t t0_ = (size_t)b * SEQ + (size_t)(c) * 64 + 16 * jg; _Pragma("unroll") for (int r_ = 0; r_ < 16; ++r_) pv[r_] = PB[(t0_ + r_) * PBW + vcol + vv]; } while (0)
#define SC_LOADG(c, dst) do { const size_t t0_ = (size_t)b * SEQ + (size_t)(c) * 64 + 16 * I + 4 * q4; _Pragma("unroll") for (int reg_ = 0; reg_ < 4; ++reg_) dst[reg_] = *(const u32x4*)(PB + (t0_ + reg_) * PBW + gcol + 8 * l15); } while (0)
#define SC_LOADT(c) do { const float* tg_ = (const float*)(blobs + (size_t)(c) * GE::BLOB + GE::OFF_TAB); _Pragma("unroll") for (int a_ = 0; a_ < NKT; ++a_) _Pragma("unroll") for (int x_ = 0; x_ < 3; ++x_) tb[a_][x_] = *(const f32x4*)(tg_ + x_ * K + 16 * (NKT * ws + a_) + 4 * q4); } while (0)
#define SC_WAITN(n) asm volatile("s_waitcnt vmcnt(%0)" :: "n"(n) : "memory")
#define SC_BARL() do { asm volatile("s_waitcnt lgkmcnt(0)" ::: "memory"); __builtin_amdgcn_s_barrier(); asm volatile("" ::: "memory"); } while (0)
#define SC_TOP(c) const int buf = (c) % 3; \
        LAS bf16* QR = (LAS bf16*)(lds + buf * IMG); LAS bf16* KR = (LAS bf16*)(lds + buf * IMG + GE::OFF_KR); (void)QR; (void)KR; \
        if ((c) + 1 < SEQ / 64) SC_WAITN(NDMA); else SC_WAITN(0);     \
        SC_BARL();       \
        SC_PIN(pv);      \
        { u32x4 w0, w1; \
          w0.x = pv[0] | ((unsigned)pv[1] << 16); w0.y = pv[2] | ((unsigned)pv[3] << 16); w0.z = pv[4] | ((unsigned)pv[5] << 16); w0.w = pv[6] | ((unsigned)pv[7] << 16); \
          w1.x = pv[8] | ((unsigned)pv[9] << 16); w1.y = pv[10] | ((unsigned)pv[11] << 16); w1.z = pv[12] | ((unsigned)pv[13] << 16); w1.w = pv[14] | ((unsigned)pv[15] << 16); \
          *(LAS u32x4*)(VT + vrow * VS + 16 * jg) = w0; *(LAS u32x4*)(VT + vrow * VS + 16 * jg + 8) = w1; }
    unsigned pv[16];
    SC_LOADV(0);
    if (owave) {
        float nw[8]; u32x4 pgc[4], pgn[4], yv[4];
        { const f32x4 n0 = *(const f32x4*)(onw + 8 * l15), n1 = *(const f32x4*)(onw + 8 * l15 + 4); nw[0] = n0[0]; nw[1] = n0[1]; nw[2] = n0[2]; nw[3] = n0[3]; nw[4] = n1[0]; nw[5] = n1[1]; nw[6] = n1[2]; nw[7] = n1[3]; }
        SC_LOADG(0, pgc);
        SC_DMA(0, 0); SC_DMA(1, 1);
#pragma unroll
        for (int reg = 0; reg < 4; ++reg) { yv[reg] = (u32x4){0u, 0u, 0u, 0u}; pgn[reg] = yv[reg]; }
        for (int c = 0; c < SEQ / 64; ++c) {
            SC_TOP(c)
            SC_BARL();
            if (c + 1 < SEQ / 64) { SC_LOADV(c + 1); SC_LOADG(c + 1, pgn); }
            if (c > 0) { bf16* yp = Y + ((size_t)b * SEQ + (size_t)(c - 1) * 64 + 16 * I + 4 * q4) * D + GRP * 512 + h * 128 + 8 * l15;
#pragma unroll
                for (int reg = 0; reg < 4; ++reg) *(u32x4*)(yp + (size_t)reg * D) = yv[reg]; }
            if (c + 2 < SEQ / 64) SC_DMA(c + 2, (c + 2) % 3);
            bf16x8 qf[NS];
#pragma unroll
            for (int s2 = 0; s2 < NS; ++s2) qf[s2] = *(const LAS bf16x8*)(QR + (16 * I + l15) * QS + 32 * s2 + 8 * q4);
            f32x4 AT[4];
#pragma unroll
            for (int J = 0; J < 4; ++J) { f32x4 acc = (f32x4){0.f, 0.f, 0.f, 0.f};
                if (J <= I) {
#pragma unroll
                    for (int s2 = 0; s2 < NS; ++s2) { const bf16x8 kf = *(const LAS bf16x8*)(KR + (16 * J + l15) * QS + 32 * s2 + 8 * q4); acc = __builtin_amdgcn_mfma_f32_16x16x32_bf16(kf, qf[s2], acc, 0, 0, 0); }
                    if (J == I) {
#pragma unroll
                        for (int reg = 0; reg < 4; ++reg) acc[reg] = (4 * q4 + reg > l15) ? 0.f : acc[reg]; } }
                AT[J] = acc; }
            u32x4 aw[2];
#pragma unroll
            for (int sp = 0; sp < 2; ++sp) { aw[sp].x = cvtpk(AT[2 * sp][0], AT[2 * sp][1]); aw[sp].y = cvtpk(AT[2 * sp][2], AT[2 * sp][3]); aw[sp].z = cvtpk(AT[2 * sp + 1][0], AT[2 * sp + 1][1]); aw[sp].w = cvtpk(AT[2 * sp + 1][2], AT[2 * sp + 1][3]); }
            f32x4 o[8]; float ss[4] = {0.f, 0.f, 0.f, 0.f};
#pragma unroll
            for (int vt = 0; vt < 8; ++vt) { f32x4 oo = (f32x4){0.f, 0.f, 0.f, 0.f};
#pragma unroll
                for (int sp = 0; sp < 2; ++sp) if (2 * sp <= I) {
                    const u32x2 b0 = *(const LAS u32x2*)(VT + (16 * vt + l15) * VS + 32 * sp + 4 * q4), b1 = *(const LAS u32x2*)(VT + (16 * vt + l15) * VS + 32 * sp + 16 + 4 * q4);
                    u32x4 bw; bw.x = b0.x; bw.y = b0.y; bw.z = b1.x; bw.w = b1.y;
                    oo = __builtin_amdgcn_mfma_f32_16x16x32_bf16(__builtin_bit_cast(bf16x8, aw[sp]), __builtin_bit_cast(bf16x8, bw), oo, 0, 0, 0); }
#pragma unroll
                for (int s2 = 0; s2 < NS; ++s2) { const bf16x8 sf = *(const LAS bf16x8*)(SST + (16 * vt + l15) * QS + 32 * s2 + 8 * q4); oo = __builtin_amdgcn_mfma_f32_16x16x32_bf16(qf[s2], sf, oo, 0, 0, 0); }
                o[vt] = oo;
#pragma unroll
                for (int reg = 0; reg < 4; ++reg) ss[reg] += oo[reg] * oo[reg]; }
#pragma unroll
            for (int reg = 0; reg < 4; ++reg) { float t = ss[reg]; t += __shfl_xor(t, 1); t += __shfl_xor(t, 2); t += __shfl_xor(t, 4); t += __shfl_xor(t, 8); const float rs = rsqrtf(t * (1.f / 128.f) + EPS);
                const unsigned gw[4] = {pgc[reg].x, pgc[reg].y, pgc[reg].z, pgc[reg].w}; unsigned yw[4];
#pragma unroll
                for (int j = 0; j < 4; ++j) yw[j] = cvtpk(o[2 * j][reg] * rs * nw[2 * j] * bf2f(gw[j] & 0xffffu), o[2 * j + 1][reg] * rs * nw[2 * j + 1] * bf2f(gw[j] >> 16));
                yv[reg] = (u32x4){yw[0], yw[1], yw[2], yw[3]}; pgc[reg] = pgn[reg]; }
        }
        { bf16* yp = Y + ((size_t)b * SEQ + (size_t)(SEQ / 64 - 1) * 64 + 16 * I + 4 * q4) * D + GRP * 512 + h * 128 + 8 * l15;
#pragma unroll
          for (int reg = 0; reg < 4; ++reg) *(u32x4*)(yp + (size_t)reg * D) = yv[reg]; }
    } else {
        f32x4 S[NKT][8]; f32x4 tb[NKT][3];
#pragma unroll
        for (int a = 0; a < NKT; ++a)
#pragma unroll
            for (int vt = 0; vt < 8; ++vt) S[a][vt] = (f32x4){0.f, 0.f, 0.f, 0.f};
        SC_LOADT(0);
        SC_DMA(0, 0); SC_DMA(1, 1);
        for (int c = 0; c < SEQ / 64; ++c) {
            SC_TOP(c)
            float d63[NKT][4], e2[NKT][4];
#pragma unroll
            for (int a = 0; a < NKT; ++a) { const int kt = NKT * ws + a;
#pragma unroll
                for (int reg = 0; reg < 4; ++reg) { d63[a][reg] = tb[a][1][reg]; e2[a][reg] = tb[a][2][reg]; }
#pragma unroll
                for (int vt = 0; vt < 8; ++vt) { u32x2 w; w.x = cvtpk(tb[a][0][0] * S[a][vt][0], tb[a][0][1] * S[a][vt][1]); w.y = cvtpk(tb[a][0][2] * S[a][vt][2], tb[a][0][3] * S[a][vt][3]);
                    *(LAS u32x2*)(SST + (16 * vt + l15) * QS + 16 * kt + 4 * q4) = w; } }
            SC_BARL();
            if (c + 1 < SEQ / 64) { SC_LOADV(c + 1); SC_LOADT(c + 1); }
            if (c + 2 < SEQ / 64) SC_DMA(c + 2, (c + 2) % 3);
            bf16x8 af[NKT][2];
            s16x4 tt[NKT][2][2];
#pragma unroll
            for (int a = 0; a < NKT; ++a)
#pragma unroll
                for (int s2 = 0; s2 < 2; ++s2) { const LAS bf16* tp = KR + (32 * s2 + 8 * q4 + (l15 >> 2)) * QS + 16 * (NKT * ws + a) + 4 * (l15 & 3);
                    const unsigned ta = (unsigned)(unsigned long)tp;
                    asm volatile("ds_read_b64_tr_b16 %0, %1" : "=v"(tt[a][s2][0]) : "v"(ta) : "memory");
                    asm volatile("ds_read_b64_tr_b16 %0, %1 offset:%2" : "=v"(tt[a][s2][1]) : "v"(ta), "n"(4 * QS * 2) : "memory"); }
            if constexpr (NKT == 2) asm volatile("s_waitcnt lgkmcnt(0)" : "+v"(tt[0][0][0]), "+v"(tt[0][0][1]), "+v"(tt[0][1][0]), "+v"(tt[0][1][1]), "+v"(tt[1][0][0]), "+v"(tt[1][0][1]), "+v"(tt[1][1][0]), "+v"(tt[1][1][1]) :: "memory");
            else asm volatile("s_waitcnt lgkmcnt(0)" : "+v"(tt[0][0][0]), "+v"(tt[0][0][1]), "+v"(tt[0][1][0]), "+v"(tt[0][1][1]) :: "memory");
#pragma unroll
            for (int a = 0; a < NKT; ++a)
#pragma unroll
                for (int s2 = 0; s2 < 2; ++s2) { const s16x4 t0 = tt[a][s2][0], t1 = tt[a][s2][1]; af[a][s2] = (bf16x8){t0[0], t0[1], t0[2], t0[3], t1[0], t1[1], t1[2], t1[3]}; }
#pragma unroll
            for (int vt = 0; vt < 8; ++vt) { bf16x8 vf[2];
#pragma unroll
                for (int s2 = 0; s2 < 2; ++s2) vf[s2] = *(const LAS bf16x8*)(VT + (16 * vt + l15) * VS + 32 * s2 + 8 * q4);
#pragma unroll
                for (int a = 0; a < NKT; ++a) { f32x4 T = (f32x4){0.f, 0.f, 0.f, 0.f};
#pragma unroll
                    for (int s2 = 0; s2 < 2; ++s2) T = __builtin_amdgcn_mfma_f32_16x16x32_bf16(af[a][s2], vf[s2], T, 0, 0, 0);
#pragma unroll
                    for (int reg = 0; reg < 4; ++reg) S[a][vt][reg] = d63[a][reg] * S[a][vt][reg] + e2[a][reg] * T[reg]; } }
        }
    }
    SC_BAR();
#undef SC_TOP
#undef SC_WAITN
#undef SC_BARL
#undef SC_DMA
#undef SC_LOADV
#undef SC_LOADG
#undef SC_LOADT
}

#ifndef CVW_P2
#define CVW_P2 4
#endif
#ifndef SCANV8
#define SCANV8 1
#endif
#if SCANV8
#define SCANFN scan128v8
#else
#define SCANFN scan128
#endif
template <int K, int GRP>
__device__ __forceinline__ void scan128v8(LAS unsigned char* lds, const bf16* PB, const unsigned char* blobs, bf16* Y, const float* onw, int b, int h, int tid, int lane, int wave) {
    typedef ScanGeo<K> GE; constexpr int QS = GE::QS, VS = GE::VS, NS = K / 32, NKT = K / 64, IMG = GE::OFF_TAB, NDMA = (GE::OFF_TAB / 8) / 1024 + 1;
    constexpr int PW = IMG / 8, NPF = PW / 1024, REM = (PW - NPF * 1024) / 16;
    LAS unsigned char* VTb = lds + 3 * IMG; LAS bf16* VT = (LAS bf16*)VTb; LAS bf16* SST = (LAS bf16*)(VTb + 128 * VS * 2);
    const int q4 = lane >> 4, l15 = lane & 15;
    const int vcol = (GRP == 0 ? C_HI : C_GV) + h * 128, gcol = (GRP == 0 ? C_HGATE : C_GGATE) + h * 128;
    const bool owave = wave < 4; const int I = wave & 3, ws = wave & 3;
    const int vrow = tid & 127, vv = 8 * (vrow & 15) + (vrow >> 4), jg = tid >> 7;
#define SC_DMA(c, buf) do { const unsigned char* src_ = blobs + (size_t)(c) * GE::BLOB + wave * PW + lane * 16; LAS unsigned char* dst_ = lds + (buf) * IMG + wave * PW; \
        _Pragma("unroll") for (int i_ = 0; i_ < NPF; ++i_) __builtin_amdgcn_global_load_lds((const unsigned*)(src_ + i_ * 1024), (LAS unsigned*)(dst_ + i_ * 1024), 16, 0, 0); \
        if (lane < REM) __builtin_amdgcn_global_load_lds((const unsigned*)(src_ + NPF * 1024), (LAS unsigned*)(dst_ + NPF * 1024), 16, 0, 0); } while (0)
#define SC_LOADV(c, pv) do { const size_t t0_ = (size_t)b * SEQ + (size_t)(c) * 64 + 16 * jg; _Pragma("unroll") for (int r_ = 0; r_ < 16; ++r_) pv[r_] = PB[(t0_ + r_) * PBW + vcol + vv]; } while (0)
#define SC_LOADG(c, dst) do { const size_t t0_ = (size_t)b * SEQ + (size_t)(c) * 64 + 16 * I + 4 * q4; _Pragma("unroll") for (int reg_ = 0; reg_ < 4; ++reg_) dst[reg_] = *(const u32x4*)(PB + (t0_ + reg_) * PBW + gcol + 8 * l15); } while (0)
#define SC_LOADT(c, tb) do { const float* tg_ = (const float*)(blobs + (size_t)(c) * GE::BLOB + GE::OFF_TAB); _Pragma("unroll") for (int a_ = 0; a_ < NKT; ++a_) _Pragma("unroll") for (int x_ = 0; x_ < 3; ++x_) tb[a_][x_] = *(const f32x4*)(tg_ + x_ * K + 16 * (NKT * ws + a_) + 4 * q4); } while (0)
#define SC_WAITN(n) asm volatile("s_waitcnt vmcnt(%0)" :: "n"(n) : "memory")
#define SC_BARL() do { asm volatile("s_waitcnt lgkmcnt(0)" ::: "memory"); __builtin_amdgcn_s_barrier(); asm volatile("" ::: "memory"); } while (0)
#define SC_TOP(c, pv, nwait) const int buf = (c) % 3; \
        LAS bf16* QR = (LAS bf16*)(lds + buf * IMG); LAS bf16* KR = (LAS bf16*)(lds + buf * IMG + GE::OFF_KR); (void)QR; (void)KR; \
        SC_WAITN(nwait);     \
        SC_BARL();       \
        SC_PIN(pv);      \
        { u32x4 w0, w1; \
          w0.x = pv[0] | ((unsigned)pv[1] << 16); w0.y = pv[2] | ((unsigned)pv[3] << 16); w0.z = pv[4] | ((unsigned)pv[5] << 16); w0.w = pv[6] | ((unsigned)pv[7] << 16); \
          w1.x = pv[8] | ((unsigned)pv[9] << 16); w1.y = pv[10] | ((unsigned)pv[11] << 16); w1.z = pv[12] | ((unsigned)pv[13] << 16); w1.w = pv[14] | ((unsigned)pv[15] << 16); \
          *(LAS u32x4*)(VT + vrow * VS + 16 * jg) = w0; *(LAS u32x4*)(VT + vrow * VS + 16 * jg + 8) = w1; }
    constexpr int NCH = SEQ / 64, UNR = 2;
#define SC_CL(c) ((c) < NCH ? (c) : NCH - 1)
    unsigned pvs[2][16];
    SC_LOADV(0, pvs[0]); SC_LOADV(1, pvs[1]);
    if (owave) {
        float nw[8]; u32x4 pgs[2][4], yv[4];
        constexpr int WOUT = 16 + 4 + 4 + NPF;
        { const f32x4 n0 = *(const f32x4*)(onw + 8 * l15), n1 = *(const f32x4*)(onw + 8 * l15 + 4); nw[0] = n0[0]; nw[1] = n0[1]; nw[2] = n0[2]; nw[3] = n0[3]; nw[4] = n1[0]; nw[5] = n1[1]; nw[6] = n1[2]; nw[7] = n1[3]; }
        SC_LOADG(0, pgs[0]); SC_LOADG(1, pgs[1]);
        SC_DMA(0, 0); SC_DMA(1, 1);
#pragma unroll
        for (int reg = 0; reg < 4; ++reg) yv[reg] = (u32x4){0u, 0u, 0u, 0u};
        SC_WAITN(0);
        for (int c0 = 0; c0 < NCH; c0 += UNR) {
#pragma unroll
          for (int j = 0; j < UNR; ++j) { const int c = c0 + j; const int par = j & 1;
            SC_TOP(c, pvs[par], WOUT)
            SC_BARL();
            SC_LOADV(SC_CL(c + 2), pvs[par]);
            { bf16* yp = Y + ((size_t)b * SEQ + (size_t)(c > 0 ? c - 1 : 0) * 64 + 16 * I + 4 * q4) * D + GRP * 512 + h * 128 + 8 * l15;
#pragma unroll
                for (int reg = 0; reg < 4; ++reg) *(u32x4*)(yp + (size_t)reg * D) = yv[reg]; }
            SC_DMA(SC_CL(c + 2), (c + 2) % 3);
            bf16x8 qf[NS];
#pragma unroll
            for (int s2 = 0; s2 < NS; ++s2) qf[s2] = *(const LAS bf16x8*)(QR + (16 * I + l15) * QS + 32 * s2 + 8 * q4);
            f32x4 AT[4];
#pragma unroll
            for (int J = 0; J < 4; ++J) { f32x4 acc = (f32x4){0.f, 0.f, 0.f, 0.f};
                if (J <= I) {
#pragma unroll
                    for (int s2 = 0; s2 < NS; ++s2) { const bf16x8 kf = *(const LAS bf16x8*)(KR + (16 * J + l15) * QS + 32 * s2 + 8 * q4); acc = __builtin_amdgcn_mfma_f32_16x16x32_bf16(kf, qf[s2], acc, 0, 0, 0); }
                    if (J == I) {
#pragma unroll
                        for (int reg = 0; reg < 4; ++reg) acc[reg] = (4 * q4 + reg > l15) ? 0.f : acc[reg]; } }
                AT[J] = acc; }
            u32x4 aw[2];
#pragma unroll
            for (int sp = 0; sp < 2; ++sp) { aw[sp].x = cvtpk(AT[2 * sp][0], AT[2 * sp][1]); aw[sp].y = cvtpk(AT[2 * sp][2], AT[2 * sp][3]); aw[sp].z = cvtpk(AT[2 * sp + 1][0], AT[2 * sp + 1][1]); aw[sp].w = cvtpk(AT[2 * sp + 1][2], AT[2 * sp + 1][3]); }
            f32x4 o[8]; float ss[4] = {0.f, 0.f, 0.f, 0.f};
#pragma unroll
            for (int vt = 0; vt < 8; ++vt) { f32x4 oo = (f32x4){0.f, 0.f, 0.f, 0.f};
#pragma unroll
                for (int sp = 0; sp < 2; ++sp) if (2 * sp <= I) {
                    const u32x2 b0 = *(const LAS u32x2*)(VT + (16 * vt + l15) * VS + 32 * sp + 4 * q4), b1 = *(const LAS u32x2*)(VT + (16 * vt + l15) * VS + 32 * sp + 16 + 4 * q4);
                    u32x4 bw; bw.x = b0.x; bw.y = b0.y; bw.z = b1.x; bw.w = b1.y;
                    oo = __builtin_amdgcn_mfma_f32_16x16x32_bf16(__builtin_bit_cast(bf16x8, aw[sp]), __builtin_bit_cast(bf16x8, bw), oo, 0, 0, 0); }
#pragma unroll
                for (int s2 = 0; s2 < NS; ++s2) { const bf16x8 sf = *(const LAS bf16x8*)(SST + (16 * vt + l15) * QS + 32 * s2 + 8 * q4); oo = __builtin_amdgcn_mfma_f32_16x16x32_bf16(qf[s2], sf, oo, 0, 0, 0); }
                o[vt] = oo;
#pragma unroll
                for (int reg = 0; reg < 4; ++reg) ss[reg] += oo[reg] * oo[reg]; }
#pragma unroll
            for (int reg = 0; reg < 4; ++reg) { float t = ss[reg]; t += __shfl_xor(t, 1); t += __shfl_xor(t, 2); t += __shfl_xor(t, 4); t += __shfl_xor(t, 8); const float rs = rsqrtf(t * (1.f / 128.f) + EPS);
                const unsigned gw[4] = {pgs[par][reg].x, pgs[par][reg].y, pgs[par][reg].z, pgs[par][reg].w}; unsigned yw[4];
#pragma unroll
                for (int j = 0; j < 4; ++j) yw[j] = cvtpk(o[2 * j][reg] * rs * nw[2 * j] * bf2f(gw[j] & 0xffffu), o[2 * j + 1][reg] * rs * nw[2 * j + 1] * bf2f(gw[j] >> 16));
                yv[reg] = (u32x4){yw[0], yw[1], yw[2], yw[3]}; }
            SC_LOADG(SC_CL(c + 2), pgs[par]);
          }
        }
        { bf16* yp = Y + ((size_t)b * SEQ + (size_t)(SEQ / 64 - 1) * 64 + 16 * I + 4 * q4) * D + GRP * 512 + h * 128 + 8 * l15;
#pragma unroll
          for (int reg = 0; reg < 4; ++reg) *(u32x4*)(yp + (size_t)reg * D) = yv[reg]; }
    } else {
        f32x4 S[NKT][8]; f32x4 tbs[2][NKT][3];
        constexpr int WST = 16 + NKT * 3 + NPF;
#pragma unroll
        for (int a = 0; a < NKT; ++a)
#pragma unroll
            for (int vt = 0; vt < 8; ++vt) S[a][vt] = (f32x4){0.f, 0.f, 0.f, 0.f};
        SC_LOADT(0, tbs[0]); SC_LOADT(1, tbs[1]);
        SC_DMA(0, 0); SC_DMA(1, 1);
        SC_WAITN(0);
        for (int c0 = 0; c0 < NCH; c0 += UNR) {
#pragma unroll
          for (int j = 0; j < UNR; ++j) { const int c = c0 + j; const int par = j & 1;
            SC_TOP(c, pvs[par], WST)
            float d63[NKT][4], e2[NKT][4];
#pragma unroll
            for (int a = 0; a < NKT; ++a) { const int kt = NKT * ws + a;
#pragma unroll
                for (int reg = 0; reg < 4; ++reg) { d63[a][reg] = tbs[par][a][1][reg]; e2[a][reg] = tbs[par][a][2][reg]; }
#pragma unroll
                for (int vt = 0; vt < 8; ++vt) { u32x2 w; w.x = cvtpk(tbs[par][a][0][0] * S[a][vt][0], tbs[par][a][0][1] * S[a][vt][1]); w.y = cvtpk(tbs[par][a][0][2] * S[a][vt][2], tbs[par][a][0][3] * S[a][vt][3]);
                    *(LAS u32x2*)(SST + (16 * vt + l15) * QS + 16 * kt + 4 * q4) = w; } }
            SC_BARL();
            SC_LOADV(SC_CL(c + 2), pvs[par]); SC_LOADT(SC_CL(c + 2), tbs[par]);
            SC_DMA(SC_CL(c + 2), (c + 2) % 3);
            bf16x8 af[NKT][2];
            s16x4 tt[NKT][2][2];
#pragma unroll
            for (int a = 0; a < NKT; ++a)
#pragma unroll
                for (int s2 = 0; s2 < 2; ++s2) { const LAS bf16* tp = KR + (32 * s2 + 8 * q4 + (l15 >> 2)) * QS + 16 * (NKT * ws + a) + 4 * (l15 & 3);
                    const unsigned ta = (unsigned)(unsigned long)tp;
                    asm volatile("ds_read_b64_tr_b16 %0, %1" : "=v"(tt[a][s2][0]) : "v"(ta) : "memory");
                    asm volatile("ds_read_b64_tr_b16 %0, %1 offset:%2" : "=v"(tt[a][s2][1]) : "v"(ta), "n"(4 * QS * 2) : "memory"); }
            if constexpr (NKT == 2) asm volatile("s_waitcnt lgkmcnt(0)" : "+v"(tt[0][0][0]), "+v"(tt[0][0][1]), "+v"(tt[0][1][0]), "+v"(tt[0][1][1]), "+v"(tt[1][0][0]), "+v"(tt[1][0][1]), "+v"(tt[1][1][0]), "+v"(tt[1][1][1]) :: "memory");
            else asm volatile("s_waitcnt lgkmcnt(0)" : "+v"(tt[0][0][0]), "+v"(tt[0][0][1]), "+v"(tt[0][1][0]), "+v"(tt[0][1][1]) :: "memory");
#pragma unroll
            for (int a = 0; a < NKT; ++a)
#pragma unroll
                for (int s2 = 0; s2 < 2; ++s2) { const s16x4 t0 = tt[a][s2][0], t1 = tt[a][s2][1]; af[a][s2] = (bf16x8){t0[0], t0[1], t0[2], t0[3], t1[0], t1[1], t1[2], t1[3]}; }
#pragma unroll
            for (int vt = 0; vt < 8; ++vt) { bf16x8 vf[2];
#pragma unroll
                for (int s2 = 0; s2 < 2; ++s2) vf[s2] = *(const LAS bf16x8*)(VT + (16 * vt + l15) * VS + 32 * s2 + 8 * q4);
#pragma unroll
                for (int a = 0; a < NKT; ++a) { f32x4 T = (f32x4){0.f, 0.f, 0.f, 0.f};
#pragma unroll
                    for (int s2 = 0; s2 < 2; ++s2) T = __builtin_amdgcn_mfma_f32_16x16x32_bf16(af[a][s2], vf[s2], T, 0, 0, 0);
#pragma unroll
                    for (int reg = 0; reg < 4; ++reg) S[a][vt][reg] = d63[a][reg] * S[a][vt][reg] + e2[a][reg] * T[reg]; } }
          }
        }
    }
    SC_BAR();
#undef SC_TOP
#undef SC_CL
#undef SC_WAITN
#undef SC_BARL
#undef SC_DMA
#undef SC_LOADV
#undef SC_LOADG
#undef SC_LOADT
}

__device__ __forceinline__ void rms_2rows_to_bf16(const float* __restrict__ x0, const float* __restrict__ x1, const float* __restrict__ w, bf16* __restrict__ o0, bf16* __restrict__ o1, int lane) {
    const f32x4* xa = (const f32x4*)x0 + lane; const f32x4* xb = (const f32x4*)x1 + lane;
    f32x4 va[4], vb[4]; float sa = 0.f, sb = 0.f;
#pragma unroll
    for (int j = 0; j < 4; ++j) { va[j] = xa[64 * j]; vb[j] = xb[64 * j]; }
#pragma unroll
    for (int j = 0; j < 4; ++j) { sa += (va[j].x * va[j].x + va[j].y * va[j].y) + (va[j].z * va[j].z + va[j].w * va[j].w); sb += (vb[j].x * vb[j].x + vb[j].y * vb[j].y) + (vb[j].z * vb[j].z + vb[j].w * vb[j].w); }
    const float ra = rsqrtf(wave_sum(sa) * (1.f / D) + EPS), rb = rsqrtf(wave_sum(sb) * (1.f / D) + EPS);
    u32x2* pa = (u32x2*)o0 + lane; u32x2* pb = (u32x2*)o1 + lane;
#pragma unroll
    for (int j = 0; j < 4; ++j) { const f32x4 ww = ((const f32x4*)w)[lane + 64 * j]; u32x2 o; o.x = pk2(va[j].x * ra * ww.x, va[j].y * ra * ww.y); o.y = pk2(va[j].z * ra * ww.z, va[j].w * ra * ww.w); pa[64 * j] = o;
        o.x = pk2(vb[j].x * rb * ww.x, vb[j].y * rb * ww.y); o.y = pk2(vb[j].z * rb * ww.z, vb[j].w * rb * ww.w); pb[64 * j] = o; }
}
__global__ void __launch_bounds__(NWAVES * 64, 2) mega_fwd(Args args) {
    extern __shared__ __attribute__((aligned(16))) unsigned char lds_raw[];
    LAS unsigned char* lds = (LAS unsigned char*)lds_raw;
    volatile LAS unsigned* MISC = (volatile LAS unsigned*)(lds + MISC_OFF);
    const int tid0 = threadIdx.x, wave = __builtin_amdgcn_readfirstlane(tid0 >> 6);
    const int G = gridDim.x, bx = blockIdx.x;
    const int vcu = (G % 8 == 0) ? (bx % 8) * (G / 8) + bx / 8 : bx;
    unsigned char* ws = args.ws;
    unsigned* ctl = (unsigned*)(ws + WS_CTL);
    for (int u = tid0; u < (LDS_BYTES - LDSCTL_OFF) / 4; u += NWAVES * 64) ((LAS unsigned*)(lds + LDSCTL_OFF))[u] = 0u;
    __syncthreads();
    XcdBarrier bar = xcd_barrier_post(ctl + CW_BAR + args.li * XCD_BAR_WORDS, MISC + 8);
    const int lo = args.ph_lo, hi = args.ph_hi;
#define IN(k) (lo <= (k) && (k) < hi)
#define SEAM(k) do { if (IN(k) && IN((k) + 1)) xcd_barrier(bar, wave == 0 && fresh_lane() == 0); } while (0)
    const float* x = args.in[0]; const float* mem = args.in[1]; const float* norm_mix_w = args.in[2]; const float* w_in = args.in[3]; const float* lb_logits = args.in[4];
    const float* norm_xa_w = args.in[10]; const float* norm_moe_w = args.in[15];
    const float* w_gk2 = args.in[6]; const float* b_gk = args.in[7]; const float* w_out = args.in[9]; const float* norm_mem_w = args.in[11];
    const float* w_xq = args.in[12]; const float* w_xkv = args.in[13]; const float* w_xo = args.in[14]; const float* w_gu = args.in[18]; const float* w_down = args.in[20];
    float* LB = (float*)(ws + WS_TAB + OFF_LB);
    bf16* WT_IN = (bf16*)(ws + WS_WT_IN); bf16* WT_OUT = (bf16*)(ws + WS_WT_OUT); bf16* WT_XQ = (bf16*)(ws + WS_WT_XQ); bf16* WT_XKV = (bf16*)(ws + WS_WT_XKV); bf16* WT_XO = (bf16*)(ws + WS_WT_XO);
    bf16* WT_GU = (bf16*)(ws + WS_WT_GU); bf16* WT_DN = (bf16*)(ws + WS_WT_DN);
    bf16* PB = (bf16*)(ws + WS_PB); _Float16* Gd = (_Float16*)(ws + WS_G); bf16* HB = (bf16*)(ws + WS_HB); bf16* HMB = (bf16*)(ws + WS_HMB); bf16* KB = (bf16*)(ws + WS_KB); bf16* VT = (bf16*)(ws + WS_VT);

    if (IN(0)) { const int lane = fresh_lane(), tid = wave * 64 + lane; (void)tid;
        LAS float* scr = (LAS float*)(lds + RING_OFF + wave * 16384);
        const int gw = vcu * NWAVES + wave, NGW = G * NWAVES;
        constexpr int I_IN = 16 * (PBW / 32), I_SQ = 16 * 32, I_KV = 16 * 64;
        constexpr int NITEMS = I_IN + 3 * I_SQ + I_KV;
        for (int it = gw; it < NITEMS; it += NGW) {
            int r = it;
            if (r < I_IN) { const int nb = r % (PBW / 32), kb = r / (PBW / 32); p0_transpose_item(w_in, INW, WT_IN, nb * 32, nb * 32, kb * 64, scr, lane); continue; } r -= I_IN;
            if (r < I_SQ) { const int nb = r & 31, kb = r >> 5; p0_transpose_item(w_out, D, WT_OUT, nb * 32, nb * 32, kb * 64, scr, lane); continue; } r -= I_SQ;
            if (r < I_SQ) { const int nb = r & 31, kb = r >> 5; p0_transpose_item(w_xq, D, WT_XQ, nb * 32, nb * 32, kb * 64, scr, lane, norm_xa_w); continue; } r -= I_SQ;
            if (r < I_SQ) { const int nb = r & 31, kb = r >> 5; p0_transpose_item(w_xo, D, WT_XO, nb * 32, nb * 32, kb * 64, scr, lane); continue; } r -= I_SQ;
            { const int nb = r & 63, kb = r >> 6; p0_transpose_item(w_xkv, 2048, WT_XKV, nb * 32, nb * 32, kb * 64, scr, lane); }
        }
        for (int it = gw; it < 256 * 16; it += NGW) { const int n = it >> 4, k = (it & 15) * 64 + lane; float s = 0.f;
#pragma unroll
            for (int r = 0; r < 16; ++r) s += w_in[(size_t)k * INW + C_GLR + r] * w_gk2[r * 256 + n];
            WT_IN[(size_t)(C_GLR + n) * D + k] = (bf16)f2bf(s); }
        if (bx == 0) { const int j = tid; LB[j] = 1.f / (1.f + __expf(lb_logits[512 + j] - lb_logits[j])); }
        for (int m = gw; m < NTOK; m += 2 * NGW) rms_2rows_to_bf16(x + (size_t)m * D, x + (size_t)(m + NGW) * D, norm_mix_w, HB + (size_t)m * D, HB + (size_t)(m + NGW) * D, lane);
        for (int m = gw; m < NMEM; m += NGW) rms_row_to_bf16(mem + (size_t)m * D, norm_mem_w, HMB + (size_t)m * D, lane);
    }
    SEAM(0);
    if (IN(1)) { const int lane = fresh_lane(), tid = wave * 64 + lane; (void)tid;
        pg8::SchedP1 S{(const char*)HB, (const char*)WT_IN, (const char*)HMB, (const char*)WT_XKV, G, bx};
        pg8::EpiP1 E{PB, Gd, KB, VT, LB, b_gk};
        pg8::gemm_phase<pg8::EpiP1, pg8::SchedP1>(lds + RING_OFF, S, E, tid, wave);
    }
    SEAM(1);

    const float* hg_onorm_w = args.in[5]; const float* gla_onorm_w = args.in[8];
    const float* w_router = args.in[16]; const float* b_router = args.in[17]; const float* b_gu = args.in[19]; const float* b_down = args.in[21]; const float* norm_final_w = args.in[22];
    bf16* Y = (bf16*)(ws + WS_Y); bf16* Q = (bf16*)(ws + WS_Q); bf16* AO = (bf16*)(ws + WS_AO); float* X1 = (float*)(ws + WS_X1);
    bf16* XG = (bf16*)(ws + WS_XG); bf16* ACT = (bf16*)(ws + WS_ACT); bf16* YB = (bf16*)(ws + WS_YB);
    int* tok_e = (int*)(ws + WS_TOKE); float* tok_g = (float*)(ws + WS_TOKG); int* tok_dest = (int*)(ws + WS_TOKDEST); float* row_gate = (float*)(ws + WS_ROWGATE);
    float* SSQ1 = (float*)(ws + WS_SSQ); float* tok_rstd = (float*)(ws + WS_TOKRSTD); float* row_rstd = (float*)(ws + WS_ROWRSTD);
    unsigned char* HB8 = ws + WS_XG; int* row_tok = (int*)(ws + WS_XG + 32 * MiB);
    int* HIST = (int*)(ws + WS_TAB + OFF_HIST); int* tile_e = (int*)(ws + WS_TAB + OFF_TILEE); int* nrt_p = (int*)(ws + WS_TAB + OFF_NRT);
    if (IN(2)) { const int lane = fresh_lane(), tid = wave * 64 + lane; (void)tid;
        unsigned char* blobs = ws + WS_YB;
        {
            float gA[16]; unsigned short qA[16], kA[16]; float gB[8]; unsigned short qB[8], kB[8];
            { const int sq = vcu & 31, c = vcu >> 5; prep_load<128, 0>(gA, qA, kA, PB, Gd, sq >> 2, sq & 3, c, tid); }
#pragma unroll 1
            for (int j = 0; j < 4; ++j) { const int rest = j * 256 + vcu, sq = rest & 31, c = rest >> 5;
                prep_p1<128>(gA, qA, kA, lds + RING_OFF, tid);
                prep_load<64, 1>(gB, qB, kB, PB, Gd, sq >> 2, sq & 3, c, tid);
                prep_p2<128>(lds + RING_OFF, blobs + blob_off(0, sq >> 2, sq & 3, c), tid);
                prep_p1<64>(gB, qB, kB, lds + RING_OFF, tid);
                if (j < 3) { const int rest2 = (j + 1) * 256 + vcu, sq2 = rest2 & 31, c2 = rest2 >> 5; prep_load<128, 0>(gA, qA, kA, PB, Gd, sq2 >> 2, sq2 & 3, c2, tid); }
                prep_p2<64>(lds + RING_OFF, blobs + blob_off(1, sq >> 2, sq & 3, c), tid); }
            asm volatile("s_waitcnt vmcnt(0)" ::: "memory");
        }
        xcd_barrier(bar, wave == 0 && fresh_lane() == 0);
        if ((vcu & 3) == 0) { const int sidx = vcu >> 2, grp = sidx >> 5, sq = sidx & 31;
            if (grp == 0) SCANFN<128, 0>(lds + RING_OFF, PB, blobs + blob_off(0, sq >> 2, sq & 3, 0), Y, hg_onorm_w, sq >> 2, sq & 3, tid, lane, wave);
            else SCANFN<64, 1>(lds + RING_OFF, PB, blobs + blob_off(1, sq >> 2, sq & 3, 0), Y, gla_onorm_w, sq >> 2, sq & 3, tid, lane, wave); }
        else {
            LAS float* scr = (LAS float*)(lds + RING_OFF + wave * 16384);
            constexpr int I_GU = 16 * 64, I_DN = 16 * 32;
            constexpr int CVW = CVW_P2;
            const int cidx = (vcu >> 2) * 3 + (vcu & 3) - 1, gw = wave < CVW ? cidx * CVW + wave : (1 << 30), NGW = 192 * CVW;
#define CV_DECODE(it, W_, ldw_, WT_, dr_, n0_, k0_, ks_) const float* W_; int ldw_, dr_, n0_, k0_; bf16* WT_; const float* ks_; { const int e_ = (it) / (I_GU + I_DN); int r_ = (it) - e_ * (I_GU + I_DN); \
                if (r_ < I_GU) { const int nb_ = r_ & 63, kb_ = r_ >> 6; W_ = w_gu + (size_t)e_ * D * 2048; ldw_ = 2048; WT_ = (bf16*)((unsigned char*)WT_GU + (size_t)e_ * 2048 * D * (MOE_FP8 ? 1 : 2)); dr_ = gu_rowmap(nb_ * 32); n0_ = nb_ * 32; k0_ = kb_ * 64; ks_ = norm_moe_w; } \
                else { r_ -= I_GU; const int nb_ = r_ & 31, kb_ = r_ >> 5; W_ = w_down + (size_t)e_ * D * D; ldw_ = D; WT_ = (bf16*)((unsigned char*)WT_DN + (size_t)e_ * D * D * (MOE_FP8 ? 1 : 2)); dr_ = nb_ * 32; n0_ = nb_ * 32; k0_ = kb_ * 64; ks_ = nullptr; } }
            constexpr int NIT = NEXP * (I_GU + I_DN);
            float ra[32], rb[32];
            int it = gw;
            if (it < NIT) { CV_DECODE(it, W0, l0, T0, d0, n0, k0, s0) (void)T0; (void)d0; (void)s0; p0_item_load(ra, W0, l0, n0, k0, lane); }
            while (it < NIT) {
                const int it2 = it + NGW;
                if (it2 < NIT) { CV_DECODE(it2, W1, l1, T1, d1, n1, k1, s1) (void)T1; (void)d1; (void)s1; p0_item_load(rb, W1, l1, n1, k1, lane); }
                { CV_DECODE(it, W0, l0, T0, d0, n0, k0, s0) (void)W0; (void)l0; (void)n0; p0_item_finish(ra, T0, d0, k0, scr, lane, s0); }
                if (it2 >= NIT) break;
                const int it3 = it2 + NGW;
                if (it3 < NIT) { CV_DECODE(it3, W0, l0, T0, d0, n0, k0, s0) (void)T0; (void)d0; (void)s0; p0_item_load(ra, W0, l0, n0, k0, lane); }
                { CV_DECODE(it2, W1, l1, T1, d1, n1, k1, s1) (void)W1; (void)l1; (void)n1; p0_item_finish(rb, T1, d1, k1, scr, lane, s1); }
                it = it3;
            }
#undef CV_DECODE
        }
    }
    SEAM(2);
    if (IN(3)) { const int lane = fresh_lane(), tid = wave * 64 + lane; (void)tid;
        pg8::SchedDense S{(const char*)Y, (const char*)WT_OUT, 64, 4, G, bx};
        pg8::EpiRes1 E{x, HB, SSQ1};
        pg8::gemm_phase<pg8::EpiRes1, pg8::SchedDense>(lds + RING_OFF, S, E, tid, wave);
    }
    SEAM(3);
    if (IN(5)) { const int lane = fresh_lane(), tid = wave * 64 + lane; (void)tid;
        pg8::SchedDense S{(const char*)HB, (const char*)WT_XQ, 64, 4, G, bx};
        pg8::EpiBf16S E{Q, 0.0625f, SSQ1};
        pg8::gemm_phase<pg8::EpiBf16S, pg8::SchedDense>(lds + RING_OFF, S, E, tid, wave);
        if (bx < 256) { int pm, pn; pg8::static_tile(bx, 64, 4, pm, pn);
            attn_unit(lds + RING_OFF, Q, KB, VT, AO, pm >> 3, pn, pm & 7, lane, wave); }
    }
    SEAM(6);
    if (IN(7)) { const int lane = fresh_lane(), tid = wave * 64 + lane; (void)tid;
        pg8::SchedDense S{(const char*)AO, (const char*)WT_XO, 64, 4, G, bx};
        pg8::EpiRes2 E{HB, MOE_FP8 ? HB8 : nullptr};
        pg8::gemm_phase<pg8::EpiRes2, pg8::SchedDense>(lds + RING_OFF, S, E, tid, wave);
    }
    SEAM(7);
    if (IN(8)) { const int lane = fresh_lane(), tid = wave * 64 + lane; (void)tid;
        LAS float* part = (LAS float*)(lds + RING_OFF);
        LAS float* ssqp = part + 8 * 2 * 32 * 32;
        LAS float* LG = ssqp + 8 * 64;
        LAS float* RSD = LG + 64 * 33;
        LAS int* hist = (LAS int*)(lds + LDSCTL_OFF);
        if (tid < 32) hist[tid] = 0;
        const float my_br = b_router[tid & 31];
        {
            const int r = lane & 31, hh = lane >> 5;
            u32x4 xw2[2][8];
#pragma unroll
            for (int tt = 0; tt < 2; ++tt) { const bf16* xp = HB + (size_t)(vcu * 64 + 32 * tt + r) * D + 128 * wave + 8 * hh;
#pragma unroll
                for (int s2 = 0; s2 < 8; ++s2) xw2[tt][s2] = *(const u32x4*)(xp + 16 * s2); }
            u32x4 bh[8], bl[8];
#pragma unroll
            for (int s2 = 0; s2 < 8; ++s2) { const int k0 = 128 * wave + 16 * s2 + 8 * hh; float wv[8];
                const f32x4 n0 = *(const f32x4*)(norm_moe_w + k0), n1 = *(const f32x4*)(norm_moe_w + k0 + 4);
#pragma unroll
                for (int j = 0; j < 8; ++j) wv[j] = w_router[(size_t)(k0 + j) * 32 + r] * (j < 4 ? n0[j] : n1[j - 4]);
                unsigned hw[4], lw[4];
#pragma unroll
                for (int j = 0; j < 4; ++j) { hw[j] = cvtpk(wv[2 * j], wv[2 * j + 1]); lw[j] = cvtpk(wv[2 * j] - bf2f(hw[j] & 0xffffu), wv[2 * j + 1] - bf2f(hw[j] >> 16)); }
                bh[s2] = (u32x4){hw[0], hw[1], hw[2], hw[3]}; bl[s2] = (u32x4){lw[0], lw[1], lw[2], lw[3]}; }
#pragma unroll
            for (int tt = 0; tt < 2; ++tt) { f32x16 acc; float ss = 0.f;
#pragma unroll
                for (int e = 0; e < 16; ++e) acc[e] = 0.f;
#pragma unroll
                for (int s2 = 0; s2 < 8; ++s2) { const u32x4 xw = xw2[tt][s2];
                    const float x0 = bf2f(xw.x & 0xffffu), x1 = bf2f(xw.x >> 16), x2 = bf2f(xw.y & 0xffffu), x3 = bf2f(xw.y >> 16), x4 = bf2f(xw.z & 0xffffu), x5 = bf2f(xw.z >> 16), x6 = bf2f(xw.w & 0xffffu), x7 = bf2f(xw.w >> 16);
                    ss += ((x0 * x0 + x1 * x1) + (x2 * x2 + x3 * x3)) + ((x4 * x4 + x5 * x5) + (x6 * x6 + x7 * x7));
                    const bf16x8 ah = __builtin_bit_cast(bf16x8, xw);
                    acc = __builtin_amdgcn_mfma_f32_32x32x16_bf16(ah, __builtin_bit_cast(bf16x8, bh[s2]), acc, 0, 0, 0);
                    acc = __builtin_amdgcn_mfma_f32_32x32x16_bf16(ah, __builtin_bit_cast(bf16x8, bl[s2]), acc, 0, 0, 0); }
#pragma unroll
                for (int reg = 0; reg < 16; ++reg) part[((wave * 2 + tt) * 32 + (reg & 3) + 8 * (reg >> 2) + 4 * hh) * 32 + r] = acc[reg];
                ss += __shfl_xor(ss, 32);
                if (hh == 0) ssqp[wave * 64 + 32 * tt + r] = ss; }
        }
        __syncthreads();
#pragma unroll
        for (int o = 0; o < 4; ++o) { const int idx = tid + 512 * o, tok = idx >> 5, e = idx & 31, tt = tok >> 5, tl = tok & 31; float sum = 0.f, sq = 0.f;
#pragma unroll
            for (int w = 0; w < 8; ++w) { sum += part[((w * 2 + tt) * 32 + tl) * 32 + e]; sq += ssqp[w * 64 + tok]; }
            const float rs = rsqrtf(sq * (1.f / D) + EPS);
            LG[tok * 33 + e] = sum * rs + my_br; if (e == 0) RSD[tok] = rs; }
        __syncthreads();
        if (wave == 0) {
            const int tok = vcu * 64 + lane; float l[32];
#pragma unroll
            for (int i = 0; i < 32; ++i) l[i] = LG[lane * 33 + i];
            int idx[4]; float val[4]; unsigned used = 0u;
#pragma unroll
            for (int k = 0; k < 4; ++k) { float best = -INFINITY; int bi = 0;
#pragma unroll
                for (int i = 0; i < 32; ++i) { const bool ok = !((used >> i) & 1u) && (l[i] > best); best = ok ? l[i] : best; bi = ok ? i : bi; }
                used |= 1u << bi; idx[k] = bi; val[k] = best; }
            float e4[4], es = 0.f;
#pragma unroll
            for (int k = 0; k < 4; ++k) { e4[k] = __expf(val[k] - val[0]); es += e4[k]; }
            const float ri = 1.f / es;
            *(int4*)(tok_e + tok * 4) = make_int4(idx[0], idx[1], idx[2], idx[3]);
            *(f32x4*)(tok_g + tok * 4) = (f32x4){e4[0] * ri, e4[1] * ri, e4[2] * ri, e4[3] * ri};
#pragma unroll
            for (int k = 0; k < 4; ++k) __hip_atomic_fetch_add(&hist[idx[k]], 1, __ATOMIC_RELAXED, __HIP_MEMORY_SCOPE_WORKGROUP);
        }
        if (tid < 64) tok_rstd[vcu * 64 + tid] = RSD[tid];
        __syncthreads();
        if (tid < 32) { HIST[vcu * 32 + tid] = hist[tid]; }
        __syncthreads();
        if (tid < 32) hist[tid] = 0;
    }
    SEAM(8);
    if (IN(9)) { const int lane = fresh_lane(), tid = wave * 64 + lane; (void)tid;
        LAS int* part = (LAS int*)(lds + RING_OFF);
        LAS int* base = part + 1024; LAS int* ea = base + 64; LAS int* dsts = ea + 256;
        int my_e = 0; float my_g = 0.f, my_rs = 0.f;
        if (tid < 256) { my_e = tok_e[vcu * 256 + tid]; my_g = tok_g[vcu * 256 + tid]; my_rs = tok_rstd[vcu * 64 + (tid >> 2)]; }
        { const int e = tid & 31, g = tid >> 5; int tot = 0, bef = 0;
#pragma unroll
            for (int w = 16 * g; w < 16 * g + 16; ++w) { const int h = HIST[w * 32 + e]; tot += h; bef += (w < vcu) ? h : 0; }
            part[g * 32 + e] = tot; part[512 + g * 32 + e] = bef; }
        if (tid < 256) ea[tid] = my_e;
        __syncthreads();
        if (tid < 32) { int tot = 0, bef = 0;
#pragma unroll
            for (int g = 0; g < 16; ++g) { tot += part[g * 32 + tid]; bef += part[512 + g * 32 + tid]; }
            const int nt = (tot + MOEB - 1) / MOEB; int inc = nt;
#pragma unroll
            for (int o = 1; o < 32; o <<= 1) { const int t = __shfl_up(inc, o); inc += (lane >= o) ? t : 0; }
            const int st = inc - nt;
            base[tid] = st * MOEB + bef;
            if (bx == 0) { for (int t = 0; t < nt; ++t) tile_e[st + t] = tid; if (tid == 31) *nrt_p = inc; } }
        __syncthreads();
        if (tid < 256) { const int e = my_e; int rank = 0; for (int a = 0; a < tid; ++a) rank += (ea[a] == e) ? 1 : 0;
            const int dest = base[e] + rank; dsts[tid] = dest; row_gate[dest] = my_g; row_rstd[dest] = my_rs; tok_dest[vcu * 256 + tid] = dest;
            if (MOE_FP8) row_tok[dest] = vcu * 64 + (tid >> 2); }
        if (!MOE_FP8) __syncthreads();
        if (!MOE_FP8)
        for (int tt = 0; tt < 8; ++tt) { const int ti = wave * 8 + tt, tok = vcu * 64 + ti;
            const u32x4* src = (const u32x4*)(HB + (size_t)tok * D); const u32x4 a = src[lane], b = src[lane + 64];
            if (MOE_FP8) { if (lane < 4) row_tok[dsts[ti * 4 + lane]] = tok; continue; }
            if (false) { u32x2 a8, b8;
                a8.x = pk4_fp8(bf2f(a.x & 0xffffu), bf2f(a.x >> 16), bf2f(a.y & 0xffffu), bf2f(a.y >> 16)); a8.y = pk4_fp8(bf2f(a.z & 0xffffu), bf2f(a.z >> 16), bf2f(a.w & 0xffffu), bf2f(a.w >> 16));
                b8.x = pk4_fp8(bf2f(b.x & 0xffffu), bf2f(b.x >> 16), bf2f(b.y & 0xffffu), bf2f(b.y >> 16)); b8.y = pk4_fp8(bf2f(b.z & 0xffffu), bf2f(b.z >> 16), bf2f(b.w & 0xffffu), bf2f(b.w >> 16));
#pragma unroll
                for (int k = 0; k < 4; ++k) { u32x2* dst = (u32x2*)((unsigned char*)XG + (size_t)dsts[ti * 4 + k] * D); dst[lane] = a8; dst[lane + 64] = b8; } }
            else {
#pragma unroll
                for (int k = 0; k < 4; ++k) { u32x4* dst = (u32x4*)(XG + (size_t)dsts[ti * 4 + k] * D); dst[lane] = a; dst[lane + 64] = b; } } }
    }
    SEAM(9);
    if (IN(10)) { const int lane = fresh_lane(), tid = wave * 64 + lane; (void)tid;
        constexpr size_t EB = MOE_FP8 ? 1 : 2;
        LAS int* tile_l = (LAS int*)(lds + TILEE_OFF);
        if (tid < NRT) tile_l[tid] = tile_e[tid];
        __syncthreads();
        pg8::SchedMoe S{MOE_FP8 ? (const char*)HB8 : (const char*)XG, (const char*)WT_GU, tile_l, *nrt_p, 8, (size_t)2048 * D * EB, (size_t)256 * D * EB, G, bx, MOE_FP8 ? row_tok : nullptr, 0};
        pg8::EpiMoe1 E{(void*)ACT, b_gu, row_rstd, ctl + CW_RDY};
        if constexpr (MOE_FP8) pg8::gemm8_phase<pg8::EpiMoe1, pg8::SchedMoe, true, HANDOFF == 1 ? 1 : 0, true>(lds + RING_OFF, S, E, tid, wave, ctl + CW_RDY); else pg8::gemm_phase<pg8::EpiMoe1, pg8::SchedMoe>(lds + RING_OFF, S, E, tid, wave);
    }
    if (IN(10) && IN(11)) { if constexpr (!MOE_FP8 || DBG_BAR10 || !HANDOFF) xcd_barrier(bar, wave == 0 && fresh_lane() == 0);
        else { if constexpr (HANDOFF == 2) {
                if (wave == 0) { const int ln = fresh_lane(); __builtin_amdgcn_fence(__ATOMIC_RELEASE, "agent");
                    const int pos = (bx & 7) * (G >> 3) + (bx >> 3), U = ln * G + pos;
                    if (U < *nrt_p * 8) (void)__hip_atomic_fetch_add(ctl + CW_RDY + 64 * (U >> 3), 1u, __ATOMIC_RELAXED, __HIP_MEMORY_SCOPE_AGENT); } }
            __builtin_amdgcn_fence(__ATOMIC_ACQUIRE, "agent"); __syncthreads(); } }
    if (IN(11)) { const int lane = fresh_lane(), tid = wave * 64 + lane; (void)tid;
        constexpr size_t EB = MOE_FP8 ? 1 : 2;
        const int nrt11 = *nrt_p;
        LAS int* tile_l = (LAS int*)(lds + TILEE_OFF);
        if (!IN(10)) { if (tid < NRT) tile_l[tid] = tile_e[tid]; __syncthreads(); }
        pg8::SchedMoe S{(const char*)ACT, (const char*)WT_DN, tile_l, nrt11, 4, (size_t)D * D * EB, (size_t)256 * D * EB, G, bx, nullptr, (MOE_FP8 && HANDOFF) ? (nrt11 * 8) % G : 0};
        pg8::EpiMoe2 E{(void*)YB, b_down, row_gate};
        if constexpr (MOE_FP8) pg8::gemm8_phase<pg8::EpiMoe2, pg8::SchedMoe, false, HANDOFF ? 2 : 0, true>(lds + RING_OFF, S, E, tid, wave, ctl + CW_RDY); else pg8::gemm_phase<pg8::EpiMoe2, pg8::SchedMoe>(lds + RING_OFF, S, E, tid, wave);
    }
    SEAM(11);
    if (IN(12)) { const int lane = fresh_lane(), tid = wave * 64 + lane; (void)tid;
        const int gw = vcu * NWAVES + wave, NGW = G * NWAVES;
        for (int m = gw; m < NTOK; m += NGW) {
            const u32x2* xr = (const u32x2*)(HB + (size_t)m * D) + lane;
            f32x4 v[4];
#pragma unroll
            for (int j = 0; j < 4; ++j) { const u32x2 xw = xr[64 * j]; v[j] = (f32x4){bf2f(xw.x & 0xffffu), bf2f(xw.x >> 16), bf2f(xw.y & 0xffffu), bf2f(xw.y >> 16)}; }
#pragma unroll
            for (int k = 0; k < 4; ++k) {
                if (MOE_FP8) { const unsigned* yr = (const unsigned*)((const unsigned char*)YB + (size_t)tok_dest[m * 4 + k] * D) + lane;
#pragma unroll
                    for (int j = 0; j < 4; ++j) { const unsigned y = yr[64 * j]; const f32x2_t lo = __builtin_amdgcn_cvt_pk_f32_fp8((int)y, false), hi = __builtin_amdgcn_cvt_pk_f32_fp8((int)y, true);
                        v[j].x += lo[0] * (1.f / Y8S); v[j].y += lo[1] * (1.f / Y8S); v[j].z += hi[0] * (1.f / Y8S); v[j].w += hi[1] * (1.f / Y8S); } }
                else { const u32x2* yr = (const u32x2*)(YB + (size_t)tok_dest[m * 4 + k] * D) + lane;
#pragma unroll
                    for (int j = 0; j < 4; ++j) { const u32x2 y = yr[64 * j]; v[j].x += bf2f(y.x & 0xffffu); v[j].y += bf2f(y.x >> 16); v[j].z += bf2f(y.y & 0xffffu); v[j].w += bf2f(y.y >> 16); } } }
            float s = 0.f;
#pragma unroll
            for (int j = 0; j < 4; ++j) s += (v[j].x * v[j].x + v[j].y * v[j].y) + (v[j].z * v[j].z + v[j].w * v[j].w);
            const float r = rsqrtf(wave_sum(s) * (1.f / D) + EPS);
            f32x4* o = (f32x4*)(args.out + (size_t)m * D) + lane;
#pragma unroll
            for (int j = 0; j < 4; ++j) { const f32x4 ww = ((const f32x4*)norm_final_w)[lane + 64 * j]; o[64 * j] = v[j] * r * ww; }
        }
    }
#undef IN
#undef SEAM
}

static void mega_launch(void* const* d_in, float* out, char* ws, int lo, int hi, int li, hipStream_t stream) {
    static bool attr = false;
    if (!attr) { if (hipFuncSetAttribute((const void*)mega_fwd, hipFuncAttributeMaxDynamicSharedMemorySize, LDS_BYTES) != hipSuccess) fprintf(stderr, "mega_launch: hipFuncSetAttribute failed\n"); attr = true; }
    Args a{};
    for (int i = 0; i < 23; ++i) a.in[i] = (const float*)d_in[i];
    a.out = out; a.ws = (unsigned char*)ws; a.ph_lo = lo; a.ph_hi = hi; a.li = li;
    hipLaunchKernelGGL(mega_fwd, dim3(256), dim3(NWAVES * 64), LDS_BYTES, stream, a);
    const hipError_t le = hipPeekAtLastError();
    if (le != hipSuccess) fprintf(stderr, "mega_launch: launch failed: %s\n", hipGetErrorName(le));
}
extern "C" void kernel_launch(void* const* d_in, const int* in_sizes, int n_in, void* d_out, int out_size, void* d_ws, size_t ws_size, hipStream_t stream) {
    if (n_in != 23 || ws_size < WS_END || out_size != NTOK * D) { fprintf(stderr, "kernel_launch: bad args n_in %d ws %zu out %d\n", n_in, ws_size, out_size); return; }
    (void)in_sizes;
    if (HANDOFF) (void)hipMemsetAsync((char*)d_ws + WS_CTL, 0, CTL_ZERO_BYTES, stream);
    else (void)hipMemsetAsync((char*)d_ws + WS_CTL + (size_t)CW_BAR * 4, 0, 16384, stream);
    mega_launch(d_in, (float*)d_out, (char*)d_ws, 0, 13, 0, stream);
}
```

```cpp
#define MEGA_MASK 0x1FFF
#include <hip/hip_runtime.h>
#include <cstdio>
#include <cstdint>

typedef unsigned short bf16;
constexpr int D = 1024, BATCH = 8, SEQ = 2048, NTOK = BATCH * SEQ, MEML = 256, NMEM = BATCH * MEML;
constexpr int INW = 3600;
constexpr int PBW = 3584;
constexpr int GW = 768;
constexpr int NIN = 3840;
constexpr int C_HQ = 0, C_HF = 512, C_HI = 1024, C_HGATE = 1536, C_GQ = 2048, C_GK = 2304, C_GV = 2560, C_GGATE = 3072, C_GLR = 3584;
constexpr int NEXP = 32, TOPK = 4, NASSIGN = NTOK * TOPK, MOEB = 256, NROWS = NASSIGN + NEXP * MOEB, NRT = NROWS / MOEB;
constexpr float EPS = 1e-6f;

constexpr size_t MiB = 1u << 20;
constexpr size_t WS_CTL = 0, CTL_ZERO_BYTES = 1 * MiB;
constexpr int CW_TMO = 0, CW_CODE = 1, CW_BAR = 32768, CW_COUNTS = 16384, CW_FILL = 16384 + 64, CW_RDY = 65536;
constexpr size_t WS_TAB = 1 * MiB;
constexpr size_t OFF_LB = 0, OFF_PSTART = 4096, OFF_TILEE = 8192, OFF_NRT = 12288, OFF_HIST = 16384;
constexpr size_t WS_TOKE = 2 * MiB, WS_TOKG = WS_TOKE + 256 * 1024, WS_TOKDEST = WS_TOKG + 256 * 1024, WS_ROWGATE = WS_TOKDEST + 256 * 1024;
constexpr size_t WS_TOKRSTD = 3 * MiB + 64 * 1024, WS_ROWRSTD = 3 * MiB + 128 * 1024, WS_SSQ = 726 * MiB;
constexpr size_t WS_WT_IN = 4 * MiB;
constexpr size_t WS_WT_OUT = 12 * MiB, WS_WT_XQ = 14 * MiB, WS_WT_XKV = 16 * MiB, WS_WT_XO = 20 * MiB;
constexpr size_t WS_WT_GU = 22 * MiB;
constexpr size_t WS_WT_DN = 150 * MiB;
constexpr size_t WS_PB = 214 * MiB;
constexpr size_t WS_G = 326 * MiB;
constexpr size_t WS_XG = 214 * MiB;
constexpr size_t WS_R2 = 374 * MiB;
constexpr size_t WS_HB = WS_R2, WS_Y = WS_R2 + 32 * MiB, WS_Q = WS_R2 + 64 * MiB, WS_AO = WS_R2 + 96 * MiB, WS_HMB = WS_R2 + 128 * MiB, WS_KB = WS_R2 + 132 * MiB, WS_VT = WS_R2 + 136 * MiB;
constexpr size_t WS_ACT = WS_PB + 80 * MiB;
constexpr size_t WS_X1 = 518 * MiB;
constexpr size_t WS_YB = 582 * MiB;
constexpr size_t WS_SCR = 726 * MiB;
constexpr size_t WS_END = 966 * MiB;

__device__ __forceinline__ unsigned f2bf(float f) { unsigned u = __builtin_bit_cast(unsigned, f); return (u + 0x7fffu + ((u >> 16) & 1u)) >> 16; }
__device__ __forceinline__ float bf2f(unsigned h) { return __builtin_bit_cast(float, h << 16); }
__device__ __forceinline__ unsigned pk2(float lo, float hi) { return f2bf(lo) | (f2bf(hi) << 16); }
__device__ __forceinline__ float wave_sum(float v) {
#pragma unroll
    for (int o = 1; o < 64; o <<= 1) v += __shfl_xor(v, o);
    return v;
}
__device__ __forceinline__ float sigmoidf_(float x) { return 1.f / (1.f + __expf(-x)); }
__device__ __forceinline__ float siluf_(float x) { return x * sigmoidf_(x); }
__device__ __forceinline__ float logsigmoidf_(float z) { return fminf(z, 0.f) - log1pf(__expf(-fabsf(z))); }
__device__ __forceinline__ int gu_rowmap(int n) { return n < 1024 ? (n >> 7) * 256 + (n & 127) : ((n - 1024) >> 7) * 256 + 128 + ((n - 1024) & 127); }
#define LAS __attribute__((address_space(3)))
#define GAS __attribute__((address_space(1)))
typedef short bf16x8 __attribute__((ext_vector_type(8)));
typedef float f32x4 __attribute__((ext_vector_type(4)));
typedef float f32x16 __attribute__((ext_vector_type(16)));
typedef unsigned u32x4 __attribute__((ext_vector_type(4)));
typedef unsigned u32x2 __attribute__((ext_vector_type(2)));
typedef short s16x4 __attribute__((ext_vector_type(4)));
typedef GAS unsigned gu32;
#define RLX_AGENT __ATOMIC_RELAXED, __HIP_MEMORY_SCOPE_AGENT
__device__ __forceinline__ int fresh_lane() { int l; asm volatile("v_mbcnt_lo_u32_b32 %0, -1, 0\n\tv_mbcnt_hi_u32_b32 %0, -1, %0" : "=v"(l)); return l; }
#define LDS_WAIT() asm volatile("s_waitcnt lgkmcnt(0)" ::: "memory")
#define VM_WAIT() asm volatile("s_waitcnt vmcnt(0)" ::: "memory")

#ifndef MOE_FP8
#define MOE_FP8 1
#endif
typedef int i32x8 __attribute__((ext_vector_type(8)));
typedef unsigned u32x8 __attribute__((ext_vector_type(8)));
constexpr float W8S = 64.f, A8S = 4.f, Y8S = 64.f;
__device__ __forceinline__ float clamp8(float x) { return __builtin_amdgcn_fmed3f(x, -448.f, 448.f); }
__device__ __forceinline__ unsigned pk4_fp8(float a, float b, float c, float d) { int w = __builtin_amdgcn_cvt_pk_fp8_f32(clamp8(a), clamp8(b), 0, false); w = __builtin_amdgcn_cvt_pk_fp8_f32(clamp8(c), clamp8(d), w, true); return (unsigned)w; }
namespace pg8 {
constexpr int BM = 256, BK = 64, HALF = 128, HTB = HALF * BK * 2, STAGE_BYTES = 8 * HTB, NXCD = 8, WGM = 8;
constexpr int KK = 1024;
__host__ __device__ __forceinline__ int lds_byte(int r, int c) { const int st = (r >> 4) * 2 + (c >> 5), rr = r & 15, cc = c & 31, ob = rr * 64 + cc * 2; return st * 1024 + (ob ^ (((ob >> 9) & 1) << 5)); }
__host__ __device__ __forceinline__ void stage_rc(int b, int& R, int& C) { const int st = b / 1024, sb = b % 1024, swz = sb ^ (((sb >> 9) & 1) << 5); R = (st >> 1) * 16 + swz / 64; C = (st & 1) * 32 + (swz % 64) / 2; }
__host__ __device__ __forceinline__ int perm32(int rho) { const int n = rho >> 4, i = rho & 15; return 8 * (i >> 2) + 4 * n + (i & 3); }
constexpr size_t TSTEP = (size_t)BM * KK * 2;

struct Unit { const char* A; const char* B; int pm, pn, aux; };

__device__ __forceinline__ void static_tile(int L, int nM, int nN, int& pm, int& pn) {
    const int nwg = nM * nN; int wgid = L; { const int q = nwg / NXCD, r = nwg % NXCD, xcd = wgid % NXCD, off = wgid / NXCD; wgid = (xcd < r ? xcd * (q + 1) : r * (q + 1) + (xcd - r) * q) + off; }
    const int nig = WGM * nN, gid = wgid / nig, fm = gid * WGM, gsz = (nM - fm) < WGM ? (nM - fm) : WGM;
    pm = fm + ((wgid % nig) % gsz); pn = (wgid % nig) / gsz;
}
struct SchedDense {
    const char* A; const char* B; int nM, nN, G, c;
    __device__ __forceinline__ bool next(int i, Unit& u) const { const int L = i * G + c; if (L >= nM * nN) return false; static_tile(L, nM, nN, u.pm, u.pn); u.A = A + (size_t)u.pm * TSTEP; u.B = B + (size_t)u.pn * TSTEP; u.aux = 0; return true; }
};
struct SchedP1 {
    const char* HB; const char* WT_IN; const char* HMB; const char* WT_XKV; int G, c;
    __device__ __forceinline__ bool next(int i, Unit& u) const {
        const int L = i * G + c;
        if (L < 960) { static_tile(L, 64, 15, u.pm, u.pn); u.A = HB + (size_t)u.pm * TSTEP; u.B = WT_IN + (size_t)u.pn * TSTEP; u.aux = 0; return true; }
        if (L < 992) { const int j = L - 960; u.pm = j >> 2; u.pn = j & 3; u.A = HMB + (size_t)u.pm * TSTEP; u.B = WT_XKV + (size_t)u.pn * TSTEP; u.aux = 1; return true; }
        if (L < 1024) { const int j = L - 992; u.pm = j >> 3; u.pn = j & 7; u.A = WT_XKV + (size_t)(4 + u.pm) * TSTEP; u.B = HMB + (size_t)u.pn * TSTEP; u.aux = 2; return true; }
        return false;
    }
};
struct SchedMoe {
    const char* A; const char* W; const LAS int* tile_e; int nrt, nct; size_t wstride, tstep; int G, c; const int* rtok; int shift;
    __device__ __forceinline__ bool next(int i, Unit& u) const {
        const int per = G >> 3, pos = (c & 7) * per + (c >> 3), E = i * G + ((pos - shift + G) % G);
        if (E >= nrt * nct) return false;
        int rt, ct;
        if (shift) { const int q = nrt & 31, nfb = nrt >> 5, ne = nfb * (32 - q) * nct;
            if (E < ne) { const int kt = E / nct; ct = E - kt * nct; const int blk = kt / (32 - q); rt = 32 * blk + q + (kt - blk * (32 - q)); }
            else { const int E2 = E - ne, kt = E2 / nct; ct = E2 - kt * nct; const int blk = kt / q; rt = 32 * blk + (kt - blk * q); } }
        else { rt = E / nct; ct = E - rt * nct; }
        const int e = tile_e[rt];
        u.pm = rt; u.pn = ct; u.aux = e; u.A = rtok ? A : A + (size_t)rt * tstep; u.B = W + (size_t)e * wstride + (size_t)ct * tstep; return true;
    }
};

__device__ __forceinline__ unsigned cvt_pk_bf16(float lo, float hi) { unsigned r; asm volatile("v_cvt_pk_bf16_f32 %0, %1, %2" : "=v"(r) : "v"(lo), "v"(hi)); return r; }
__device__ __forceinline__ float fast_sigmoid(float x) { return __builtin_amdgcn_rcpf(1.f + __expf(-x)); }
__device__ __forceinline__ f32x4 silu4(f32x4 v) { f32x4 o; o[0] = v[0] * fast_sigmoid(v[0]); o[1] = v[1] * fast_sigmoid(v[1]); o[2] = v[2] * fast_sigmoid(v[2]); o[3] = v[3] * fast_sigmoid(v[3]); return o; }
typedef _Float16 h16x2 __attribute__((ext_vector_type(2)));
__device__ __forceinline__ unsigned pkh2(float a, float b) { const h16x2 h = {(_Float16)a, (_Float16)b}; return __builtin_bit_cast(unsigned, h); }
__device__ __forceinline__ u32x4 pack8h(f32x4 a, f32x4 b) { u32x4 w; w.x = pkh2(a[0], a[1]); w.y = pkh2(a[2], a[3]); w.z = pkh2(b[0], b[1]); w.w = pkh2(b[2], b[3]); return w; }
__device__ __forceinline__ u32x4 pack8(f32x4 a, f32x4 b) { u32x4 w; w.x = cvt_pk_bf16(a[0], a[1]); w.y = cvt_pk_bf16(a[2], a[3]); w.z = cvt_pk_bf16(b[0], b[1]); w.w = cvt_pk_bf16(b[2], b[3]); return w; }

#define EPI_ROWS(...) _Pragma("unroll") for (int ai = 0; ai < 2; ++ai) _Pragma("unroll") for (int m = 0; m < 4; ++m) { const int row = row0 + ai * HALF + m * 16; _Pragma("unroll") for (int bj = 0; bj < 2; ++bj) { const f32x4 v0 = acc[ai][bj][m][0], v1 = acc[ai][bj][m][1]; __VA_ARGS__ } }

__device__ __forceinline__ void st16_wt(void* p, u32x4 v) { asm volatile("global_store_dwordx4 %0, %1, off sc1\n\ts_nop 1" :: "v"(p), "v"(v) : "memory"); }
#ifndef WT_STORES
#define WT_STORES 1
#endif
template <int W> __device__ __forceinline__ void st16(void* p, u32x4 v) { if (W) st16_wt(p, v); else *(u32x4*)p = v; }
#ifndef WT3
#define WT3 0
#endif
#ifndef WT7
#define WT7 0
#endif
#ifndef WT11
#define WT11 0
#endif
struct EpiP1 {
    bf16* PB; _Float16* G; bf16* KB; bf16* VT; const float* LB; const float* b_gk;
    template <int TY> __device__ __forceinline__ void tile(const f32x4 (&acc)[2][2][4][2], const Unit& u, int row0, int cl) const {
        f32x4 p0[2], p1[2];
#pragma unroll
        for (int bj = 0; bj < 2; ++bj) { const int c = u.pn * 256 + bj * HALF + cl;
            if (TY == 3) { p0[bj] = *(const f32x4*)(LB + (c - C_HF)); p1[bj] = *(const f32x4*)(LB + (c - C_HF) + 4); }
            else if (TY == 4) { p0[bj] = *(const f32x4*)(b_gk + (c - C_GLR)); p1[bj] = *(const f32x4*)(b_gk + (c - C_GLR) + 4); }
            else { p0[bj] = (f32x4){0.f, 0.f, 0.f, 0.f}; p1[bj] = p0[bj]; } }
        EPI_ROWS({
            const int c = u.pn * 256 + bj * HALF + cl;
            if (TY == 0) *(u32x4*)(PB + (size_t)row * PBW + c) = pack8(v0, v1);
            else if (TY == 1) *(u32x4*)(PB + (size_t)row * PBW + c) = pack8(silu4(v0), silu4(v1));
            else if (TY == 2) *(u32x4*)(PB + (size_t)row * PBW + c) = pack8(v0 * 0.125f, v1 * 0.125f);
            else if (TY == 3) { f32x4 f0, f1, k0, k1, g0, g1;
_Pragma("unroll")
                for (int j = 0; j < 4; ++j) { f0[j] = p0[bj][j] + (1.f - p0[bj][j]) * fast_sigmoid(v0[j]); f1[j] = p1[bj][j] + (1.f - p1[bj][j]) * fast_sigmoid(v1[j]);
                    k0[j] = 1.f - f0[j]; k1[j] = 1.f - f1[j]; g0[j] = __logf(f0[j]); g1[j] = __logf(f1[j]); }
                *(u32x4*)(PB + (size_t)row * PBW + c) = pack8(k0, k1);
                *(u32x4*)(G + (size_t)row * GW + (c - C_HF)) = pack8h(g0, g1); }
            else { f32x4 g0, g1;
_Pragma("unroll")
                for (int j = 0; j < 4; ++j) { const float z0 = v0[j] + p0[bj][j], z1 = v1[j] + p1[bj][j];
                    g0[j] = (fminf(z0, 0.f) - __logf(1.f + __expf(-fabsf(z0)))) * 0.0625f; g1[j] = (fminf(z1, 0.f) - __logf(1.f + __expf(-fabsf(z1)))) * 0.0625f; }
                *(u32x4*)(G + (size_t)row * GW + 512 + (c - C_GLR)) = pack8h(g0, g1); }
        })
    }
    __device__ __forceinline__ void operator()(const f32x4 (&acc)[2][2][4][2], const Unit& u, int wr, int wc, int fr, int fq) const {
        const int row0 = u.pm * BM + wr * 64 + fr, cl = wc * 32 + 8 * fq;
        if (u.aux == 0) {
            const int pn = u.pn;
            if (pn == 2 || pn == 3) tile<3>(acc, u, row0, cl);
            else if (pn == 14) tile<4>(acc, u, row0, cl);
            else if (pn == 8) tile<2>(acc, u, row0, cl);
            else if (pn < 2 || pn == 6 || pn == 7 || pn == 12 || pn == 13) tile<1>(acc, u, row0, cl);
            else tile<0>(acc, u, row0, cl);
        } else if (u.aux == 1) {
            EPI_ROWS({ *(u32x4*)(KB + (size_t)row * D + u.pn * 256 + bj * HALF + cl) = pack8(v0, v1); })
        } else {
            EPI_ROWS({ *(u32x4*)(VT + (size_t)row * NMEM + u.pn * 256 + bj * HALF + cl) = pack8(v0, v1); })
        }
    }
};
struct EpiRes1 {
    const float* R; bf16* XB; float* SSQ;
    __device__ __forceinline__ void operator()(const f32x4 (&acc)[2][2][4][2], const Unit& u, int wr, int wc, int fr, int fq) const {
        const int row0 = u.pm * BM + wr * 64 + fr, cl = wc * 32 + 8 * fq;
#pragma unroll
        for (int ai = 0; ai < 2; ++ai)
#pragma unroll
            for (int m = 0; m < 4; ++m) { const int row = row0 + ai * HALF + m * 16; const size_t off = (size_t)row * D + u.pn * 256 + cl;
                f32x4 r[2][2]; float ss = 0.f;
#pragma unroll
                for (int bj = 0; bj < 2; ++bj) { r[bj][0] = *(const f32x4*)(R + off + bj * HALF); r[bj][1] = *(const f32x4*)(R + off + bj * HALF + 4); }
#pragma unroll
                for (int bj = 0; bj < 2; ++bj) { const f32x4 c0 = r[bj][0] + acc[ai][bj][m][0], c1 = r[bj][1] + acc[ai][bj][m][1];
                    st16<WT3>(XB + off + bj * HALF, pack8(c0, c1));
                    ss += ((c0[0] * c0[0] + c0[1] * c0[1]) + (c0[2] * c0[2] + c0[3] * c0[3])) + ((c1[0] * c1[0] + c1[1] * c1[1]) + (c1[2] * c1[2] + c1[3] * c1[3])); }
                ss += __shfl_xor(ss, 16); ss += __shfl_xor(ss, 32);
                if (fq == 0) SSQ[(size_t)row * 16 + u.pn * 4 + wc] = ss;
                if (m & 1) asm volatile("" ::: "memory"); }
    }
};
struct EpiRes2 {
    bf16* XB; unsigned char* X8;
    __device__ __forceinline__ void operator()(const f32x4 (&acc)[2][2][4][2], const Unit& u, int wr, int wc, int fr, int fq) const {
        const int row0 = u.pm * BM + wr * 64 + fr, cl = wc * 32 + 8 * fq;
#pragma unroll
        for (int ai = 0; ai < 2; ++ai)
#pragma unroll
            for (int mp = 0; mp < 4; mp += 2) {
                u32x4 r[2][2]; u32x2 w8[2][2];
#pragma unroll
                for (int q = 0; q < 2; ++q)
#pragma unroll
                    for (int bj = 0; bj < 2; ++bj) r[q][bj] = *(const u32x4*)(XB + (size_t)(row0 + ai * HALF + (mp + q) * 16) * D + u.pn * 256 + cl + bj * HALF);
#pragma unroll
                for (int q = 0; q < 2; ++q) { const int m = mp + q; const size_t off = (size_t)(row0 + ai * HALF + m * 16) * D + u.pn * 256 + cl;
#pragma unroll
                    for (int bj = 0; bj < 2; ++bj) { const f32x4 c0 = (f32x4){bf2f(r[q][bj].x & 0xffffu), bf2f(r[q][bj].x >> 16), bf2f(r[q][bj].y & 0xffffu), bf2f(r[q][bj].y >> 16)} + acc[ai][bj][m][0],
                                                                  c1 = (f32x4){bf2f(r[q][bj].z & 0xffffu), bf2f(r[q][bj].z >> 16), bf2f(r[q][bj].w & 0xffffu), bf2f(r[q][bj].w >> 16)} + acc[ai][bj][m][1];
                        st16<WT7>(XB + off + bj * HALF, pack8(c0, c1));
                        w8[q][bj].x = pk4_fp8(c0[0], c0[1], c0[2], c0[3]); w8[q][bj].y = pk4_fp8(c1[0], c1[1], c1[2], c1[3]); } }
                if (X8) {
#pragma unroll
                    for (int bj = 0; bj < 2; ++bj) { const u32x2 rx = __builtin_amdgcn_permlane16_swap(w8[0][bj].x, w8[1][bj].x, false, false), ry = __builtin_amdgcn_permlane16_swap(w8[0][bj].y, w8[1][bj].y, false, false);
                        st16<WT7>(X8 + (size_t)(row0 + ai * HALF + (mp + (fq & 1)) * 16) * D + u.pn * 256 + bj * HALF + cl - 8 * (fq & 1), (u32x4){rx.x, ry.x, rx.y, ry.y}); } }
                asm volatile("" ::: "memory"); }
    }
};
__device__ __forceinline__ float row_rstd16(const float* SSQ, int row, int fq) {
    const f32x4 p = *(const f32x4*)(SSQ + (size_t)row * 16 + 4 * fq); float t = (p[0] + p[1]) + (p[2] + p[3]); t += __shfl_xor(t, 16); t += __shfl_xor(t, 32);
    return rsqrtf(t * (1.f / D) + EPS);
}
struct EpiBf16S {
    bf16* O; float scale; const float* SSQ;
    __device__ __forceinline__ void operator()(const f32x4 (&acc)[2][2][4][2], const Unit& u, int wr, int wc, int fr, int fq) const {
        const int row0 = u.pm * BM + wr * 64 + fr, cl = wc * 32 + 8 * fq;
        float scv[2][4];
#pragma unroll
        for (int ai = 0; ai < 2; ++ai)
#pragma unroll
            for (int m = 0; m < 4; ++m) scv[ai][m] = row_rstd16(SSQ, row0 + ai * HALF + m * 16, fq) * scale;
#pragma unroll
        for (int ai = 0; ai < 2; ++ai)
#pragma unroll
            for (int m = 0; m < 4; ++m) { const int row = row0 + ai * HALF + m * 16; const float sc = scv[ai][m];
#pragma unroll
                for (int bj = 0; bj < 2; ++bj) *(u32x4*)(O + (size_t)row * D + u.pn * 256 + bj * HALF + cl) = pack8(acc[ai][bj][m][0] * sc, acc[ai][bj][m][1] * sc); }
    }
};
typedef float f32x2 __attribute__((ext_vector_type(2)));
struct EpiMoe1 {
    void* ACT; const float* bgu; const float* row_rstd; unsigned* rdy;
    static __device__ __forceinline__ f32x2 act2(f32x2 ag, f32x2 au, f32x2 rs, f32x2 bg, f32x2 bu) {
        constexpr float OS = MOE_FP8 ? A8S : 1.f, C2 = -1.702f * 1.4426950408889634f;
        f32x2 g = ag * rs + bg, u = au * rs + bu;
        g.x = fminf(g.x, 7.f); g.y = fminf(g.y, 7.f); u.x = __builtin_amdgcn_fmed3f(u.x, -7.f, 7.f); u.y = __builtin_amdgcn_fmed3f(u.y, -7.f, 7.f);
        const f32x2 t = g * C2; f32x2 e; e.x = __builtin_amdgcn_exp2f(t.x); e.y = __builtin_amdgcn_exp2f(t.y);
        const f32x2 d = e + 1.f; f32x2 r; r.x = __builtin_amdgcn_rcpf(d.x); r.y = __builtin_amdgcn_rcpf(d.y);
        return (u * OS + OS) * (g * r);
    }
    __device__ __forceinline__ void operator()(const f32x4 (&acc)[2][2][4][2], const Unit& u, int wr, int wc, int fr, int fq) const { run<false>(acc, u, wr, wc, fr, fq, -1); }
    __device__ __forceinline__ const float* pre(const Unit& u, int idx) const { return idx < 256 ? bgu + (size_t)u.aux * 2048 + (idx >> 7) * 1024 + u.pn * HALF + (idx & 127) : row_rstd + u.pm * BM + (idx - 256); }
    __device__ __forceinline__ void run_pre0(const f32x4 (&acc)[2][2][4][2], const Unit& u, int wr, int wc, int fr, int fq, const LAS float* eb) const { run_pre<false>(acc, u, wr, wc, fr, fq, -1, eb); }
    template <bool PUB>
    __device__ __forceinline__ void run_pre(const f32x4 (&acc)[2][2][4][2], const Unit& u, int wr, int wc, int fr, int fq, int prev_pm, const LAS float* eb) const {
        int upm = __builtin_amdgcn_readfirstlane(u.pm), upn = __builtin_amdgcn_readfirstlane(u.pn); asm volatile("" : "+s"(upm), "+s"(upn));
        const int rl = wr * 64 + fr, row0 = upm * BM + rl, cl = wc * 32 + 8 * fq, c = upn * HALF + cl;
        const f32x4 bg0 = *(const LAS f32x4*)(eb + cl), bg1 = *(const LAS f32x4*)(eb + cl + 4), bu0 = *(const LAS f32x4*)(eb + 128 + cl), bu1 = *(const LAS f32x4*)(eb + 128 + cl + 4);
        float rsv[2][4];
#pragma unroll
        for (int ai = 0; ai < 2; ++ai)
#pragma unroll
            for (int m = 0; m < 4; ++m) rsv[ai][m] = eb[256 + rl + ai * HALF + m * 16] * (1.f / W8S);
        u32x4 o[2][2];
#pragma unroll
        for (int ai = 0; ai < 2; ++ai)
#pragma unroll
            for (int mp = 0; mp < 4; mp += 2) { u32x2 wq[2];
#pragma unroll
                for (int q = 0; q < 2; ++q) { const int m = mp + q; const f32x2 rs = {rsv[ai][m], rsv[ai][m]};
                    const f32x4 g0 = acc[ai][0][m][0], g1 = acc[ai][0][m][1], u0 = acc[ai][1][m][0], u1 = acc[ai][1][m][1];
                    const f32x2 a = act2((f32x2){g0[0], g0[1]}, (f32x2){u0[0], u0[1]}, rs, (f32x2){bg0[0], bg0[1]}, (f32x2){bu0[0], bu0[1]}), b2 = act2((f32x2){g0[2], g0[3]}, (f32x2){u0[2], u0[3]}, rs, (f32x2){bg0[2], bg0[3]}, (f32x2){bu0[2], bu0[3]});
                    const f32x2 c2 = act2((f32x2){g1[0], g1[1]}, (f32x2){u1[0], u1[1]}, rs, (f32x2){bg1[0], bg1[1]}, (f32x2){bu1[0], bu1[1]}), d2 = act2((f32x2){g1[2], g1[3]}, (f32x2){u1[2], u1[3]}, rs, (f32x2){bg1[2], bg1[3]}, (f32x2){bu1[2], bu1[3]});
                    int w0 = __builtin_amdgcn_cvt_pk_fp8_f32(a.x, a.y, 0, false); w0 = __builtin_amdgcn_cvt_pk_fp8_f32(b2.x, b2.y, w0, true);
                    int w1 = __builtin_amdgcn_cvt_pk_fp8_f32(c2.x, c2.y, 0, false); w1 = __builtin_amdgcn_cvt_pk_fp8_f32(d2.x, d2.y, w1, true); wq[q].x = (unsigned)w0; wq[q].y = (unsigned)w1; }
                const u32x2 rx = __builtin_amdgcn_permlane16_swap(wq[0].x, wq[1].x, false, false), ry = __builtin_amdgcn_permlane16_swap(wq[0].y, wq[1].y, false, false);
                o[ai][mp >> 1] = (u32x4){rx.x, ry.x, rx.y, ry.y}; }
        if constexpr (PUB) {
            asm volatile("s_waitcnt vmcnt(0)" : "+v"(o[0][0]), "+v"(o[0][1]), "+v"(o[1][0]), "+v"(o[1][1]) :: "memory");
            if (prev_pm >= 0 && fr == 0 && fq == 0) (void)__hip_atomic_fetch_add(rdy + 64 * prev_pm, 1u, __ATOMIC_RELAXED, __HIP_MEMORY_SCOPE_AGENT);
        }
#pragma unroll
        for (int ai = 0; ai < 2; ++ai)
#pragma unroll
            for (int h = 0; h < 2; ++h) { unsigned char* dst = (unsigned char*)ACT + (size_t)(row0 + ai * HALF + (2 * h + (fq & 1)) * 16) * D + (c - 8 * (fq & 1));
                if constexpr (PUB) asm volatile("global_store_dwordx4 %0, %1, off sc1\n\ts_nop 1" :: "v"(dst), "v"(o[ai][h]) : "memory");
                else *(u32x4*)dst = o[ai][h]; }
    }
    template <bool PUB>
    __device__ __forceinline__ void run(const f32x4 (&acc)[2][2][4][2], const Unit& u, int wr, int wc, int fr, int fq, int prev_pm) const {
        int upm = __builtin_amdgcn_readfirstlane(u.pm), upn = __builtin_amdgcn_readfirstlane(u.pn), uaux = __builtin_amdgcn_readfirstlane(u.aux); asm volatile("" : "+s"(upm), "+s"(upn), "+s"(uaux));
        const int row0 = upm * BM + wr * 64 + fr, cl = wc * 32 + 8 * fq, c = upn * HALF + cl;
        const float* bb = bgu + (size_t)uaux * 2048 + c;
        const f32x4 bg0 = *(const f32x4*)bb, bg1 = *(const f32x4*)(bb + 4), bu0 = *(const f32x4*)(bb + 1024), bu1 = *(const f32x4*)(bb + 1028);
        float rsv[2][4];
#pragma unroll
        for (int ai = 0; ai < 2; ++ai)
#pragma unroll
            for (int m = 0; m < 4; ++m) rsv[ai][m] = row_rstd[row0 + ai * HALF + m * 16] * (MOE_FP8 ? 1.f / W8S : 1.f);
        if constexpr (PUB) {
            asm volatile("s_waitcnt vmcnt(0)" :: "v"(bg0), "v"(bg1), "v"(bu0), "v"(bu1), "v"(rsv[0][0]), "v"(rsv[0][1]), "v"(rsv[0][2]), "v"(rsv[0][3]), "v"(rsv[1][0]), "v"(rsv[1][1]), "v"(rsv[1][2]), "v"(rsv[1][3]) : "memory");
            if (prev_pm >= 0 && fr == 0 && fq == 0) (void)__hip_atomic_fetch_add(rdy + 64 * prev_pm, 1u, __ATOMIC_RELAXED, __HIP_MEMORY_SCOPE_AGENT);
        }
#pragma unroll
        for (int ai = 0; ai < 2; ++ai)
#pragma unroll
            for (int mp = 0; mp < 4; mp += 2) { u32x2 wq[2];
#pragma unroll
                for (int q = 0; q < 2; ++q) { const int m = mp + q; const f32x2 rs = {rsv[ai][m], rsv[ai][m]};
                    const f32x4 g0 = acc[ai][0][m][0], g1 = acc[ai][0][m][1], u0 = acc[ai][1][m][0], u1 = acc[ai][1][m][1];
                    const f32x2 a = act2((f32x2){g0[0], g0[1]}, (f32x2){u0[0], u0[1]}, rs, (f32x2){bg0[0], bg0[1]}, (f32x2){bu0[0], bu0[1]}), b2 = act2((f32x2){g0[2], g0[3]}, (f32x2){u0[2], u0[3]}, rs, (f32x2){bg0[2], bg0[3]}, (f32x2){bu0[2], bu0[3]});
                    const f32x2 c2 = act2((f32x2){g1[0], g1[1]}, (f32x2){u1[0], u1[1]}, rs, (f32x2){bg1[0], bg1[1]}, (f32x2){bu1[0], bu1[1]}), d2 = act2((f32x2){g1[2], g1[3]}, (f32x2){u1[2], u1[3]}, rs, (f32x2){bg1[2], bg1[3]}, (f32x2){bu1[2], bu1[3]});
                    if (MOE_FP8) { int w0 = __builtin_amdgcn_cvt_pk_fp8_f32(a.x, a.y, 0, false); w0 = __builtin_amdgcn_cvt_pk_fp8_f32(b2.x, b2.y, w0, true);
                        int w1 = __builtin_amdgcn_cvt_pk_fp8_f32(c2.x, c2.y, 0, false); w1 = __builtin_amdgcn_cvt_pk_fp8_f32(d2.x, d2.y, w1, true); wq[q].x = (unsigned)w0; wq[q].y = (unsigned)w1;
                        if constexpr (!PUB) *(u32x2*)((unsigned char*)ACT + (size_t)(row0 + ai * HALF + m * 16) * D + c) = wq[q]; }
                    else *(u32x4*)((bf16*)ACT + (size_t)(row0 + ai * HALF + m * 16) * D + c) = pack8((f32x4){a.x, a.y, b2.x, b2.y}, (f32x4){c2.x, c2.y, d2.x, d2.y}); }
                if constexpr (PUB && MOE_FP8) {
                    const u32x2 rx = __builtin_amdgcn_permlane16_swap(wq[0].x, wq[1].x, false, false), ry = __builtin_amdgcn_permlane16_swap(wq[0].y, wq[1].y, false, false);
                    const u32x4 o = {rx.x, ry.x, rx.y, ry.y};
                    unsigned char* dst = (unsigned char*)ACT + (size_t)(row0 + ai * HALF + (mp + (fq & 1)) * 16) * D + (c - 8 * (fq & 1));
                    asm volatile("global_store_dwordx4 %0, %1, off sc1\n\ts_nop 1" :: "v"(dst), "v"(o) : "memory"); } }
    }
};
struct EpiMoe2 {
    void* YB; const float* bd; const float* row_gate;
    __device__ __forceinline__ const float* pre(const Unit& u, int idx) const { return idx < 256 ? bd + (size_t)u.aux * D + u.pn * 256 + idx : row_gate + u.pm * BM + (idx - 256); }
    __device__ __forceinline__ void run_pre0(const f32x4 (&acc)[2][2][4][2], const Unit& u, int wr, int wc, int fr, int fq, const LAS float* eb) const {
        int upm = __builtin_amdgcn_readfirstlane(u.pm), upn = __builtin_amdgcn_readfirstlane(u.pn); asm volatile("" : "+s"(upm), "+s"(upn));
        const int rl = wr * 64 + fr, row0 = upm * BM + rl, cl = wc * 32 + 8 * fq;
        constexpr float ASC = 1.f / (W8S * A8S);
        f32x4 b0[2], b1[2];
#pragma unroll
        for (int bj = 0; bj < 2; ++bj) { b0[bj] = *(const LAS f32x4*)(eb + bj * HALF + cl); b1[bj] = *(const LAS f32x4*)(eb + bj * HALF + cl + 4); }
        float gv[2][4];
#pragma unroll
        for (int ai = 0; ai < 2; ++ai)
#pragma unroll
            for (int m = 0; m < 4; ++m) gv[ai][m] = eb[256 + rl + ai * HALF + m * 16] * Y8S;
#pragma unroll
        for (int ai = 0; ai < 2; ++ai)
#pragma unroll
            for (int mp = 0; mp < 4; mp += 2)
#pragma unroll
                for (int bj = 0; bj < 2; ++bj) { u32x2 wq[2];
#pragma unroll
                    for (int q = 0; q < 2; ++q) { const int m = mp + q; const float g = gv[ai][m];
                        const f32x4 y0 = (acc[ai][bj][m][0] * ASC + b0[bj]) * g, y1 = (acc[ai][bj][m][1] * ASC + b1[bj]) * g;
                        wq[q].x = pk4_fp8(y0[0], y0[1], y0[2], y0[3]); wq[q].y = pk4_fp8(y1[0], y1[1], y1[2], y1[3]); }
                    const u32x2 rx = __builtin_amdgcn_permlane16_swap(wq[0].x, wq[1].x, false, false), ry = __builtin_amdgcn_permlane16_swap(wq[0].y, wq[1].y, false, false);
                    st16<WT11>((unsigned char*)YB + (size_t)(row0 + ai * HALF + (mp + (fq & 1)) * 16) * D + upn * 256 + bj * HALF + cl - 8 * (fq & 1), (u32x4){rx.x, ry.x, rx.y, ry.y}); }
    }
    __device__ __forceinline__ void operator()(const f32x4 (&acc)[2][2][4][2], const Unit& u, int wr, int wc, int fr, int fq) const {
        int upm = __builtin_amdgcn_readfirstlane(u.pm), upn = __builtin_amdgcn_readfirstlane(u.pn), uaux = __builtin_amdgcn_readfirstlane(u.aux); asm volatile("" : "+s"(upm), "+s"(upn), "+s"(uaux));
        const int row0 = upm * BM + wr * 64 + fr, cl = wc * 32 + 8 * fq;
        constexpr float ASC = MOE_FP8 ? 1.f / (W8S * A8S) : 1.f;
        f32x4 b0[2], b1[2];
#pragma unroll
        for (int bj = 0; bj < 2; ++bj) { const float* bb = bd + (size_t)uaux * D + upn * 256 + bj * HALF + cl; b0[bj] = *(const f32x4*)bb; b1[bj] = *(const f32x4*)(bb + 4); }
        float gv[2][4];
#pragma unroll
        for (int ai = 0; ai < 2; ++ai)
#pragma unroll
            for (int m = 0; m < 4; ++m) gv[ai][m] = row_gate[row0 + ai * HALF + m * 16] * (MOE_FP8 ? Y8S : 1.f);
#pragma unroll
        for (int ai = 0; ai < 2; ++ai)
#pragma unroll
            for (int m = 0; m < 4; ++m) { const int row = row0 + ai * HALF + m * 16; const float g = gv[ai][m];
#pragma unroll
                for (int bj = 0; bj < 2; ++bj) { const f32x4 y0 = (acc[ai][bj][m][0] * ASC + b0[bj]) * g, y1 = (acc[ai][bj][m][1] * ASC + b1[bj]) * g;
                    if (MOE_FP8) { u32x2 w; w.x = pk4_fp8(y0[0], y0[1], y0[2], y0[3]); w.y = pk4_fp8(y1[0], y1[1], y1[2], y1[3]); *(u32x2*)((unsigned char*)YB + (size_t)row * D + upn * 256 + bj * HALF + cl) = w; }
                    else *(u32x4*)((bf16*)YB + (size_t)row * D + upn * 256 + bj * HALF + cl) = pack8(y0, y1); } }
    }
};


template <class Epi, class Sched>
__device__ __forceinline__ void gemm_phase(LAS unsigned char* lds, const Sched& S, const Epi& E, const int tid, const int wid) {
    const int wr = wid >> 2, wc = wid & 3, lane = tid & 63, fr = lane & 15, fq = lane >> 4;
    constexpr int K = KK, nt = K / BK;
    unsigned voffA[2], voffB[2];
#pragma unroll
    for (int i = 0; i < 2; ++i) { int R, C; stage_rc(tid * 16 + i * 8192, R, C); const int Rb = (R & ~31) + perm32(R & 31);
        voffA[i] = (unsigned)(R * K + C) * 2u; voffB[i] = (unsigned)(Rb * K + C) * 2u; }
    constexpr size_t kstep = (size_t)(BK * 2), hstep = (size_t)HALF * K * 2;
    const unsigned ldsw = (unsigned)wid * 1024u;
    const int aoff = lds_byte(wr * 64 + fr, fq * 8), boff = lds_byte(wc * 32 + fr, fq * 8);
#define PG8_SA(b, h) (((b) * 2 + (h)) * HTB)
#define PG8_SB(b, h) ((4 + (b) * 2 + (h)) * HTB)
#define PG8_STAGE(bufoff, gbase, voff) do { _Pragma("unroll") for (int _i = 0; _i < 2; ++_i) \
        __builtin_amdgcn_global_load_lds((const unsigned*)((const char*)(gbase) + (voff)[_i]), (LAS unsigned*)(lds + (bufoff) + ldsw + _i * 8192), 16, 0, 0); } while (0)
#define PG8_LDA(dst, b, h) do { _Pragma("unroll") for (int m = 0; m < 4; ++m) _Pragma("unroll") for (int k = 0; k < 2; ++k) dst[m][k] = *(const LAS bf16x8*)(lds + PG8_SA(b, h) + aoff + m * 2048 + k * 1024); } while (0)
#define PG8_LDB(dst, b, h) do { _Pragma("unroll") for (int n = 0; n < 2; ++n) _Pragma("unroll") for (int k = 0; k < 2; ++k) dst[n][k] = *(const LAS bf16x8*)(lds + PG8_SB(b, h) + boff + n * 2048 + k * 1024); } while (0)
#define PG8_MMA(ai, bj, At, Bt) do { __builtin_amdgcn_s_setprio(1); _Pragma("unroll") for (int m = 0; m < 4; ++m) _Pragma("unroll") for (int n = 0; n < 2; ++n) _Pragma("unroll") for (int k = 0; k < 2; ++k) \
        acc[ai][bj][m][n] = __builtin_amdgcn_mfma_f32_16x16x32_bf16(Bt[n][k], At[m][k], acc[ai][bj][m][n], 0, 0, 0); __builtin_amdgcn_s_setprio(0); } while (0)
#define PG8_WAIT_V(n) asm volatile("s_waitcnt vmcnt(" #n ")" ::: "memory")
#define PG8_WAIT_L(n) asm volatile("s_waitcnt lgkmcnt(" #n ")" ::: "memory")
#define PG8_BAR __builtin_amdgcn_s_barrier()
#define PG8_SCHED __builtin_amdgcn_sched_barrier(0)
    Unit cur, nxt; int ui = 0;
    if (!S.next(0, cur)) return;
    f32x4 acc[2][2][4][2];
#pragma unroll
    for (int a = 0; a < 2; ++a)
#pragma unroll
        for (int b = 0; b < 2; ++b)
#pragma unroll
            for (int m = 0; m < 4; ++m)
#pragma unroll
                for (int n = 0; n < 2; ++n) acc[a][b][m][n] = (f32x4){0.f, 0.f, 0.f, 0.f};
    bf16x8 At[4][2], B0[2][2], B1[2][2];
    const char* cA = cur.A; const char* cB = cur.B;
    PG8_STAGE(PG8_SB(0, 0), cB, voffB); PG8_STAGE(PG8_SB(0, 1), cB + hstep, voffB); PG8_STAGE(PG8_SA(0, 0), cA, voffA); PG8_STAGE(PG8_SA(0, 1), cA + hstep, voffA);
    if (wr == 1) PG8_BAR;
    PG8_WAIT_V(2); PG8_BAR;
    PG8_STAGE(PG8_SB(1, 0), cB + kstep, voffB); PG8_STAGE(PG8_SA(1, 0), cA + kstep, voffA); PG8_STAGE(PG8_SB(1, 1), cB + hstep + kstep, voffB);
    PG8_WAIT_V(6); PG8_BAR;
    for (;;) {
        const bool has_next = S.next(ui + 1, nxt);
        const char* nA = has_next ? nxt.A : cA; const char* nB = has_next ? nxt.B : cB;
        for (int t = 0; t < nt; t += 2) {
            const bool last = (t == nt - 2);
            const char* a1 = cA + (size_t)(t + 1) * kstep;
            const char* a2 = last ? nA : cA + (size_t)(t + 2) * kstep; const char* b2 = last ? nB : cB + (size_t)(t + 2) * kstep;
            const char* a3 = a2 + kstep; const char* b3 = b2 + kstep;
            PG8_LDB(B0, 0, 0); PG8_LDB(B1, 0, 1); PG8_SCHED; PG8_LDA(At, 0, 0); PG8_STAGE(PG8_SA(1, 1), a1 + hstep, voffA);
            PG8_WAIT_V(8); PG8_WAIT_L(0); PG8_BAR; PG8_MMA(0, 0, At, B0); PG8_MMA(0, 1, At, B1); PG8_BAR; PG8_SCHED;
            PG8_LDA(At, 0, 1); PG8_STAGE(PG8_SB(0, 0), b2, voffB); PG8_STAGE(PG8_SB(0, 1), b2 + hstep, voffB); PG8_STAGE(PG8_SA(0, 0), a2, voffA);
            PG8_WAIT_V(8); PG8_WAIT_L(0); PG8_BAR; PG8_MMA(1, 0, At, B0); PG8_MMA(1, 1, At, B1); PG8_BAR; PG8_SCHED;
            PG8_LDB(B0, 1, 0); PG8_LDB(B1, 1, 1); PG8_SCHED; PG8_LDA(At, 1, 0); PG8_STAGE(PG8_SA(0, 1), a2 + hstep, voffA);
            PG8_WAIT_V(8); PG8_WAIT_L(0); PG8_BAR; PG8_MMA(0, 0, At, B0); PG8_MMA(0, 1, At, B1); PG8_BAR; PG8_SCHED;
            PG8_LDA(At, 1, 1); PG8_STAGE(PG8_SB(1, 0), b3, voffB); PG8_STAGE(PG8_SB(1, 1), b3 + hstep, voffB); PG8_STAGE(PG8_SA(1, 0), a3, voffA);
            PG8_WAIT_V(8); PG8_WAIT_L(0); PG8_BAR; PG8_MMA(1, 0, At, B0); PG8_MMA(1, 1, At, B1); PG8_BAR; PG8_SCHED;
        }
        if (wr == 0) PG8_BAR;
        E(acc, cur, wr, wc, fr, fq);
        if (!has_next) break;
#pragma unroll
        for (int a = 0; a < 2; ++a)
#pragma unroll
            for (int b = 0; b < 2; ++b)
#pragma unroll
                for (int m = 0; m < 4; ++m)
#pragma unroll
                    for (int n = 0; n < 2; ++n) acc[a][b][m][n] = (f32x4){0.f, 0.f, 0.f, 0.f};
        cur = nxt; cA = nA; cB = nB; ++ui;
        if (wr == 1) PG8_BAR;
    }
    PG8_WAIT_V(0);
    PG8_BAR;
#undef PG8_SA
#undef PG8_SB
#undef PG8_STAGE
#undef PG8_LDA
#undef PG8_LDB
#undef PG8_MMA
#undef PG8_WAIT_V
#undef PG8_WAIT_L
#undef PG8_BAR
#undef PG8_SCHED
}
#ifndef HANDOFF
#define HANDOFF 0
#endif
constexpr unsigned RDY_NEED = HANDOFF == 2 ? 8u : 64u, RDY_SPIN_CAP = 1u << 22;
__device__ __forceinline__ void rdy_wait(const unsigned* w) { unsigned sp = 0;
    while ((unsigned)__builtin_amdgcn_readfirstlane((int)__hip_atomic_load(w, __ATOMIC_RELAXED, __HIP_MEMORY_SCOPE_AGENT)) < RDY_NEED) { __builtin_amdgcn_s_sleep(2); if (++sp > RDY_SPIN_CAP) break; } }
template <class Epi, class Sched, bool GATHER = false, int MODE = 0, bool PRE = false>
__device__ __forceinline__ void gemm8_phase(LAS unsigned char* lds, const Sched& S, const Epi& E, const int tid, const int wid, unsigned* rdy = nullptr) {
    const int wr = wid >> 2, wc = wid & 3, lane = tid & 63, fr = lane & 15, fq = lane >> 4;
    constexpr int K = KK / 2, nt = K / BK;
    unsigned voffA[2], voffB[2]; int RA[2], CA[2];
#pragma unroll
    for (int i = 0; i < 2; ++i) { int R, C; stage_rc(tid * 16 + i * 8192, R, C); const int Rb = (R & ~31) + perm32(R & 31); RA[i] = R; CA[i] = C;
        voffA[i] = (unsigned)(R * K + C) * 2u; voffB[i] = (unsigned)(Rb * K + C) * 2u; }
    unsigned vA0[2], vA1[2], nA0[2], nA1[2];
    LAS int* lidx = (LAS int*)(lds + STAGE_BYTES);
    constexpr size_t kstep = (size_t)(BK * 2), hstep = (size_t)HALF * K * 2;
    const unsigned ldsw = (unsigned)wid * 1024u;
    const int aoff = lds_byte(wr * 64 + fr, fq * 8), boff = lds_byte(wc * 32 + fr, fq * 8);
#define PG8_SA(b, h) (((b) * 2 + (h)) * HTB)
#define PG8_SB(b, h) ((4 + (b) * 2 + (h)) * HTB)
#define PG8_STAGE(bufoff, gbase, voff) do { _Pragma("unroll") for (int _i = 0; _i < 2; ++_i) \
        __builtin_amdgcn_global_load_lds((const unsigned*)((const char*)(gbase) + (voff)[_i]), (LAS unsigned*)(lds + (bufoff) + ldsw + _i * 8192), 16, 0, 0); } while (0)
#define PG8_LD8(p) __builtin_shufflevector(*(const LAS u32x4*)(p), *(const LAS u32x4*)((p) + 1024), 0, 1, 2, 3, 4, 5, 6, 7)
#define PG8_STAGE_A(bufoff, gbase, h, vg0, vg1) do { if constexpr (GATHER) { if ((h) == 0) PG8_STAGE(bufoff, gbase, vg0); else PG8_STAGE(bufoff, gbase, vg1); } else PG8_STAGE(bufoff, (gbase) + (h) * hstep, voffA); } while (0)
#define PG8_LDA(dst, b, h) do { _Pragma("unroll") for (int m = 0; m < 4; ++m) dst[m] = PG8_LD8(lds + PG8_SA(b, h) + aoff + m * 2048); } while (0)
#define PG8_LDB(dst, b, h) do { _Pragma("unroll") for (int n = 0; n < 2; ++n) dst[n] = PG8_LD8(lds + PG8_SB(b, h) + boff + n * 2048); } while (0)
#define PG8_MMA(ai, bj, At, Bt) do { __builtin_amdgcn_s_setprio(1); _Pragma("unroll") for (int m = 0; m < 4; ++m) _Pragma("unroll") for (int n = 0; n < 2; ++n) \
        asm volatile("v_mfma_f32_16x16x128_f8f6f4 %0, %1, %2, %0" : "+v"(acc[ai][bj][m][n]) : "v"(Bt[n]), "v"(At[m])); __builtin_amdgcn_s_setprio(0); } while (0)
#define PG8_WAIT_V(n) asm volatile("s_waitcnt vmcnt(" #n ")" ::: "memory")
#define PG8_WAIT_L(n) asm volatile("s_waitcnt lgkmcnt(" #n ")" ::: "memory")
#define PG8_BAR __builtin_amdgcn_s_barrier()
#define PG8_SCHED __builtin_amdgcn_sched_barrier(0)
    Unit cur, nxt; int ui = 0;
    if (!S.next(0, cur)) return;
    f32x4 acc[2][2][4][2];
#pragma unroll
    for (int a = 0; a < 2; ++a)
#pragma unroll
        for (int b = 0; b < 2; ++b)
#pragma unroll
            for (int m = 0; m < 4; ++m)
#pragma unroll
                for (int n = 0; n < 2; ++n) acc[a][b][m][n] = (f32x4){0.f, 0.f, 0.f, 0.f};
    u32x8 At[4], B0[2], B1[2];
    const char* cA = cur.A; const char* cB = cur.B;
    int prev_pm = -1; (void)prev_pm;
    LAS float* ebuf = (LAS float*)(lds + STAGE_BYTES + 8192);
#define PG8_PRE(u_, par_) do { if constexpr (PRE) { if (wid >= 4) { _Pragma("unroll") for (int _j = 0; _j < 2; ++_j) \
        __builtin_amdgcn_global_load_lds((const unsigned*)E.pre(u_, _j * 256 + (wid - 4) * 64 + lane), (LAS unsigned*)(ebuf + (par_) * 512 + _j * 256 + (wid - 4) * 64), 4, 0, 0); } } } while (0)
    PG8_PRE(cur, 0);
    if constexpr (MODE == 2) { rdy_wait(rdy + 64 * cur.pm); asm volatile("" ::: "memory"); }
    if constexpr (GATHER) {
#pragma unroll
        for (int i = 0; i < 2; ++i) { const unsigned r0 = (unsigned)S.rtok[cur.pm * 256 + RA[i]], r1 = (unsigned)S.rtok[cur.pm * 256 + HALF + RA[i]];
            vA0[i] = (r0 < (unsigned)NTOK ? r0 : (unsigned)(NTOK - 1)) * (unsigned)(K * 2) + (unsigned)CA[i] * 2u; vA1[i] = (r1 < (unsigned)NTOK ? r1 : (unsigned)(NTOK - 1)) * (unsigned)(K * 2) + (unsigned)CA[i] * 2u; nA0[i] = vA0[i]; nA1[i] = vA1[i]; } }
    PG8_STAGE(PG8_SB(0, 0), cB, voffB); PG8_STAGE(PG8_SB(0, 1), cB + hstep, voffB); PG8_STAGE_A(PG8_SA(0, 0), cA, 0, vA0, vA1); PG8_STAGE_A(PG8_SA(0, 1), cA, 1, vA0, vA1);
    if (wr == 1) PG8_BAR;
    PG8_WAIT_V(2); PG8_BAR;
    PG8_STAGE(PG8_SB(1, 0), cB + kstep, voffB); PG8_STAGE_A(PG8_SA(1, 0), cA + kstep, 0, vA0, vA1); PG8_STAGE(PG8_SB(1, 1), cB + hstep + kstep, voffB);
    PG8_WAIT_V(6); PG8_BAR;
    for (;;) {
        const bool has_next = S.next(ui + 1, nxt);
        const char* nA = has_next ? nxt.A : cA; const char* nB = has_next ? nxt.B : cB;
        if constexpr (MODE == 2) { if (has_next && wid == 0) __builtin_amdgcn_global_load_lds((const unsigned*)(rdy + 64 * nxt.pm), (LAS unsigned*)(lidx + ((ui + 1) & 1) * 256), 4, 0, 16); }
        if constexpr (GATHER) { if (has_next && wid < 4) __builtin_amdgcn_global_load_lds((const unsigned*)(S.rtok + nxt.pm * 256 + 64 * wid + (tid & 63)), (LAS unsigned*)(lidx + ((ui + 1) & 1) * 256 + 64 * wid), 4, 0, 0); }
#pragma clang loop unroll(disable)
        for (int t = 0; t < nt; t += 2) {
            const bool last = (t == nt - 2);
            const char* a1 = cA + (size_t)(t + 1) * kstep;
            const char* a2 = last ? nA : cA + (size_t)(t + 2) * kstep; const char* b2 = last ? nB : cB + (size_t)(t + 2) * kstep;
            const char* a3 = a2 + kstep; const char* b3 = b2 + kstep;
            if constexpr (GATHER) { if (last && has_next) { const LAS int* ix = lidx + ((ui + 1) & 1) * 256;
#pragma unroll
                    for (int i = 0; i < 2; ++i) { const unsigned r0 = (unsigned)ix[RA[i]], r1 = (unsigned)ix[HALF + RA[i]];
                        nA0[i] = (r0 < (unsigned)NTOK ? r0 : (unsigned)(NTOK - 1)) * (unsigned)(K * 2) + (unsigned)CA[i] * 2u; nA1[i] = (r1 < (unsigned)NTOK ? r1 : (unsigned)(NTOK - 1)) * (unsigned)(K * 2) + (unsigned)CA[i] * 2u; } } }
            if constexpr (MODE == 2) { if (last && has_next) { const unsigned snap = (unsigned)__builtin_amdgcn_readfirstlane(*(const LAS int*)(lidx + ((ui + 1) & 1) * 256));
                    if (snap < RDY_NEED) rdy_wait(rdy + 64 * nxt.pm);
                    asm volatile("" ::: "memory"); } }
            unsigned sA0[2], sA1[2];
#pragma unroll
            for (int i = 0; i < 2; ++i) { sA0[i] = last ? nA0[i] : vA0[i]; sA1[i] = last ? nA1[i] : vA1[i]; }
            PG8_LDB(B0, 0, 0); PG8_LDB(B1, 0, 1); PG8_SCHED; PG8_LDA(At, 0, 0); PG8_STAGE_A(PG8_SA(1, 1), a1, 1, vA0, vA1);
            PG8_WAIT_V(8); PG8_WAIT_L(0); PG8_BAR; PG8_MMA(0, 0, At, B0); PG8_MMA(0, 1, At, B1); PG8_BAR; PG8_SCHED;
            PG8_LDA(At, 0, 1); PG8_STAGE(PG8_SB(0, 0), b2, voffB); PG8_STAGE(PG8_SB(0, 1), b2 + hstep, voffB); PG8_STAGE_A(PG8_SA(0, 0), a2, 0, sA0, sA1);
            PG8_WAIT_V(8); PG8_WAIT_L(0); PG8_BAR; PG8_MMA(1, 0, At, B0); PG8_MMA(1, 1, At, B1); PG8_BAR; PG8_SCHED;
            PG8_LDB(B0, 1, 0); PG8_LDB(B1, 1, 1); PG8_SCHED; PG8_LDA(At, 1, 0); PG8_STAGE_A(PG8_SA(0, 1), a2, 1, sA0, sA1);
            PG8_WAIT_V(8); PG8_WAIT_L(0); PG8_BAR; PG8_MMA(0, 0, At, B0); PG8_MMA(0, 1, At, B1); PG8_BAR; PG8_SCHED;
            PG8_LDA(At, 1, 1); PG8_STAGE(PG8_SB(1, 0), b3, voffB); PG8_STAGE(PG8_SB(1, 1), b3 + hstep, voffB); PG8_STAGE_A(PG8_SA(1, 0), a3, 0, sA0, sA1);
            PG8_WAIT_V(8); PG8_WAIT_L(0); PG8_BAR; PG8_MMA(1, 0, At, B0); PG8_MMA(1, 1, At, B1); PG8_BAR; PG8_SCHED;
        }
        asm volatile("s_nop 15\n\ts_nop 15" ::: "memory");
        if (wr == 0) PG8_BAR;
        if constexpr (MODE == 1 && PRE) { E.template run_pre<true>(acc, cur, wr, wc, fr, fq, prev_pm, ebuf + (ui & 1) * 512); prev_pm = __builtin_amdgcn_readfirstlane(cur.pm); }
        else if constexpr (MODE == 1) { E.template run<true>(acc, cur, wr, wc, fr, fq, prev_pm); prev_pm = __builtin_amdgcn_readfirstlane(cur.pm); }
        else if constexpr (PRE) E.run_pre0(acc, cur, wr, wc, fr, fq, ebuf + (ui & 1) * 512);
        else E(acc, cur, wr, wc, fr, fq);
        if (!has_next) break;
#pragma unroll
        for (int a = 0; a < 2; ++a)
#pragma unroll
            for (int b = 0; b < 2; ++b)
#pragma unroll
                for (int m = 0; m < 4; ++m)
#pragma unroll
                    for (int n = 0; n < 2; ++n) acc[a][b][m][n] = (f32x4){0.f, 0.f, 0.f, 0.f};
        cur = nxt; cA = nA; cB = nB; ++ui;
        PG8_PRE(cur, ui & 1);
        if constexpr (GATHER) {
#pragma unroll
            for (int i = 0; i < 2; ++i) { vA0[i] = nA0[i]; vA1[i] = nA1[i]; } }
        if (wr == 1) PG8_BAR;
    }
    PG8_WAIT_V(0);
    if constexpr (MODE == 1) { if (lane == 0) (void)__hip_atomic_fetch_add(rdy + 64 * __builtin_amdgcn_readfirstlane(cur.pm), 1u, __ATOMIC_RELAXED, __HIP_MEMORY_SCOPE_AGENT); }
    PG8_BAR;
#undef PG8_PRE
#undef PG8_SA
#undef PG8_SB
#undef PG8_STAGE
#undef PG8_LDA
#undef PG8_STAGE_A
#undef PG8_LD8
#undef PG8_LDB
#undef PG8_MMA
#undef PG8_WAIT_V
#undef PG8_WAIT_L
#undef PG8_BAR
#undef PG8_SCHED
}
}

#define XB_TMO      128
#define XB_XCNT(j)  (256  + 64 * (j))
#define XB_XSUB(j)  (1280 + 64 * (j))
#define XB_XGEN(j)  (2304 + 64 * (j))
#define XB_TOP      3328
#define XB_TOPGEN   3392
#define XCD_BAR_WORDS 3456
#define XB_SPIN_CAP (1u << 18)
__device__ __forceinline__ unsigned xb_ld(unsigned* p)              { return __hip_atomic_load(p, __ATOMIC_RELAXED, __HIP_MEMORY_SCOPE_AGENT); }
__device__ __forceinline__ unsigned xb_add(unsigned* p, unsigned v) { return __hip_atomic_fetch_add(p, v, __ATOMIC_RELAXED, __HIP_MEMORY_SCOPE_AGENT); }
__device__ __forceinline__ unsigned xb_xcc_id() { return (unsigned)__builtin_amdgcn_s_getreg((3 << 11) | 20) & 0xFu; }
#define XB_SPIN(cond, bar) do { unsigned _sp = 0; while (cond) { __builtin_amdgcn_s_sleep(1); \
    if ((++_sp & 255u) == 0u) { if (xb_ld(&(bar)[XB_TMO])) break; if (_sp > XB_SPIN_CAP) { atomicAdd(&(bar)[XB_TMO], 1u); break; } } } } while (0)
struct XcdBarrier { unsigned* bar; unsigned x; volatile LAS unsigned* st; };
__device__ __forceinline__ XcdBarrier xcd_barrier_post(unsigned* bar, volatile LAS unsigned* st) {
    XcdBarrier b; b.bar = bar; b.x = xb_xcc_id(); b.st = st;
    if (threadIdx.x == 0) (void)xb_add(&bar[XB_XCNT(b.x)], 1u);
    return b;
}
__device__ __forceinline__ void xcd_barrier_complete(unsigned* bar, unsigned x, unsigned& nloc, unsigned& nx) {
    const unsigned G = gridDim.x * gridDim.y * gridDim.z;
    unsigned sum, cnt, mine, sp = 0u;
    for (;;) {
        sum = 0u; cnt = 0u; mine = 0u;
#pragma unroll
        for (unsigned j = 0; j < 16; ++j) { const unsigned c = xb_ld(&bar[XB_XCNT(j)]); sum += c; cnt += (c > 0u) ? 1u : 0u; mine = (j == x) ? c : mine; }
        if (sum == G) break;
        __builtin_amdgcn_s_sleep(1);
        if ((++sp & 255u) == 0u) { if (xb_ld(&bar[XB_TMO])) break; if (sp > XB_SPIN_CAP) { atomicAdd(&bar[XB_TMO], 1u); break; } }
    }
    nloc = mine > 0u ? mine : 1u; nx = cnt > 0u ? cnt : 1u;
}
__device__ __forceinline__ void xcd_barrier(const XcdBarrier& b, const bool leader) {
    asm volatile("s_waitcnt vmcnt(0)" ::: "memory");
    __syncthreads();
    if (leader) {
        unsigned* bar = b.bar;
        __builtin_amdgcn_s_waitcnt(0);
        unsigned nloc = b.st[0], nx = b.st[1];
        if (nloc == 0u) { xcd_barrier_complete(bar, b.x, nloc, nx); b.st[0] = nloc; b.st[1] = nx; }
        const unsigned old = xb_add(&bar[XB_XSUB(b.x)], 1u);
        const unsigned gen = old / nloc;
        if (old + 1u == (gen + 1u) * nloc) {
            __builtin_amdgcn_fence(__ATOMIC_RELEASE, "agent");
            asm volatile("s_waitcnt vmcnt(0)" ::: "memory");
            const unsigned og = xb_add(&bar[XB_TOP], 1u);
            const unsigned tg = og / nx;
            if (og + 1u == (tg + 1u) * nx) xb_add(&bar[XB_TOPGEN], 1u);
            else XB_SPIN(xb_ld(&bar[XB_TOPGEN]) == tg, bar);
            __builtin_amdgcn_fence(__ATOMIC_ACQUIRE, "agent");
            xb_add(&bar[XB_XGEN(b.x)], 1u);
            asm volatile("s_waitcnt vmcnt(0)" ::: "memory");
        } else {
            XB_SPIN(xb_ld(&bar[XB_XGEN(b.x)]) == gen, bar);
            __builtin_amdgcn_fence(__ATOMIC_ACQUIRE, "agent");
            asm volatile("s_waitcnt vmcnt(0)" ::: "memory");
        }
    }
    __syncthreads();
}

constexpr int NWAVES = 8;
constexpr int RING_OFF = 0, RING_BYTES = 131072;
constexpr int LDSCTL_OFF = 160 * 1024 - 512, MISC_OFF = LDSCTL_OFF + 320;
#ifndef DBG_BAR10
#define DBG_BAR10 0
#endif

constexpr int TILEE_OFF = RING_OFF + RING_BYTES + 4096;
constexpr int LDS_BYTES = 160 * 1024;

struct Args { const float* in[23]; float* out; unsigned char* ws; int ph_lo, ph_hi, li, pad; };

__device__ __forceinline__ void p0_transpose_item(const float* __restrict__ W, int ldw, bf16* __restrict__ WT, int drow0, int n0, int k0, LAS float* scr, int lane, const float* __restrict__ kscale = nullptr) {
    const int c = lane & 7;
    f32x4 ks0 = (f32x4){1.f, 1.f, 1.f, 1.f}, ks1 = ks0;
    if (kscale) { ks0 = *(const f32x4*)(kscale + k0 + 8 * c); ks1 = *(const f32x4*)(kscale + k0 + 8 * c + 4); }
#pragma unroll 8
    for (int i = 0; i < 32; ++i) { const int kk = 2 * i + (lane >> 5); scr[kk * 33 + (lane & 31)] = W[(size_t)(k0 + kk) * ldw + n0 + (lane & 31)]; }
    LDS_WAIT(); asm volatile("" ::: "memory");
    float t[4][8];
#pragma unroll
    for (int j = 0; j < 4; ++j) { const LAS float* sp = scr + (8 * c) * 33 + (lane >> 3) + 8 * j;
#pragma unroll
        for (int q = 0; q < 8; ++q) t[j][q] = sp[q * 33]; }
    LDS_WAIT(); asm volatile("" ::: "memory");
#pragma unroll
    for (int j = 0; j < 4; ++j) { const int n = (lane >> 3) + 8 * j;
        u32x4 o; o.x = pk2(t[j][0] * ks0[0], t[j][1] * ks0[1]); o.y = pk2(t[j][2] * ks0[2], t[j][3] * ks0[3]); o.z = pk2(t[j][4] * ks1[0], t[j][5] * ks1[1]); o.w = pk2(t[j][6] * ks1[2], t[j][7] * ks1[3]);
        *(GAS u32x4*)(WT + (size_t)(drow0 + n) * D + k0 + 8 * c) = o; }
}
__device__ __forceinline__ void p0_item_load(float (&rg)[32], const float* __restrict__ W, int ldw, int n0, int k0, int lane) {
#pragma unroll
    for (int i = 0; i < 32; ++i) rg[i] = W[(size_t)(k0 + 2 * i + (lane >> 5)) * ldw + n0 + (lane & 31)];
}
__device__ __forceinline__ void p0_item_finish(const float (&rg)[32], bf16* __restrict__ WT, int drow0, int k0, LAS float* scr, int lane, const float* __restrict__ kscale) {
    const int c = lane & 7;
    f32x4 ks0 = (f32x4){1.f, 1.f, 1.f, 1.f}, ks1 = ks0;
    if (kscale) { ks0 = *(const f32x4*)(kscale + k0 + 8 * c); ks1 = *(const f32x4*)(kscale + k0 + 8 * c + 4); }
#pragma unroll
    for (int i = 0; i < 32; ++i) scr[(2 * i + (lane >> 5)) * 33 + (lane & 31)] = rg[i];
    LDS_WAIT(); asm volatile("" ::: "memory");
    float t[4][8];
#pragma unroll
    for (int j = 0; j < 4; ++j) { const LAS float* sp = scr + (8 * c) * 33 + (lane >> 3) + 8 * j;
#pragma unroll
        for (int q = 0; q < 8; ++q) t[j][q] = sp[q * 33]; }
    LDS_WAIT(); asm volatile("" ::: "memory");
    const float sc = MOE_FP8 ? W8S : 1.f;
#pragma unroll
    for (int j = 0; j < 4; ++j) { const int n = (lane >> 3) + 8 * j;
        const float v0 = t[j][0] * (ks0[0] * sc), v1 = t[j][1] * (ks0[1] * sc), v2 = t[j][2] * (ks0[2] * sc), v3 = t[j][3] * (ks0[3] * sc), v4 = t[j][4] * (ks1[0] * sc), v5 = t[j][5] * (ks1[1] * sc), v6 = t[j][6] * (ks1[2] * sc), v7 = t[j][7] * (ks1[3] * sc);
        if (MOE_FP8) { u32x2 o; o.x = pk4_fp8(v0, v1, v2, v3); o.y = pk4_fp8(v4, v5, v6, v7);
            *(GAS u32x2*)((unsigned char*)WT + (size_t)(drow0 + n) * D + k0 + 8 * c) = o; }
        else { u32x4 o; o.x = pk2(v0, v1); o.y = pk2(v2, v3); o.z = pk2(v4, v5); o.w = pk2(v6, v7);
            *(GAS u32x4*)(WT + (size_t)(drow0 + n) * D + k0 + 8 * c) = o; } }
}
__device__ __forceinline__ void rms_row_to_bf16(const float* __restrict__ xrow, const float* __restrict__ w, bf16* __restrict__ orow, int lane) {
    const f32x4* xr = (const f32x4*)xrow + lane;
    f32x4 v[4]; float s = 0.f;
#pragma unroll
    for (int j = 0; j < 4; ++j) { v[j] = xr[64 * j]; s += (v[j].x * v[j].x + v[j].y * v[j].y) + (v[j].z * v[j].z + v[j].w * v[j].w); }
    const float r = rsqrtf(wave_sum(s) * (1.f / D) + EPS);
    u32x2* o8 = (u32x2*)orow + lane;
#pragma unroll
    for (int j = 0; j < 4; ++j) { const f32x4 ww = ((const f32x4*)w)[lane + 64 * j]; u32x2 o; o.x = pk2(v[j].x * r * ww.x, v[j].y * r * ww.y); o.y = pk2(v[j].z * r * ww.z, v[j].w * r * ww.w); o8[64 * j] = o; }
}


typedef __bf16 bf16x2_t __attribute__((ext_vector_type(2)));
typedef float f32x2_t __attribute__((ext_vector_type(2)));
__device__ __forceinline__ unsigned cvtpk(float lo, float hi) { const f32x2_t v = {lo, hi}; const bf16x2_t b = __builtin_convertvector(v, bf16x2_t); return __builtin_bit_cast(unsigned, b); }
__device__ __forceinline__ void attn_unit(LAS unsigned char* lds, const bf16* Q, const bf16* KB, const bf16* VT, bf16* AO, int b, int h, int qb, int lane, int wave) {
    constexpr int RS = 528, HB = 73728, HOFF = HB - 128 * RS;
    const int r = lane & 31, hh = lane >> 5;
    const size_t tokq = (size_t)b * SEQ + (size_t)qb * 256 + wave * 32 + r;
    bf16x8 qf[16];
    { const bf16* qp = Q + tokq * D + h * 256 + 8 * hh;
#pragma unroll
      for (int s2 = 0; s2 < 16; ++s2) qf[s2] = *(const bf16x8*)(qp + 16 * s2); }
    const char* kbase = (const char*)(KB + (size_t)(b * MEML) * D + h * 256);
    const char* vbase = (const char*)(VT + (size_t)(h * 256) * NMEM + b * MEML);
#define ATT_DMA(base, pitch, half) do { int ln_ = lane; asm volatile("" : "+v"(ln_)); int g_ = wave * 64 + ln_; int row_ = g_ / 33, cs_ = g_ - row_ * 33; \
        _Pragma("unroll") for (int i_ = 0; i_ < 9; ++i_) { const int rr_ = row_ > 127 ? 127 : row_, cc_ = cs_ > 31 ? 31 : cs_; \
            __builtin_amdgcn_global_load_lds((const unsigned*)((base) + (size_t)(128 * (half) + rr_) * (pitch) + cc_ * 16), (LAS unsigned*)(lds + (half) * HB + (wave + 8 * i_) * 1024), 16, 0, 0); \
            cs_ += 17; row_ += 15; if (cs_ >= 33) { cs_ -= 33; row_ += 1; } } } while (0)
#define ATT_WAIT(n) asm volatile("s_waitcnt vmcnt(" #n ")" ::: "memory")
#define ATT_BAR() do { asm volatile("s_waitcnt lgkmcnt(0)" ::: "memory"); __builtin_amdgcn_s_barrier(); asm volatile("" ::: "memory"); } while (0)
    ATT_DMA(kbase, D * 2, 0); ATT_DMA(kbase, D * 2, 1);
    ATT_WAIT(9); ATT_BAR();
    const LAS unsigned char* kread = lds + r * RS + hh * 16;
    u32x4 pp[8][2]; float alpha[4]; float mrun = -INFINITY, lrun = 0.f;
#pragma unroll
    for (int kq = 0; kq < 4; ++kq) {
        if (kq == 2) { ATT_WAIT(9); ATT_BAR(); }
        f32x16 st[2];
#pragma unroll
        for (int t2 = 0; t2 < 2; ++t2) { const int t = 2 * kq + t2; f32x16 acc;
#pragma unroll
            for (int e = 0; e < 16; ++e) acc[e] = 0.f;
#pragma unroll
            for (int s2 = 0; s2 < 16; ++s2) { const bf16x8 a = *(const LAS bf16x8*)(kread + 32 * t * RS + (t >= 4 ? HOFF : 0) + s2 * 32); acc = __builtin_amdgcn_mfma_f32_32x32x16_bf16(a, qf[s2], acc, 0, 0, 0); if ((s2 & 3) == 3) __builtin_amdgcn_sched_barrier(0); }
            st[t2] = acc; }
        if (kq == 1) { ATT_BAR(); ATT_DMA(vbase, NMEM * 2, 0); }
        if (kq == 3) { ATT_BAR(); ATT_DMA(vbase, NMEM * 2, 1); }
        float m = st[0][0];
#pragma unroll
        for (int t2 = 0; t2 < 2; ++t2)
#pragma unroll
            for (int e = 0; e < 16; ++e) m = fmaxf(m, st[t2][e]);
        m = fmaxf(m, __shfl_xor(m, 32)); m = fmaxf(m, mrun);
        alpha[kq] = __builtin_amdgcn_exp2f((mrun - m) * 1.4426950408889634f); mrun = m;
        float ls = 0.f; const float mc = m * 1.4426950408889634f;
#pragma unroll
        for (int t2 = 0; t2 < 2; ++t2) { const int t = 2 * kq + t2; float pe[16];
#pragma unroll
            for (int e = 0; e < 16; ++e) { pe[e] = __builtin_amdgcn_exp2f(st[t2][e] * 1.4426950408889634f - mc); ls += pe[e]; }
#pragma unroll
            for (int u = 0; u < 2; ++u) { pp[t][u].x = cvtpk(pe[8 * u], pe[8 * u + 1]); pp[t][u].y = cvtpk(pe[8 * u + 2], pe[8 * u + 3]); pp[t][u].z = cvtpk(pe[8 * u + 4], pe[8 * u + 5]); pp[t][u].w = cvtpk(pe[8 * u + 6], pe[8 * u + 7]); }
            __builtin_amdgcn_sched_barrier(0); }
        lrun = lrun * alpha[kq] + ls;
    }
    const float l = lrun + __shfl_xor(lrun, 32);
    const float rl = 1.f / l;
    bf16* orow0 = AO + tokq * D + h * 256;
    const LAS unsigned char* vread = lds + r * RS + 8 * hh;
#pragma unroll
    for (int half = 0; half < 2; ++half) {
        if (half == 0) { ATT_WAIT(9); } else { ATT_WAIT(0); }
        ATT_BAR();
#pragma unroll
        for (int dt = 4 * half; dt < 4 * half + 4; ++dt) { f32x16 acc;
#pragma unroll
            for (int e = 0; e < 16; ++e) acc[e] = 0.f;
            const LAS unsigned char* vrow = vread + 32 * dt * RS + (dt >= 4 ? HOFF : 0);
#pragma unroll
            for (int t = 0; t < 8; ++t) {
                if (t == 2 || t == 4 || t == 6) {
#pragma unroll
                    for (int e = 0; e < 16; ++e) acc[e] *= alpha[t >> 1]; }
#pragma unroll
                for (int u = 0; u < 2; ++u) { const u32x2 a0 = *(const LAS u32x2*)(vrow + (4 * t + 2 * u) * 16), a1 = *(const LAS u32x2*)(vrow + (4 * t + 2 * u + 1) * 16);
                    u32x4 aw; aw.x = a0.x; aw.y = a0.y; aw.z = a1.x; aw.w = a1.y;
                    acc = __builtin_amdgcn_mfma_f32_32x32x16_bf16(__builtin_bit_cast(bf16x8, aw), __builtin_bit_cast(bf16x8, pp[t][u]), acc, 0, 0, 0); }
                __builtin_amdgcn_sched_barrier(0); }
            u32x2 w[4];
#pragma unroll
            for (int g = 0; g < 4; ++g) { w[g].x = cvtpk(acc[4 * g] * rl, acc[4 * g + 1] * rl); w[g].y = cvtpk(acc[4 * g + 2] * rl, acc[4 * g + 3] * rl); }
#pragma unroll
            for (int p2 = 0; p2 < 2; ++p2) {
                const u32x2 rx = __builtin_amdgcn_permlane32_swap(w[2 * p2].x, w[2 * p2 + 1].x, false, false), ry = __builtin_amdgcn_permlane32_swap(w[2 * p2].y, w[2 * p2 + 1].y, false, false);
                *(u32x4*)(orow0 + 32 * dt + 16 * p2 + 8 * hh) = (u32x4){rx.x, ry.x, rx.y, ry.y}; } }
    }
    ATT_BAR();
#undef ATT_DMA
#undef ATT_WAIT
#undef ATT_BAR
}

template <int K> struct ScanGeo { static constexpr int QS = K + 8, VS = 72, OFF_KR = 64 * QS * 2, OFF_TAB = 2 * 64 * QS * 2, BLOB = OFF_TAB + 3 * K * 4; };
__device__ __forceinline__ size_t blob_off(int grp, int b, int h, int c) { return grp == 0 ? (size_t)(((b * 4 + h) * 32) + c) * ScanGeo<128>::BLOB : (size_t)1024 * ScanGeo<128>::BLOB + (size_t)(((b * 4 + h) * 32) + c) * ScanGeo<64>::BLOB; }
#define SC_PIN(pv) asm volatile("" : "+v"(pv[0]), "+v"(pv[1]), "+v"(pv[2]), "+v"(pv[3]), "+v"(pv[4]), "+v"(pv[5]), "+v"(pv[6]), "+v"(pv[7]), "+v"(pv[8]), "+v"(pv[9]), "+v"(pv[10]), "+v"(pv[11]), "+v"(pv[12]), "+v"(pv[13]), "+v"(pv[14]), "+v"(pv[15]))
#define SC_BAR() do { asm volatile("s_waitcnt vmcnt(0) lgkmcnt(0)" ::: "memory"); __builtin_amdgcn_s_barrier(); asm volatile("" ::: "memory"); } while (0)
#define SC_BARL2() do { asm volatile("s_waitcnt lgkmcnt(0)" ::: "memory"); __builtin_amdgcn_s_barrier(); asm volatile("" ::: "memory"); } while (0)

template <int K, int GRP>
__device__ __forceinline__ void prep_load(float (&g)[64 / (512 / K)], unsigned short (&q)[64 / (512 / K)], unsigned short (&kk)[64 / (512 / K)], const bf16* PB, const _Float16* G, int b, int h, int c, int tid) {
    constexpr int NQ = 512 / K, RPT = 64 / NQ;
    const int qcol = (GRP == 0 ? C_HQ : C_GQ) + h * K, kcol = (GRP == 0 ? C_HF : C_GK) + h * K, gcol = (GRP == 0 ? 0 : 512) + h * K;
    const int pk = tid & (K - 1), prq = tid / K;
    const size_t tok0 = (size_t)b * SEQ + (size_t)c * 64;
#pragma unroll
    for (int r = 0; r < RPT; ++r) { const size_t tk = tok0 + RPT * prq + r; g[r] = (float)G[tk * GW + gcol + pk]; q[r] = PB[tk * PBW + qcol + pk]; kk[r] = PB[tk * PBW + kcol + pk]; }
}
template <int K>
__device__ __forceinline__ void prep_p1(const float (&g)[64 / (512 / K)], const unsigned short (&pq)[64 / (512 / K)], const unsigned short (&pkk)[64 / (512 / K)], LAS unsigned char* lds, int tid) {
    typedef ScanGeo<K> GE; constexpr int NQ = 512 / K, RPT = 64 / NQ, QS = GE::QS;
    LAS bf16* QR = (LAS bf16*)lds; LAS bf16* KR = (LAS bf16*)(lds + GE::OFF_KR); LAS float* TAB = (LAS float*)(lds + GE::OFF_TAB); LAS float* TOT = (LAS float*)(lds + GE::BLOB);
    const int pk = tid & (K - 1), prq = tid / K;
    float bc[RPT];
    { float run = 0.f;
#pragma unroll
      for (int r = 0; r < RPT; ++r) { run += g[r]; bc[r] = run; }
      TOT[prq * K + pk] = run; }
    SC_BARL2();
    { float pre = 0.f, rr = 0.f, tot = 0.f;
#pragma unroll
      for (int gq = 0; gq < NQ; ++gq) { const float t = TOT[gq * K + pk]; pre += (gq < prq) ? t : 0.f; rr += (gq < NQ / 2) ? t : 0.f; tot += t; }
      if (prq == 0) { TAB[pk] = __expf(rr); TAB[K + pk] = __expf(tot); TAB[2 * K + pk] = __expf(tot - rr); }
#pragma unroll
      for (int r = 0; r < RPT; ++r) { const float bb = pre + bc[r]; const float e1 = __expf(bb - rr); const float qv = bf2f(pq[r]) * e1, kv = bf2f(pkk[r]) * __builtin_amdgcn_rcpf(e1);
          QR[(RPT * prq + r) * QS + pk] = (bf16)f2bf(qv); KR[(RPT * prq + r) * QS + pk] = (bf16)f2bf(kv); } }
}
template <int K>
__device__ __forceinline__ void prep_p2(LAS unsigned char* lds, unsigned char* blob, int tid) {
    typedef ScanGeo<K> GE;
    SC_BARL2();
    for (int i = tid; i < GE::BLOB / 16; i += NWAVES * 64) ((u32x4*)blob)[i] = ((const LAS u32x4*)lds)[i];
    SC_BARL2();
}

template <int K, int GRP>
__device__ __forceinline__ void scan128(LAS unsigned char* lds, const bf16* PB, const unsigned char* blobs, bf16* Y, const float* onw, int b, int h, int tid, int lane, int wave) {
    typedef ScanGeo<K> GE; constexpr int QS = GE::QS, VS = GE::VS, NS = K / 32, NKT = K / 64, IMG = GE::OFF_TAB, NDMA = (GE::OFF_TAB / 8) / 1024 + 1;
    constexpr int PW = IMG / 8, NPF = PW / 1024, REM = (PW - NPF * 1024) / 16;
    LAS unsigned char* VTb = lds + 3 * IMG; LAS bf16* VT = (LAS bf16*)VTb; LAS bf16* SST = (LAS bf16*)(VTb + 128 * VS * 2);
    const int q4 = lane >> 4, l15 = lane & 15;
    const int vcol = (GRP == 0 ? C_HI : C_GV) + h * 128, gcol = (GRP == 0 ? C_HGATE : C_GGATE) + h * 128;
    const bool owave = wave < 4; const int I = wave & 3, ws = wave & 3;
    const int vrow = tid & 127, vv = 8 * (vrow & 15) + (vrow >> 4), jg = tid >> 7;
#define SC_DMA(c, buf) do { const unsigned char* src_ = blobs + (size_t)(c) * GE::BLOB + wave * PW + lane * 16; LAS unsigned char* dst_ = lds + (buf) * IMG + wave * PW; \
        _Pragma("unroll") for (int i_ = 0; i_ < NPF; ++i_) __builtin_amdgcn_global_load_lds((const unsigned*)(src_ + i_ * 1024), (LAS unsigned*)(dst_ + i_ * 1024), 16, 0, 0); \
        if (lane < REM) __builtin_amdgcn_global_load_lds((const unsigned*)(src_ + NPF * 1024), (LAS unsigned*)(dst_ + NPF * 1024), 16, 0, 0); } while (0)
#define SC_LOADV(c) do { const size_t t0_ = (size_t)b * SEQ + (size_t)(c) * 64 + 16 * jg; _Pragma("unroll") for (int r_ = 0; r_ < 16; ++r_) pv[r_] = PB[(t0_ + r_) * PBW + vcol + vv]; } while (0)
#define SC_LOADG(c, dst) do { const size_t t0_ = (size_t)b * SEQ + (size_t)(c) * 64 + 16 * I + 4 * q4; _Pragma("unroll") for (int reg_ = 0; reg_ < 4; ++reg_) dst[reg_] = *(const u32x4*)(PB + (t0_ + reg_) * PBW + gcol + 8 * l15); } while (0)
#define SC_LOADT(c) do { const float* tg_ = (const float*)(blobs + (size_t)(c) * GE::BLOB + GE::OFF_TAB); _Pragma("unroll") for (int a_ = 0; a_ < NKT; ++a_) _Pragma("unroll") for (int x_ = 0; x_ < 3; ++x_) tb[a_][x_] = *(const f32x4*)(tg_ + x_ * K + 16 * (NKT * ws + a_) + 4 * q4); } while (0)
#define SC_WAITN(n) asm volatile("s_waitcnt vmcnt(%0)" :: "n"(n) : "memory")
#define SC_BARL() do { asm volatile("s_waitcnt lgkmcnt(0)" ::: "memory"); __builtin_amdgcn_s_barrier(); asm volatile("" ::: "memory"); } while (0)
#define SC_TOP(c) const int buf = (c) % 3; \
        LAS bf16* QR = (LAS bf16*)(lds + buf * IMG); LAS bf16* KR = (LAS bf16*)(lds + buf * IMG + GE::OFF_KR); (void)QR; (void)KR; \
        if ((c) + 1 < SEQ / 64) SC_WAITN(NDMA); else SC_WAITN(0);     \
        SC_BARL();       \
        SC_PIN(pv);      \
        { u32x4 w0, w1; \
          w0.x = pv[0] | ((unsigned)pv[1] << 16); w0.y = pv[2] | ((unsigned)pv[3] << 16); w0.z = pv[4] | ((unsigned)pv[5] << 16); w0.w = pv[6] | ((unsigned)pv[7] << 16); \
          w1.x = pv[8] | ((unsigned)pv[9] << 16); w1.y = pv[10] | ((unsigned)pv[11] << 16); w1.z = pv[12] | ((unsigned)pv[13] << 16); w1.w = pv[14] | ((unsigned)pv[15] << 16); \
          *(LAS u32x4*)(VT + vrow * VS + 16 * jg) = w0; *(LAS u32x4*)(VT + vrow * VS + 16 * jg + 8) = w1; }
    unsigned pv[16];
    SC_LOADV(0);
    if (owave) {
        float nw[8]; u32x4 pgc[4], pgn[4], yv[4];
        { const f32x4 n0 = *(const f32x4*)(onw + 8 * l15), n1 = *(const f32x4*)(onw + 8 * l15 + 4); nw[0] = n0[0]; nw[1] = n0[1]; nw[2] = n0[2]; nw[3] = n0[3]; nw[4] = n1[0]; nw[5] = n1[1]; nw[6] = n1[2]; nw[7] = n1[3]; }
        SC_LOADG(0, pgc);
        SC_DMA(0, 0); SC_DMA(1, 1);
#pragma unroll
        for (int reg = 0; reg < 4; ++reg) { yv[reg] = (u32x4){0u, 0u, 0u, 0u}; pgn[reg] = yv[reg]; }
        for (int c = 0; c < SEQ / 64; ++c) {
            SC_TOP(c)
            SC_BARL();
            if (c + 1 < SEQ / 64) { SC_LOADV(c + 1); SC_LOADG(c + 1, pgn); }
            if (c > 0) { bf16* yp = Y + ((size_t)b * SEQ + (size_t)(c - 1) * 64 + 16 * I + 4 * q4) * D + GRP * 512 + h * 128 + 8 * l15;
#pragma unroll
                for (int reg = 0; reg < 4; ++reg) *(u32x4*)(yp + (size_t)reg * D) = yv[reg]; }
            if (c + 2 < SEQ / 64) SC_DMA(c + 2, (c + 2) % 3);
            bf16x8 qf[NS];
#pragma unroll
            for (int s2 = 0; s2 < NS; ++s2) qf[s2] = *(const LAS bf16x8*)(QR + (16 * I + l15) * QS + 32 * s2 + 8 * q4);
            f32x4 AT[4];
#pragma unroll
            for (int J = 0; J < 4; ++J) { f32x4 acc = (f32x4){0.f, 0.f, 0.f, 0.f};
                if (J <= I) {
#pragma unroll
                    for (int s2 = 0; s2 < NS; ++s2) { const bf16x8 kf = *(const LAS bf16x8*)(KR + (16 * J + l15) * QS + 32 * s2 + 8 * q4); acc = __builtin_amdgcn_mfma_f32_16x16x32_bf16(kf, qf[s2], acc, 0, 0, 0); }
                    if (J == I) {
#pragma unroll
                        for (int reg = 0; reg < 4; ++reg) acc[reg] = (4 * q4 + reg > l15) ? 0.f : acc[reg]; } }
                AT[J] = acc; }
            u32x4 aw[2];
#pragma unroll
            for (int sp = 0; sp < 2; ++sp) { aw[sp].x = cvtpk(AT[2 * sp][0], AT[2 * sp][1]); aw[sp].y = cvtpk(AT[2 * sp][2], AT[2 * sp][3]); aw[sp].z = cvtpk(AT[2 * sp + 1][0], AT[2 * sp + 1][1]); aw[sp].w = cvtpk(AT[2 * sp + 1][2], AT[2 * sp + 1][3]); }
            f32x4 o[8]; float ss[4] = {0.f, 0.f, 0.f, 0.f};
#pragma unroll
            for (int vt = 0; vt < 8; ++vt) { f32x4 oo = (f32x4){0.f, 0.f, 0.f, 0.f};
#pragma unroll
                for (int sp = 0; sp < 2; ++sp) if (2 * sp <= I) {
                    const u32x2 b0 = *(const LAS u32x2*)(VT + (16 * vt + l15) * VS + 32 * sp + 4 * q4), b1 = *(const LAS u32x2*)(VT + (16 * vt + l15) * VS + 32 * sp + 16 + 4 * q4);
                    u32x4 bw; bw.x = b0.x; bw.y = b0.y; bw.z = b1.x; bw.w = b1.y;
                    oo = __builtin_amdgcn_mfma_f32_16x16x32_bf16(__builtin_bit_cast(bf16x8, aw[sp]), __builtin_bit_cast(bf16x8, bw), oo, 0, 0, 0); }
#pragma unroll
                for (int s2 = 0; s2 < NS; ++s2) { const bf16x8 sf = *(const LAS bf16x8*)(SST + (16 * vt + l15) * QS + 32 * s2 + 8 * q4); oo = __builtin_amdgcn_mfma_f32_16x16x32_bf16(qf[s2], sf, oo, 0, 0, 0); }
                o[vt] = oo;
#pragma unroll
                for (int reg = 0; reg < 4; ++reg) ss[reg] += oo[reg] * oo[reg]; }
#pragma unroll
            for (int reg = 0; reg < 4; ++reg) { float t = ss[reg]; t += __shfl_xor(t, 1); t += __shfl_xor(t, 2); t += __shfl_xor(t, 4); t += __shfl_xor(t, 8); const float rs = rsqrtf(t * (1.f / 128.f) + EPS);
                const unsigned gw[4] = {pgc[reg].x, pgc[reg].y, pgc[reg].z, pgc[reg].w}; unsigned yw[4];
#pragma unroll
                for (int j = 0; j < 4; ++j) yw[j] = cvtpk(o[2 * j][reg] * rs * nw[2 * j] * bf2f(gw[j] & 0xffffu), o[2 * j + 1][reg] * rs * nw[2 * j + 1] * bf2f(gw[j] >> 16));
                yv[reg] = (u32x4){yw[0], yw[1], yw[2], yw[3]}; pgc[reg] = pgn[reg]; }
        }
        { bf16* yp = Y + ((size_t)b * SEQ + (size_t)(SEQ / 64 - 1) * 64 + 16 * I + 4 * q4) * D + GRP * 512 + h * 128 + 8 * l15;
#pragma unroll
          for (int reg = 0; reg < 4; ++reg) *(u32x4*)(yp + (size_t)reg * D) = yv[reg]; }
    } else {
        f32x4 S[NKT][8]; f32x4 tb[NKT][3];
#pragma unroll
        for (int a = 0; a < NKT; ++a)
#pragma unroll
            for (int vt = 0; vt < 8; ++vt) S[a][vt] = (f32x4){0.f, 0.f, 0.f, 0.f};
        SC_LOADT(0);
        SC_DMA(0, 0); SC_DMA(1, 1);
        for (int c = 0; c < SEQ / 64; ++c) {
            SC_TOP(c)
            float d63[NKT][4], e2[NKT][4];
#pragma unroll
            for (int a = 0; a < NKT; ++a) { const int kt = NKT * ws + a;
#pragma unroll
                for (int reg = 0; reg < 4; ++reg) { d63[a][reg] = tb[a][1][reg]; e2[a][reg] = tb[a][2][reg]; }
#pragma unroll
                for (int vt = 0; vt < 8; ++vt) { u32x2 w; w.x = cvtpk(tb[a][0][0] * S[a][vt][0], tb[a][0][1] * S[a][vt][1]); w.y = cvtpk(tb[a][0][2] * S[a][vt][2], tb[a][0][3] * S[a][vt][3]);
                    *(LAS u32x2*)(SST + (16 * vt + l15) * QS + 16 * kt + 4 * q4) = w; } }
            SC_BARL();
            if (c + 1 < SEQ / 64) { SC_LOADV(c + 1); SC_LOADT(c + 1); }
            if (c + 2 < SEQ / 64) SC_DMA(c + 2, (c + 2) % 3);
            bf16x8 af[NKT][2];
            s16x4 tt[NKT][2][2];
#pragma unroll
            for (int a = 0; a < NKT; ++a)
#pragma unroll
                for (int s2 = 0; s2 < 2; ++s2) { const LAS bf16* tp = KR + (32 * s2 + 8 * q4 + (l15 >> 2)) * QS + 16 * (NKT * ws + a) + 4 * (l15 & 3);
                    const unsigned ta = (unsigned)(unsigned long)tp;
                    asm volatile("ds_read_b64_tr_b16 %0, %1" : "=v"(tt[a][s2][0]) : "v"(ta) : "memory");
                    asm volatile("ds_read_b64_tr_b16 %0, %1 offset:%2" : "=v"(tt[a][s2][1]) : "v"(ta), "n"(4 * QS * 2) : "memory"); }
            if constexpr (NKT == 2) asm volatile("s_waitcnt lgkmcnt(0)" : "+v"(tt[0][0][0]), "+v"(tt[0][0][1]), "+v"(tt[0][1][0]), "+v"(tt[0][1][1]), "+v"(tt[1][0][0]), "+v"(tt[1][0][1]), "+v"(tt[1][1][0]), "+v"(tt[1][1][1]) :: "memory");
            else asm volatile("s_waitcnt lgkmcnt(0)" : "+v"(tt[0][0][0]), "+v"(tt[0][0][1]), "+v"(tt[0][1][0]), "+v"(tt[0][1][1]) :: "memory");
#pragma unroll
            for (int a = 0; a < NKT; ++a)
#pragma unroll
                for (int s2 = 0; s2 < 2; ++s2) { const s16x4 t0 = tt[a][s2][0], t1 = tt[a][s2][1]; af[a][s2] = (bf16x8){t0[0], t0[1], t0[2], t0[3], t1[0], t1[1], t1[2], t1[3]}; }
#pragma unroll
            for (int vt = 0; vt < 8; ++vt) { bf16x8 vf[2];
#pragma unroll
                for (int s2 = 0; s2 < 2; ++s2) vf[s2] = *(const LAS bf16x8*)(VT + (16 * vt + l15) * VS + 32 * s2 + 8 * q4);
#pragma unroll
                for (int a = 0; a < NKT; ++a) { f32x4 T = (f32x4){0.f, 0.f, 0.f, 0.f};
#pragma unroll
                    for (int s2 = 0; s2 < 2; ++s2) T = __builtin_amdgcn_mfma_f32_16x16x32_bf16(af[a][s2], vf[s2], T, 0, 0, 0);
#pragma unroll
                    for (int reg = 0; reg < 4; ++reg) S[a][vt][reg] = d63[a][reg] * S[a][vt][reg] + e2[a][reg] * T[reg]; } }
        }
    }
    SC_BAR();
#undef SC_TOP
#undef SC_WAITN
#undef SC_BARL
#undef SC_DMA
#undef SC_LOADV
#undef SC_LOADG
#undef SC_LOADT
}

#ifndef CVW_P2
#define CVW_P2 4
#endif
#ifndef SCAN_UNR
#define SCAN_UNR 8
#endif
#ifndef SCANV8
#define SCANV8 1
#endif
#if SCANV8
#define SCANFN scan128v8
#else
#define SCANFN scan128
#endif
template <int K, int GRP>
__device__ __forceinline__ void scan128v8(LAS unsigned char* lds, const bf16* PB, const unsigned char* blobs, bf16* Y, const float* onw, int b, int h, int tid, int lane, int wave) {
    typedef ScanGeo<K> GE; constexpr int QS = GE::QS, VS = GE::VS, NS = K / 32, NKT = K / 64, IMG = GE::BLOB, NDMA = (GE::BLOB / 8) / 1024 + 1;
    constexpr int PW = IMG / 8, NPF = PW / 1024, REM = (PW - NPF * 1024) / 16;
    LAS unsigned char* VTb = lds + 3 * IMG; LAS bf16* VT = (LAS bf16*)VTb; LAS bf16* SST = (LAS bf16*)(VTb + 128 * VS * 2);
    const int q4 = lane >> 4, l15 = lane & 15;
    const int vcol = (GRP == 0 ? C_HI : C_GV) + h * 128, gcol = (GRP == 0 ? C_HGATE : C_GGATE) + h * 128;
    const bool owave = wave < 4; const int I = wave & 3, ws = wave & 3;
    const int vrow = tid & 127, vv = 8 * (vrow & 15) + (vrow >> 4), jg = tid >> 7;
#define SC_DMA(c, buf) do { const unsigned char* src_ = blobs + (size_t)(c) * GE::BLOB + wave * PW + lane * 16; LAS unsigned char* dst_ = lds + (buf) * IMG + wave * PW; \
        _Pragma("unroll") for (int i_ = 0; i_ < NPF; ++i_) __builtin_amdgcn_global_load_lds((const unsigned*)(src_ + i_ * 1024), (LAS unsigned*)(dst_ + i_ * 1024), 16, 0, 0); \
        if (lane < REM) __builtin_amdgcn_global_load_lds((const unsigned*)(src_ + NPF * 1024), (LAS unsigned*)(dst_ + NPF * 1024), 16, 0, 0); } while (0)
#define SC_LOADV(c, pv) do { const size_t t0_ = (size_t)b * SEQ + (size_t)(c) * 64 + 16 * jg; _Pragma("unroll") for (int r_ = 0; r_ < 16; ++r_) pv[r_] = PB[(t0_ + r_) * PBW + vcol + vv]; } while (0)
#define SC_LOADG(c, dst) do { const size_t t0_ = (size_t)b * SEQ + (size_t)(c) * 64 + 16 * I + 4 * q4; _Pragma("unroll") for (int reg_ = 0; reg_ < 4; ++reg_) dst[reg_] = *(const u32x4*)(PB + (t0_ + reg_) * PBW + gcol + 8 * l15); } while (0)
#define SC_LOADT(c, tb) do { const float* tg_ = (const float*)(blobs + (size_t)(c) * GE::BLOB + GE::OFF_TAB); _Pragma("unroll") for (int a_ = 0; a_ < NKT; ++a_) _Pragma("unroll") for (int x_ = 0; x_ < 3; ++x_) tb[a_][x_] = *(const f32x4*)(tg_ + x_ * K + 16 * (NKT * ws + a_) + 4 * q4); } while (0)
#define SC_WAITN(n) asm volatile("s_waitcnt vmcnt(%0)" :: "n"(n) : "memory")
#define SC_BARL() do { asm volatile("s_waitcnt lgkmcnt(0)" ::: "memory"); __builtin_amdgcn_s_barrier(); asm volatile("" ::: "memory"); } while (0)
#define SC_TOP(c, pv, nwait) const int buf = (c) % 3; \
        LAS bf16* QR = (LAS bf16*)(lds + buf * IMG); LAS bf16* KR = (LAS bf16*)(lds + buf * IMG + GE::OFF_KR); (void)QR; (void)KR; \
        SC_WAITN(nwait);     \
        SC_BARL();       \
        SC_PIN(pv);      \
        { u32x4 w0, w1; \
          w0.x = pv[0] | ((unsigned)pv[1] << 16); w0.y = pv[2] | ((unsigned)pv[3] << 16); w0.z = pv[4] | ((unsigned)pv[5] << 16); w0.w = pv[6] | ((unsigned)pv[7] << 16); \
          w1.x = pv[8] | ((unsigned)pv[9] << 16); w1.y = pv[10] | ((unsigned)pv[11] << 16); w1.z = pv[12] | ((unsigned)pv[13] << 16); w1.w = pv[14] | ((unsigned)pv[15] << 16); \
          *(LAS u32x4*)(VT + vrow * VS + 16 * jg) = w0; *(LAS u32x4*)(VT + vrow * VS + 16 * jg + 8) = w1; }
    constexpr int NCH = SEQ / 64, UNR = SCAN_UNR;
#define SC_CL(c) ((c) < NCH ? (c) : NCH - 1)
    unsigned pvs[2][16];
    SC_LOADV(0, pvs[0]); SC_LOADV(1, pvs[1]);
    if (owave) {
        float nw[8]; u32x4 pgs[2][4], yv[4];
        constexpr int WOUT = 16 + 4 + 4 + NPF;
        { const f32x4 n0 = *(const f32x4*)(onw + 8 * l15), n1 = *(const f32x4*)(onw + 8 * l15 + 4); nw[0] = n0[0]; nw[1] = n0[1]; nw[2] = n0[2]; nw[3] = n0[3]; nw[4] = n1[0]; nw[5] = n1[1]; nw[6] = n1[2]; nw[7] = n1[3]; }
        SC_LOADG(0, pgs[0]); SC_LOADG(1, pgs[1]);
        SC_DMA(0, 0); SC_DMA(1, 1);
#pragma unroll
        for (int reg = 0; reg < 4; ++reg) yv[reg] = (u32x4){0u, 0u, 0u, 0u};
        SC_WAITN(0);
        for (int c0 = 0; c0 < NCH; c0 += UNR) {
#pragma unroll
          for (int j = 0; j < UNR; ++j) { int c = c0 + j; asm volatile("" : "+s"(c)); const int par = j & 1;
            const int c2 = c + 2 < NCH ? c + 2 : NCH - 1;
            SC_TOP(c, pvs[par], WOUT)
            SC_BARL();
            SC_LOADV(c2, pvs[par]);
            { bf16* yp = Y + ((size_t)b * SEQ + (size_t)(c > 0 ? c - 1 : 0) * 64 + 16 * I + 4 * q4) * D + GRP * 512 + h * 128 + 8 * l15;
#pragma unroll
                for (int reg = 0; reg < 4; ++reg) *(u32x4*)(yp + (size_t)reg * D) = yv[reg]; }
            SC_DMA(c2, (c + 2) % 3);
            bf16x8 qf[NS];
#pragma unroll
            for (int s2 = 0; s2 < NS; ++s2) qf[s2] = *(const LAS bf16x8*)(QR + (16 * I + l15) * QS + 32 * s2 + 8 * q4);
            f32x4 AT[4];
#pragma unroll
            for (int J = 0; J < 4; ++J) { f32x4 acc = (f32x4){0.f, 0.f, 0.f, 0.f};
                if (J <= I) {
#pragma unroll
                    for (int s2 = 0; s2 < NS; ++s2) { const bf16x8 kf = *(const LAS bf16x8*)(KR + (16 * J + l15) * QS + 32 * s2 + 8 * q4); acc = __builtin_amdgcn_mfma_f32_16x16x32_bf16(kf, qf[s2], acc, 0, 0, 0); }
                    if (J == I) {
#pragma unroll
                        for (int reg = 0; reg < 4; ++reg) acc[reg] = (4 * q4 + reg > l15) ? 0.f : acc[reg]; } }
                AT[J] = acc; }
            u32x4 aw[2];
#pragma unroll
            for (int sp = 0; sp < 2; ++sp) { aw[sp].x = cvtpk(AT[2 * sp][0], AT[2 * sp][1]); aw[sp].y = cvtpk(AT[2 * sp][2], AT[2 * sp][3]); aw[sp].z = cvtpk(AT[2 * sp + 1][0], AT[2 * sp + 1][1]); aw[sp].w = cvtpk(AT[2 * sp + 1][2], AT[2 * sp + 1][3]); }
            f32x4 o[8]; float ss[4] = {0.f, 0.f, 0.f, 0.f};
#pragma unroll
            for (int vt = 0; vt < 8; ++vt) { f32x4 oo = (f32x4){0.f, 0.f, 0.f, 0.f};
#pragma unroll
                for (int sp = 0; sp < 2; ++sp) if (2 * sp <= I) {
                    const u32x2 b0 = *(const LAS u32x2*)(VT + (16 * vt + l15) * VS + 32 * sp + 4 * q4), b1 = *(const LAS u32x2*)(VT + (16 * vt + l15) * VS + 32 * sp + 16 + 4 * q4);
                    u32x4 bw; bw.x = b0.x; bw.y = b0.y; bw.z = b1.x; bw.w = b1.y;
                    oo = __builtin_amdgcn_mfma_f32_16x16x32_bf16(__builtin_bit_cast(bf16x8, aw[sp]), __builtin_bit_cast(bf16x8, bw), oo, 0, 0, 0); }
#pragma unroll
                for (int s2 = 0; s2 < NS; ++s2) { const bf16x8 sf = *(const LAS bf16x8*)(SST + (16 * vt + l15) * QS + 32 * s2 + 8 * q4); oo = __builtin_amdgcn_mfma_f32_16x16x32_bf16(qf[s2], sf, oo, 0, 0, 0); }
                o[vt] = oo;
#pragma unroll
                for (int reg = 0; reg < 4; ++reg) ss[reg] += oo[reg] * oo[reg]; }
#pragma unroll
            for (int reg = 0; reg < 4; ++reg) { float t = ss[reg]; t += __shfl_xor(t, 1); t += __shfl_xor(t, 2); t += __shfl_xor(t, 4); t += __shfl_xor(t, 8); const float rs = rsqrtf(t * (1.f / 128.f) + EPS);
                const unsigned gw[4] = {pgs[par][reg].x, pgs[par][reg].y, pgs[par][reg].z, pgs[par][reg].w}; unsigned yw[4];
#pragma unroll
                for (int j = 0; j < 4; ++j) yw[j] = cvtpk(o[2 * j][reg] * rs * nw[2 * j] * bf2f(gw[j] & 0xffffu), o[2 * j + 1][reg] * rs * nw[2 * j + 1] * bf2f(gw[j] >> 16));
                yv[reg] = (u32x4){yw[0], yw[1], yw[2], yw[3]}; }
            SC_LOADG(c2, pgs[par]);
          }
        }
        { bf16* yp = Y + ((size_t)b * SEQ + (size_t)(SEQ / 64 - 1) * 64 + 16 * I + 4 * q4) * D + GRP * 512 + h * 128 + 8 * l15;
#pragma unroll
          for (int reg = 0; reg < 4; ++reg) *(u32x4*)(yp + (size_t)reg * D) = yv[reg]; }
    } else {
        f32x4 S[NKT][8];
        constexpr int WST = 16 + NPF;
#pragma unroll
        for (int a = 0; a < NKT; ++a)
#pragma unroll
            for (int vt = 0; vt < 8; ++vt) S[a][vt] = (f32x4){0.f, 0.f, 0.f, 0.f};
        SC_DMA(0, 0); SC_DMA(1, 1);
        SC_WAITN(0);
        for (int c0 = 0; c0 < NCH; c0 += UNR) {
#pragma unroll
          for (int j = 0; j < UNR; ++j) { int c = c0 + j; asm volatile("" : "+s"(c)); const int par = j & 1;
            const int c2 = c + 2 < NCH ? c + 2 : NCH - 1;
            SC_TOP(c, pvs[par], WST)
            f32x4 tbl[NKT][3];
            { const LAS float* tg = (const LAS float*)(lds + buf * IMG + GE::OFF_TAB);
#pragma unroll
              for (int a = 0; a < NKT; ++a)
#pragma unroll
                  for (int x = 0; x < 3; ++x) tbl[a][x] = *(const LAS f32x4*)(tg + x * K + 16 * (NKT * ws + a) + 4 * q4); }
            float d63[NKT][4], e2[NKT][4];
#pragma unroll
            for (int a = 0; a < NKT; ++a) { const int kt = NKT * ws + a;
#pragma unroll
                for (int reg = 0; reg < 4; ++reg) { d63[a][reg] = tbl[a][1][reg]; e2[a][reg] = tbl[a][2][reg]; }
#pragma unroll
                for (int vt = 0; vt < 8; ++vt) { u32x2 w; w.x = cvtpk(tbl[a][0][0] * S[a][vt][0], tbl[a][0][1] * S[a][vt][1]); w.y = cvtpk(tbl[a][0][2] * S[a][vt][2], tbl[a][0][3] * S[a][vt][3]);
                    *(LAS u32x2*)(SST + (16 * vt + l15) * QS + 16 * kt + 4 * q4) = w; } }
            SC_BARL();
            SC_LOADV(c2, pvs[par]);
            SC_DMA(c2, (c + 2) % 3);
            bf16x8 af[NKT][2];
            s16x4 tt[NKT][2][2];
#pragma unroll
            for (int a = 0; a < NKT; ++a)
#pragma unroll
                for (int s2 = 0; s2 < 2; ++s2) { const LAS bf16* tp = KR + (32 * s2 + 8 * q4 + (l15 >> 2)) * QS + 16 * (NKT * ws + a) + 4 * (l15 & 3);
                    const unsigned ta = (unsigned)(unsigned long)tp;
                    asm volatile("ds_read_b64_tr_b16 %0, %1" : "=v"(tt[a][s2][0]) : "v"(ta) : "memory");
                    asm volatile("ds_read_b64_tr_b16 %0, %1 offset:%2" : "=v"(tt[a][s2][1]) : "v"(ta), "n"(4 * QS * 2) : "memory"); }
            if constexpr (NKT == 2) asm volatile("s_waitcnt lgkmcnt(0)" : "+v"(tt[0][0][0]), "+v"(tt[0][0][1]), "+v"(tt[0][1][0]), "+v"(tt[0][1][1]), "+v"(tt[1][0][0]), "+v"(tt[1][0][1]), "+v"(tt[1][1][0]), "+v"(tt[1][1][1]) :: "memory");
            else asm volatile("s_waitcnt lgkmcnt(0)" : "+v"(tt[0][0][0]), "+v"(tt[0][0][1]), "+v"(tt[0][1][0]), "+v"(tt[0][1][1]) :: "memory");
#pragma unroll
            for (int a = 0; a < NKT; ++a)
#pragma unroll
                for (int s2 = 0; s2 < 2; ++s2) { const s16x4 t0 = tt[a][s2][0], t1 = tt[a][s2][1]; af[a][s2] = (bf16x8){t0[0], t0[1], t0[2], t0[3], t1[0], t1[1], t1[2], t1[3]}; }
#pragma unroll
            for (int vt = 0; vt < 8; ++vt) { bf16x8 vf[2];
#pragma unroll
                for (int s2 = 0; s2 < 2; ++s2) vf[s2] = *(const LAS bf16x8*)(VT + (16 * vt + l15) * VS + 32 * s2 + 8 * q4);
#pragma unroll
                for (int a = 0; a < NKT; ++a) { f32x4 T = (f32x4){0.f, 0.f, 0.f, 0.f};
#pragma unroll
                    for (int s2 = 0; s2 < 2; ++s2) T = __builtin_amdgcn_mfma_f32_16x16x32_bf16(af[a][s2], vf[s2], T, 0, 0, 0);
#pragma unroll
                    for (int reg = 0; reg < 4; ++reg) S[a][vt][reg] = d63[a][reg] * S[a][vt][reg] + e2[a][reg] * T[reg]; } }
          }
        }
    }
    SC_BAR();
#undef SC_TOP
#undef SC_CL
#undef SC_WAITN
#undef SC_BARL
#undef SC_DMA
#undef SC_LOADV
#undef SC_LOADG
#undef SC_LOADT
}

__device__ __forceinline__ void rms_2rows_to_bf16(const float* __restrict__ x0, const float* __restrict__ x1, const float* __restrict__ w, bf16* __restrict__ o0, bf16* __restrict__ o1, int lane) {
    const f32x4* xa = (const f32x4*)x0 + lane; const f32x4* xb = (const f32x4*)x1 + lane;
    f32x4 va[4], vb[4]; float sa = 0.f, sb = 0.f;
#pragma unroll
    for (int j = 0; j < 4; ++j) { va[j] = xa[64 * j]; vb[j] = xb[64 * j]; }
#pragma unroll
    for (int j = 0; j < 4; ++j) { sa += (va[j].x * va[j].x + va[j].y * va[j].y) + (va[j].z * va[j].z + va[j].w * va[j].w); sb += (vb[j].x * vb[j].x + vb[j].y * vb[j].y) + (vb[j].z * vb[j].z + vb[j].w * vb[j].w); }
    const float ra = rsqrtf(wave_sum(sa) * (1.f / D) + EPS), rb = rsqrtf(wave_sum(sb) * (1.f / D) + EPS);
    u32x2* pa = (u32x2*)o0 + lane; u32x2* pb = (u32x2*)o1 + lane;
#pragma unroll
    for (int j = 0; j < 4; ++j) { const f32x4 ww = ((const f32x4*)w)[lane + 64 * j]; u32x2 o; o.x = pk2(va[j].x * ra * ww.x, va[j].y * ra * ww.y); o.y = pk2(va[j].z * ra * ww.z, va[j].w * ra * ww.w); pa[64 * j] = o;
        o.x = pk2(vb[j].x * rb * ww.x, vb[j].y * rb * ww.y); o.y = pk2(vb[j].z * rb * ww.z, vb[j].w * rb * ww.w); pb[64 * j] = o; }
}
__global__ void __launch_bounds__(NWAVES * 64, 2) mega_fwd(Args args) {
    extern __shared__ __attribute__((aligned(16))) unsigned char lds_raw[];
    LAS unsigned char* lds = (LAS unsigned char*)lds_raw;
    volatile LAS unsigned* MISC = (volatile LAS unsigned*)(lds + MISC_OFF);
    const int tid0 = threadIdx.x, wave = __builtin_amdgcn_readfirstlane(tid0 >> 6);
    const int G = gridDim.x, bx = blockIdx.x;
    const int vcu = (G % 8 == 0) ? (bx % 8) * (G / 8) + bx / 8 : bx;
    unsigned char* ws = args.ws;
    unsigned* ctl = (unsigned*)(ws + WS_CTL);
    for (int u = tid0; u < (LDS_BYTES - LDSCTL_OFF) / 4; u += NWAVES * 64) ((LAS unsigned*)(lds + LDSCTL_OFF))[u] = 0u;
    __syncthreads();
    XcdBarrier bar = xcd_barrier_post(ctl + CW_BAR + args.li * XCD_BAR_WORDS, MISC + 8);
    const int lo = args.ph_lo, hi = args.ph_hi;
#define IN(k) (lo <= (k) && (k) < hi)
#define SEAM(k) do { if (IN(k) && IN((k) + 1)) xcd_barrier(bar, wave == 0 && fresh_lane() == 0); } while (0)
    const float* x = args.in[0]; const float* mem = args.in[1]; const float* norm_mix_w = args.in[2]; const float* w_in = args.in[3]; const float* lb_logits = args.in[4];
    const float* norm_xa_w = args.in[10]; const float* norm_moe_w = args.in[15];
    const float* w_gk2 = args.in[6]; const float* b_gk = args.in[7]; const float* w_out = args.in[9]; const float* norm_mem_w = args.in[11];
    const float* w_xq = args.in[12]; const float* w_xkv = args.in[13]; const float* w_xo = args.in[14]; const float* w_gu = args.in[18]; const float* w_down = args.in[20];
    float* LB = (float*)(ws + WS_TAB + OFF_LB);
    bf16* WT_IN = (bf16*)(ws + WS_WT_IN); bf16* WT_OUT = (bf16*)(ws + WS_WT_OUT); bf16* WT_XQ = (bf16*)(ws + WS_WT_XQ); bf16* WT_XKV = (bf16*)(ws + WS_WT_XKV); bf16* WT_XO = (bf16*)(ws + WS_WT_XO);
    bf16* WT_GU = (bf16*)(ws + WS_WT_GU); bf16* WT_DN = (bf16*)(ws + WS_WT_DN);
    bf16* PB = (bf16*)(ws + WS_PB); _Float16* Gd = (_Float16*)(ws + WS_G); bf16* HB = (bf16*)(ws + WS_HB); bf16* HMB = (bf16*)(ws + WS_HMB); bf16* KB = (bf16*)(ws + WS_KB); bf16* VT = (bf16*)(ws + WS_VT);

    if (IN(0)) { const int lane = fresh_lane(), tid = wave * 64 + lane; (void)tid;
        LAS float* scr = (LAS float*)(lds + RING_OFF + wave * 16384);
        const int gw = vcu * NWAVES + wave, NGW = G * NWAVES;
        constexpr int I_IN = 16 * (PBW / 32), I_SQ = 16 * 32, I_KV = 16 * 64;
        constexpr int NITEMS = I_IN + 3 * I_SQ + I_KV;
        for (int it = gw; it < NITEMS; it += NGW) {
            int r = it;
            if (r < I_IN) { const int nb = r % (PBW / 32), kb = r / (PBW / 32); p0_transpose_item(w_in, INW, WT_IN, nb * 32, nb * 32, kb * 64, scr, lane); continue; } r -= I_IN;
            if (r < I_SQ) { const int nb = r & 31, kb = r >> 5; p0_transpose_item(w_out, D, WT_OUT, nb * 32, nb * 32, kb * 64, scr, lane); continue; } r -= I_SQ;
            if (r < I_SQ) { const int nb = r & 31, kb = r >> 5; p0_transpose_item(w_xq, D, WT_XQ, nb * 32, nb * 32, kb * 64, scr, lane, norm_xa_w); continue; } r -= I_SQ;
            if (r < I_SQ) { const int nb = r & 31, kb = r >> 5; p0_transpose_item(w_xo, D, WT_XO, nb * 32, nb * 32, kb * 64, scr, lane); continue; } r -= I_SQ;
            { const int nb = r & 63, kb = r >> 6; p0_transpose_item(w_xkv, 2048, WT_XKV, nb * 32, nb * 32, kb * 64, scr, lane); }
        }
        for (int it = gw; it < 256 * 16; it += NGW) { const int n = it >> 4, k = (it & 15) * 64 + lane; float s = 0.f;
#pragma unroll
            for (int r = 0; r < 16; ++r) s += w_in[(size_t)k * INW + C_GLR + r] * w_gk2[r * 256 + n];
            WT_IN[(size_t)(C_GLR + n) * D + k] = (bf16)f2bf(s); }
        if (bx == 0) { const int j = tid; LB[j] = 1.f / (1.f + __expf(lb_logits[512 + j] - lb_logits[j])); }
        for (int m = gw; m < NTOK; m += 2 * NGW) rms_2rows_to_bf16(x + (size_t)m * D, x + (size_t)(m + NGW) * D, norm_mix_w, HB + (size_t)m * D, HB + (size_t)(m + NGW) * D, lane);
        for (int m = gw; m < NMEM; m += NGW) rms_row_to_bf16(mem + (size_t)m * D, norm_mem_w, HMB + (size_t)m * D, lane);
    }
    SEAM(0);
    if (IN(1)) { const int lane = fresh_lane(), tid = wave * 64 + lane; (void)tid;
        pg8::SchedP1 S{(const char*)HB, (const char*)WT_IN, (const char*)HMB, (const char*)WT_XKV, G, bx};
        pg8::EpiP1 E{PB, Gd, KB, VT, LB, b_gk};
        pg8::gemm_phase<pg8::EpiP1, pg8::SchedP1>(lds + RING_OFF, S, E, tid, wave);
    }
    SEAM(1);

    const float* hg_onorm_w = args.in[5]; const float* gla_onorm_w = args.in[8];
    const float* w_router = args.in[16]; const float* b_router = args.in[17]; const float* b_gu = args.in[19]; const float* b_down = args.in[21]; const float* norm_final_w = args.in[22];
    bf16* Y = (bf16*)(ws + WS_Y); bf16* Q = (bf16*)(ws + WS_Q); bf16* AO = (bf16*)(ws + WS_AO); float* X1 = (float*)(ws + WS_X1);
    bf16* XG = (bf16*)(ws + WS_XG); bf16* ACT = (bf16*)(ws + WS_ACT); bf16* YB = (bf16*)(ws + WS_YB);
    int* tok_e = (int*)(ws + WS_TOKE); float* tok_g = (float*)(ws + WS_TOKG); int* tok_dest = (int*)(ws + WS_TOKDEST); float* row_gate = (float*)(ws + WS_ROWGATE);
    float* SSQ1 = (float*)(ws + WS_SSQ); float* tok_rstd = (float*)(ws + WS_TOKRSTD); float* row_rstd = (float*)(ws + WS_ROWRSTD);
    unsigned char* HB8 = ws + WS_XG; int* row_tok = (int*)(ws + WS_XG + 32 * MiB);
    int* HIST = (int*)(ws + WS_TAB + OFF_HIST); int* tile_e = (int*)(ws + WS_TAB + OFF_TILEE); int* nrt_p = (int*)(ws + WS_TAB + OFF_NRT);
    if (IN(2)) { const int lane = fresh_lane(), tid = wave * 64 + lane; (void)tid;
        unsigned char* blobs = ws + WS_YB;
        {
            float gA[16]; unsigned short qA[16], kA[16]; float gB[8]; unsigned short qB[8], kB[8];
            { const int sq = vcu & 31, c = vcu >> 5; prep_load<128, 0>(gA, qA, kA, PB, Gd, sq >> 2, sq & 3, c, tid); }
#pragma unroll 1
            for (int j = 0; j < 4; ++j) { const int rest = j * 256 + vcu, sq = rest & 31, c = rest >> 5;
                prep_p1<128>(gA, qA, kA, lds + RING_OFF, tid);
                prep_load<64, 1>(gB, qB, kB, PB, Gd, sq >> 2, sq & 3, c, tid);
                prep_p2<128>(lds + RING_OFF, blobs + blob_off(0, sq >> 2, sq & 3, c), tid);
                prep_p1<64>(gB, qB, kB, lds + RING_OFF, tid);
                if (j < 3) { const int rest2 = (j + 1) * 256 + vcu, sq2 = rest2 & 31, c2 = rest2 >> 5; prep_load<128, 0>(gA, qA, kA, PB, Gd, sq2 >> 2, sq2 & 3, c2, tid); }
                prep_p2<64>(lds + RING_OFF, blobs + blob_off(1, sq >> 2, sq & 3, c), tid); }
            asm volatile("s_waitcnt vmcnt(0)" ::: "memory");
        }
        xcd_barrier(bar, wave == 0 && fresh_lane() == 0);
        if ((vcu & 3) == 0) { const int sidx = vcu >> 2, grp = sidx >> 5, sq = sidx & 31;
            if (grp == 0) SCANFN<128, 0>(lds + RING_OFF, PB, blobs + blob_off(0, sq >> 2, sq & 3, 0), Y, hg_onorm_w, sq >> 2, sq & 3, tid, lane, wave);
            else SCANFN<64, 1>(lds + RING_OFF, PB, blobs + blob_off(1, sq >> 2, sq & 3, 0), Y, gla_onorm_w, sq >> 2, sq & 3, tid, lane, wave); }
        else {
            LAS float* scr = (LAS float*)(lds + RING_OFF + wave * 16384);
            constexpr int I_GU = 16 * 64, I_DN = 16 * 32;
            constexpr int CVW = CVW_P2;
            const int cidx = (vcu >> 2) * 3 + (vcu & 3) - 1, gw = wave < CVW ? cidx * CVW + wave : (1 << 30), NGW = 192 * CVW;
#define CV_DECODE(it, W_, ldw_, WT_, dr_, n0_, k0_, ks_) const float* W_; int ldw_, dr_, n0_, k0_; bf16* WT_; const float* ks_; { const int e_ = (it) / (I_GU + I_DN); int r_ = (it) - e_ * (I_GU + I_DN); \
                if (r_ < I_GU) { const int nb_ = r_ & 63, kb_ = r_ >> 6; W_ = w_gu + (size_t)e_ * D * 2048; ldw_ = 2048; WT_ = (bf16*)((unsigned char*)WT_GU + (size_t)e_ * 2048 * D * (MOE_FP8 ? 1 : 2)); dr_ = gu_rowmap(nb_ * 32); n0_ = nb_ * 32; k0_ = kb_ * 64; ks_ = norm_moe_w; } \
                else { r_ -= I_GU; const int nb_ = r_ & 31, kb_ = r_ >> 5; W_ = w_down + (size_t)e_ * D * D; ldw_ = D; WT_ = (bf16*)((unsigned char*)WT_DN + (size_t)e_ * D * D * (MOE_FP8 ? 1 : 2)); dr_ = nb_ * 32; n0_ = nb_ * 32; k0_ = kb_ * 64; ks_ = nullptr; } }
            constexpr int NIT = NEXP * (I_GU + I_DN);
            float ra[32], rb[32];
            int it = gw;
            if (it < NIT) { CV_DECODE(it, W0, l0, T0, d0, n0, k0, s0) (void)T0; (void)d0; (void)s0; p0_item_load(ra, W0, l0, n0, k0, lane); }
            while (it < NIT) {
                const int it2 = it + NGW;
                if (it2 < NIT) { CV_DECODE(it2, W1, l1, T1, d1, n1, k1, s1) (void)T1; (void)d1; (void)s1; p0_item_load(rb, W1, l1, n1, k1, lane); }
                { CV_DECODE(it, W0, l0, T0, d0, n0, k0, s0) (void)W0; (void)l0; (void)n0; p0_item_finish(ra, T0, d0, k0, scr, lane, s0); }
                if (it2 >= NIT) break;
                const int it3 = it2 + NGW;
                if (it3 < NIT) { CV_DECODE(it3, W0, l0, T0, d0, n0, k0, s0) (void)T0; (void)d0; (void)s0; p0_item_load(ra, W0, l0, n0, k0, lane); }
                { CV_DECODE(it2, W1, l1, T1, d1, n1, k1, s1) (void)W1; (void)l1; (void)n1; p0_item_finish(rb, T1, d1, k1, scr, lane, s1); }
                it = it3;
            }
#undef CV_DECODE
        }
    }
    SEAM(2);
    if (IN(3)) { const int lane = fresh_lane(), tid = wave * 64 + lane; (void)tid;
        pg8::SchedDense S{(const char*)Y, (const char*)WT_OUT, 64, 4, G, bx};
        pg8::EpiRes1 E{x, HB, SSQ1};
        pg8::gemm_phase<pg8::EpiRes1, pg8::SchedDense>(lds + RING_OFF, S, E, tid, wave);
    }
    SEAM(3);
    if (IN(5)) { const int lane = fresh_lane(), tid = wave * 64 + lane; (void)tid;
        pg8::SchedDense S{(const char*)HB, (const char*)WT_XQ, 64, 4, G, bx};
        pg8::EpiBf16S E{Q, 0.0625f, SSQ1};
        pg8::gemm_phase<pg8::EpiBf16S, pg8::SchedDense>(lds + RING_OFF, S, E, tid, wave);
        if (bx < 256) { int pm, pn; pg8::static_tile(bx, 64, 4, pm, pn);
            attn_unit(lds + RING_OFF, Q, KB, VT, AO, pm >> 3, pn, pm & 7, lane, wave); }
    }
    SEAM(6);
    if (IN(7)) { const int lane = fresh_lane(), tid = wave * 64 + lane; (void)tid;
        pg8::SchedDense S{(const char*)AO, (const char*)WT_XO, 64, 4, G, bx};
        pg8::EpiRes2 E{HB, MOE_FP8 ? HB8 : nullptr};
        pg8::gemm_phase<pg8::EpiRes2, pg8::SchedDense>(lds + RING_OFF, S, E, tid, wave);
    }
    SEAM(7);
    if (IN(8)) { const int lane = fresh_lane(), tid = wave * 64 + lane; (void)tid;
        LAS float* part = (LAS float*)(lds + RING_OFF);
        LAS float* ssqp = part + 8 * 2 * 32 * 32;
        LAS float* LG = ssqp + 8 * 64;
        LAS float* RSD = LG + 64 * 33;
        LAS int* hist = (LAS int*)(lds + LDSCTL_OFF);
        if (tid < 32) hist[tid] = 0;
        const float my_br = b_router[tid & 31];
        {
            const int r = lane & 31, hh = lane >> 5;
            u32x4 xw2[2][8];
#pragma unroll
            for (int tt = 0; tt < 2; ++tt) { const bf16* xp = HB + (size_t)(vcu * 64 + 32 * tt + r) * D + 128 * wave + 8 * hh;
#pragma unroll
                for (int s2 = 0; s2 < 8; ++s2) xw2[tt][s2] = *(const u32x4*)(xp + 16 * s2); }
            u32x4 bh[8], bl[8];
#pragma unroll
            for (int s2 = 0; s2 < 8; ++s2) { const int k0 = 128 * wave + 16 * s2 + 8 * hh; float wv[8];
                const f32x4 n0 = *(const f32x4*)(norm_moe_w + k0), n1 = *(const f32x4*)(norm_moe_w + k0 + 4);
#pragma unroll
                for (int j = 0; j < 8; ++j) wv[j] = w_router[(size_t)(k0 + j) * 32 + r] * (j < 4 ? n0[j] : n1[j - 4]);
                unsigned hw[4], lw[4];
#pragma unroll
                for (int j = 0; j < 4; ++j) { hw[j] = cvtpk(wv[2 * j], wv[2 * j + 1]); lw[j] = cvtpk(wv[2 * j] - bf2f(hw[j] & 0xffffu), wv[2 * j + 1] - bf2f(hw[j] >> 16)); }
                bh[s2] = (u32x4){hw[0], hw[1], hw[2], hw[3]}; bl[s2] = (u32x4){lw[0], lw[1], lw[2], lw[3]}; }
#pragma unroll
            for (int tt = 0; tt < 2; ++tt) { f32x16 acc; float ss = 0.f;
#pragma unroll
                for (int e = 0; e < 16; ++e) acc[e] = 0.f;
#pragma unroll
                for (int s2 = 0; s2 < 8; ++s2) { const u32x4 xw = xw2[tt][s2];
                    const float x0 = bf2f(xw.x & 0xffffu), x1 = bf2f(xw.x >> 16), x2 = bf2f(xw.y & 0xffffu), x3 = bf2f(xw.y >> 16), x4 = bf2f(xw.z & 0xffffu), x5 = bf2f(xw.z >> 16), x6 = bf2f(xw.w & 0xffffu), x7 = bf2f(xw.w >> 16);
                    ss += ((x0 * x0 + x1 * x1) + (x2 * x2 + x3 * x3)) + ((x4 * x4 + x5 * x5) + (x6 * x6 + x7 * x7));
                    const bf16x8 ah = __builtin_bit_cast(bf16x8, xw);
                    acc = __builtin_amdgcn_mfma_f32_32x32x16_bf16(ah, __builtin_bit_cast(bf16x8, bh[s2]), acc, 0, 0, 0);
                    acc = __builtin_amdgcn_mfma_f32_32x32x16_bf16(ah, __builtin_bit_cast(bf16x8, bl[s2]), acc, 0, 0, 0); }
#pragma unroll
                for (int reg = 0; reg < 16; ++reg) part[((wave * 2 + tt) * 32 + (reg & 3) + 8 * (reg >> 2) + 4 * hh) * 32 + r] = acc[reg];
                ss += __shfl_xor(ss, 32);
                if (hh == 0) ssqp[wave * 64 + 32 * tt + r] = ss; }
        }
        __syncthreads();
#pragma unroll
        for (int o = 0; o < 4; ++o) { const int idx = tid + 512 * o, tok = idx >> 5, e = idx & 31, tt = tok >> 5, tl = tok & 31; float sum = 0.f, sq = 0.f;
#pragma unroll
            for (int w = 0; w < 8; ++w) { sum += part[((w * 2 + tt) * 32 + tl) * 32 + e]; sq += ssqp[w * 64 + tok]; }
            const float rs = rsqrtf(sq * (1.f / D) + EPS);
            LG[tok * 33 + e] = sum * rs + my_br; if (e == 0) RSD[tok] = rs; }
        __syncthreads();
        if (wave == 0) {
            const int tok = vcu * 64 + lane; float l[32];
#pragma unroll
            for (int i = 0; i < 32; ++i) l[i] = LG[lane * 33 + i];
            int idx[4]; float val[4]; unsigned used = 0u;
#pragma unroll
            for (int k = 0; k < 4; ++k) { float best = -INFINITY; int bi = 0;
#pragma unroll
                for (int i = 0; i < 32; ++i) { const bool ok = !((used >> i) & 1u) && (l[i] > best); best = ok ? l[i] : best; bi = ok ? i : bi; }
                used |= 1u << bi; idx[k] = bi; val[k] = best; }
            float e4[4], es = 0.f;
#pragma unroll
            for (int k = 0; k < 4; ++k) { e4[k] = __expf(val[k] - val[0]); es += e4[k]; }
            const float ri = 1.f / es;
            *(int4*)(tok_e + tok * 4) = make_int4(idx[0], idx[1], idx[2], idx[3]);
            *(f32x4*)(tok_g + tok * 4) = (f32x4){e4[0] * ri, e4[1] * ri, e4[2] * ri, e4[3] * ri};
#pragma unroll
            for (int k = 0; k < 4; ++k) __hip_atomic_fetch_add(&hist[idx[k]], 1, __ATOMIC_RELAXED, __HIP_MEMORY_SCOPE_WORKGROUP);
        }
        if (tid < 64) tok_rstd[vcu * 64 + tid] = RSD[tid];
        __syncthreads();
        if (tid < 32) { HIST[vcu * 32 + tid] = hist[tid]; }
        __syncthreads();
        if (tid < 32) hist[tid] = 0;
    }
    SEAM(8);
    if (IN(9)) { const int lane = fresh_lane(), tid = wave * 64 + lane; (void)tid;
        LAS int* part = (LAS int*)(lds + RING_OFF);
        LAS int* base = part + 1024; LAS int* ea = base + 64; LAS int* dsts = ea + 256;
        int my_e = 0; float my_g = 0.f, my_rs = 0.f;
        if (tid < 256) { my_e = tok_e[vcu * 256 + tid]; my_g = tok_g[vcu * 256 + tid]; my_rs = tok_rstd[vcu * 64 + (tid >> 2)]; }
        { const int e = tid & 31, g = tid >> 5; int tot = 0, bef = 0;
#pragma unroll
            for (int w = 16 * g; w < 16 * g + 16; ++w) { const int h = HIST[w * 32 + e]; tot += h; bef += (w < vcu) ? h : 0; }
            part[g * 32 + e] = tot; part[512 + g * 32 + e] = bef; }
        if (tid < 256) ea[tid] = my_e;
        __syncthreads();
        if (tid < 32) { int tot = 0, bef = 0;
#pragma unroll
            for (int g = 0; g < 16; ++g) { tot += part[g * 32 + tid]; bef += part[512 + g * 32 + tid]; }
            const int nt = (tot + MOEB - 1) / MOEB; int inc = nt;
#pragma unroll
            for (int o = 1; o < 32; o <<= 1) { const int t = __shfl_up(inc, o); inc += (lane >= o) ? t : 0; }
            const int st = inc - nt;
            base[tid] = st * MOEB + bef;
            if (bx == 0) { for (int t = 0; t < nt; ++t) tile_e[st + t] = tid; if (tid == 31) *nrt_p = inc; } }
        __syncthreads();
        if (tid < 256) { const int e = my_e; int rank = 0; for (int a = 0; a < tid; ++a) rank += (ea[a] == e) ? 1 : 0;
            const int dest = base[e] + rank; dsts[tid] = dest; row_gate[dest] = my_g; row_rstd[dest] = my_rs; tok_dest[vcu * 256 + tid] = dest;
            if (MOE_FP8) row_tok[dest] = vcu * 64 + (tid >> 2); }
        if (!MOE_FP8) __syncthreads();
        if (!MOE_FP8)
        for (int tt = 0; tt < 8; ++tt) { const int ti = wave * 8 + tt, tok = vcu * 64 + ti;
            const u32x4* src = (const u32x4*)(HB + (size_t)tok * D); const u32x4 a = src[lane], b = src[lane + 64];
            if (MOE_FP8) { if (lane < 4) row_tok[dsts[ti * 4 + lane]] = tok; continue; }
            if (false) { u32x2 a8, b8;
                a8.x = pk4_fp8(bf2f(a.x & 0xffffu), bf2f(a.x >> 16), bf2f(a.y & 0xffffu), bf2f(a.y >> 16)); a8.y = pk4_fp8(bf2f(a.z & 0xffffu), bf2f(a.z >> 16), bf2f(a.w & 0xffffu), bf2f(a.w >> 16));
                b8.x = pk4_fp8(bf2f(b.x & 0xffffu), bf2f(b.x >> 16), bf2f(b.y & 0xffffu), bf2f(b.y >> 16)); b8.y = pk4_fp8(bf2f(b.z & 0xffffu), bf2f(b.z >> 16), bf2f(b.w & 0xffffu), bf2f(b.w >> 16));
#pragma unroll
                for (int k = 0; k < 4; ++k) { u32x2* dst = (u32x2*)((unsigned char*)XG + (size_t)dsts[ti * 4 + k] * D); dst[lane] = a8; dst[lane + 64] = b8; } }
            else {
#pragma unroll
                for (int k = 0; k < 4; ++k) { u32x4* dst = (u32x4*)(XG + (size_t)dsts[ti * 4 + k] * D); dst[lane] = a; dst[lane + 64] = b; } } }
    }
    SEAM(9);
    if (IN(10)) { const int lane = fresh_lane(), tid = wave * 64 + lane; (void)tid;
        constexpr size_t EB = MOE_FP8 ? 1 : 2;
        LAS int* tile_l = (LAS int*)(lds + TILEE_OFF);
        if (tid < NRT) tile_l[tid] = tile_e[tid];
        __syncthreads();
        pg8::SchedMoe S{MOE_FP8 ? (const char*)HB8 : (const char*)XG, (const char*)WT_GU, tile_l, *nrt_p, 8, (size_t)2048 * D * EB, (size_t)256 * D * EB, G, bx, MOE_FP8 ? row_tok : nullptr, 0};
        pg8::EpiMoe1 E{(void*)ACT, b_gu, row_rstd, ctl + CW_RDY};
        if constexpr (MOE_FP8) pg8::gemm8_phase<pg8::EpiMoe1, pg8::SchedMoe, true, HANDOFF == 1 ? 1 : 0, true>(lds + RING_OFF, S, E, tid, wave, ctl + CW_RDY); else pg8::gemm_phase<pg8::EpiMoe1, pg8::SchedMoe>(lds + RING_OFF, S, E, tid, wave);
    }
    if (IN(10) && IN(11)) { if constexpr (!MOE_FP8 || DBG_BAR10 || !HANDOFF) xcd_barrier(bar, wave == 0 && fresh_lane() == 0);
        else { if constexpr (HANDOFF == 2) {
                if (wave == 0) { const int ln = fresh_lane(); __builtin_amdgcn_fence(__ATOMIC_RELEASE, "agent");
                    const int pos = (bx & 7) * (G >> 3) + (bx >> 3), U = ln * G + pos;
                    if (U < *nrt_p * 8) (void)__hip_atomic_fetch_add(ctl + CW_RDY + 64 * (U >> 3), 1u, __ATOMIC_RELAXED, __HIP_MEMORY_SCOPE_AGENT); } }
            __builtin_amdgcn_fence(__ATOMIC_ACQUIRE, "agent"); __syncthreads(); } }
    if (IN(11)) { const int lane = fresh_lane(), tid = wave * 64 + lane; (void)tid;
        constexpr size_t EB = MOE_FP8 ? 1 : 2;
        const int nrt11 = *nrt_p;
        LAS int* tile_l = (LAS int*)(lds + TILEE_OFF);
        if (!IN(10)) { if (tid < NRT) tile_l[tid] = tile_e[tid]; __syncthreads(); }
        pg8::SchedMoe S{(const char*)ACT, (const char*)WT_DN, tile_l, nrt11, 4, (size_t)D * D * EB, (size_t)256 * D * EB, G, bx, nullptr, (MOE_FP8 && HANDOFF) ? (nrt11 * 8) % G : 0};
        pg8::EpiMoe2 E{(void*)YB, b_down, row_gate};
        if constexpr (MOE_FP8) pg8::gemm8_phase<pg8::EpiMoe2, pg8::SchedMoe, false, HANDOFF ? 2 : 0, true>(lds + RING_OFF, S, E, tid, wave, ctl + CW_RDY); else pg8::gemm_phase<pg8::EpiMoe2, pg8::SchedMoe>(lds + RING_OFF, S, E, tid, wave);
    }
    SEAM(11);
    if (IN(12)) { const int lane = fresh_lane(), tid = wave * 64 + lane; (void)tid;
        const int gw = vcu * NWAVES + wave, NGW = G * NWAVES;
        for (int m = gw; m < NTOK; m += NGW) {
            const u32x2* xr = (const u32x2*)(HB + (size_t)m * D) + lane;
            f32x4 v[4];
#pragma unroll
            for (int j = 0; j < 4; ++j) { const u32x2 xw = xr[64 * j]; v[j] = (f32x4){bf2f(xw.x & 0xffffu), bf2f(xw.x >> 16), bf2f(xw.y & 0xffffu), bf2f(xw.y >> 16)}; }
#pragma unroll
            for (int k = 0; k < 4; ++k) {
                if (MOE_FP8) { const unsigned* yr = (const unsigned*)((const unsigned char*)YB + (size_t)tok_dest[m * 4 + k] * D) + lane;
#pragma unroll
                    for (int j = 0; j < 4; ++j) { const unsigned y = yr[64 * j]; const f32x2_t lo = __builtin_amdgcn_cvt_pk_f32_fp8((int)y, false), hi = __builtin_amdgcn_cvt_pk_f32_fp8((int)y, true);
                        v[j].x += lo[0] * (1.f / Y8S); v[j].y += lo[1] * (1.f / Y8S); v[j].z += hi[0] * (1.f / Y8S); v[j].w += hi[1] * (1.f / Y8S); } }
                else { const u32x2* yr = (const u32x2*)(YB + (size_t)tok_dest[m * 4 + k] * D) + lane;
#pragma unroll
                    for (int j = 0; j < 4; ++j) { const u32x2 y = yr[64 * j]; v[j].x += bf2f(y.x & 0xffffu); v[j].y += bf2f(y.x >> 16); v[j].z += bf2f(y.y & 0xffffu); v[j].w += bf2f(y.y >> 16); } } }
            float s = 0.f;
#pragma unroll
            for (int j = 0; j < 4; ++j) s += (v[j].x * v[j].x + v[j].y * v[j].y) + (v[j].z * v[j].z + v[j].w * v[j].w);
            const float r = rsqrtf(wave_sum(s) * (1.f / D) + EPS);
            f32x4* o = (f32x4*)(args.out + (size_t)m * D) + lane;
#pragma unroll
            for (int j = 0; j < 4; ++j) { const f32x4 ww = ((const f32x4*)norm_final_w)[lane + 64 * j]; o[64 * j] = v[j] * r * ww; }
        }
    }
#undef IN
#undef SEAM
}

static void mega_launch(void* const* d_in, float* out, char* ws, int lo, int hi, int li, hipStream_t stream) {
    static bool attr = false;
    if (!attr) { if (hipFuncSetAttribute((const void*)mega_fwd, hipFuncAttributeMaxDynamicSharedMemorySize, LDS_BYTES) != hipSuccess) fprintf(stderr, "mega_launch: hipFuncSetAttribute failed\n"); attr = true; }
    Args a{};
    for (int i = 0; i < 23; ++i) a.in[i] = (const float*)d_in[i];
    a.out = out; a.ws = (unsigned char*)ws; a.ph_lo = lo; a.ph_hi = hi; a.li = li;
    hipLaunchKernelGGL(mega_fwd, dim3(256), dim3(NWAVES * 64), LDS_BYTES, stream, a);
    const hipError_t le = hipPeekAtLastError();
    if (le != hipSuccess) fprintf(stderr, "mega_launch: launch failed: %s\n", hipGetErrorName(le));
}
extern "C" void kernel_launch(void* const* d_in, const int* in_sizes, int n_in, void* d_out, int out_size, void* d_ws, size_t ws_size, hipStream_t stream) {
    if (n_in != 23 || ws_size < WS_END || out_size != NTOK * D) { fprintf(stderr, "kernel_launch: bad args n_in %d ws %zu out %d\n", n_in, ws_size, out_size); return; }
    (void)in_sizes;
    if (HANDOFF) (void)hipMemsetAsync((char*)d_ws + WS_CTL, 0, CTL_ZERO_BYTES, stream);
    else (void)hipMemsetAsync((char*)d_ws + WS_CTL + (size_t)CW_BAR * 4, 0, 16384, stream);
    mega_launch(d_in, (float*)d_out, (char*)d_ws, 0, 13, 0, stream);
}
```
